# Optimizing an MI355X kernel written in HIP

```python
import jax, jax.numpy as jnp
from jax import lax
import numpy as np

D_MODEL = 1024
BATCH = 8
SEQ = 4096
DEPTH = 1

GRID_W = 64
CTX_LEN = 256
D_MIX = D_MODEL
RET_HEADS = 4
RET_DK = 128
RET_DV = 128
RET_W = RET_HEADS * RET_DV
RET_CHUNK = 128
ATT_HEADS = 8
ATT_KV_HEADS = 2
ATT_DH = 64
ATT_W = ATT_HEADS * ATT_DH
ATT_BLOCK = 128
WINDOW = 128
ROPE_BASE = 10000.0
EPS = 1e-6
NEG = -1e30
SPLIT_SIZES = (RET_HEADS * RET_DK, RET_HEADS * RET_DK, RET_W, RET_W,
               ATT_W, ATT_KV_HEADS * ATT_DH, ATT_KV_HEADS * ATT_DH, ATT_W)
IN_COLS = 4 * RET_W + 2 * ATT_W + 2 * ATT_KV_HEADS * ATT_DH

kernel_name = "hymba_retention_swa_sink_prefix_dit"


def rms_norm(x):
    x32 = x.astype(jnp.float32)
    return (x32 * lax.rsqrt(jnp.mean(x32 * x32, axis=-1, keepdims=True) + EPS)).astype(x.dtype)


def split_heads(t, n_heads):
    B, L, _ = t.shape
    return t.reshape(B, L, n_heads, -1).transpose(0, 2, 1, 3)


def merge_heads(t):
    B, H, L, d = t.shape
    return t.transpose(0, 2, 1, 3).reshape(B, L, H * d)


def project(h, w_in_l):
    y = h @ w_in_l
    idx = [int(i) for i in np.cumsum(SPLIT_SIZES)[:-1]]
    rq, rk, rv, rg, aq, ak, av, ag = jnp.split(y, idx, axis=-1)
    rq = split_heads(rq, RET_HEADS)
    rk = split_heads(rk, RET_HEADS) * (RET_DK ** -0.5)
    rv = split_heads(rv, RET_HEADS)
    aq = split_heads(aq, ATT_HEADS)
    ak = split_heads(ak, ATT_KV_HEADS)
    av = split_heads(av, ATT_KV_HEADS)
    return rq, rk, rv, rg, aq, ak, av, ag


def axial_rope(x, rows, cols):
    dh = x.shape[-1]
    half = dh // 2
    nf = half // 2
    inv = ROPE_BASE ** (-jnp.arange(nf, dtype=jnp.float32) / nf)
    ang = jnp.concatenate([rows.astype(jnp.float32)[:, None] * inv,
                           cols.astype(jnp.float32)[:, None] * inv], axis=-1)
    cos, sin = jnp.cos(ang), jnp.sin(ang)
    x1, x2 = x[..., :half], x[..., half:]
    return jnp.concatenate([x1 * cos - x2 * sin, x1 * sin + x2 * cos], axis=-1).astype(x.dtype)


def retention_chunked(q, k, v, log_gamma, state0, strict):
    B, H, L, _ = q.shape
    C = RET_CHUNK
    n = L // C

    def chunks(t):
        return t.astype(jnp.float32).reshape(B, H, n, C, t.shape[-1]).transpose(2, 0, 1, 3, 4)

    pos = jnp.arange(C, dtype=jnp.float32)
    diff = pos[:, None] - pos[None, :]
    mask = (diff > 0) if strict else (diff >= 0)
    decay_in = jnp.where(mask[None], jnp.exp(log_gamma[:, None, None] * jnp.where(mask, diff, 0.0)[None]), 0.0)
    decay_q = jnp.exp(log_gamma[:, None] * (pos + 1.0))[None, :, :, None]
    decay_k = jnp.exp(log_gamma[:, None] * (C - 1.0 - pos))[None, :, :, None]
    decay_c = jnp.exp(log_gamma * C)[None, :, None, None]

    def step(R, inp):
        qc, kc, vc = inp
        s = jnp.einsum('bhid,bhjd->bhij', qc, kc) * decay_in
        inner = jnp.einsum('bhij,bhje->bhie', s, vc)
        cross = jnp.einsum('bhid,bhde->bhie', qc, R) * decay_q
        R = R * decay_c + jnp.einsum('bhjd,bhje->bhde', kc * decay_k, vc)
        return R, inner + cross

    R, out = lax.scan(step, state0, (chunks(q), chunks(k), chunks(v)))
    out = out.transpose(1, 2, 0, 3, 4).reshape(B, H, L, -1)
    return out, R


def retention_final_state(k, v, log_gamma, reverse):
    L = k.shape[2]
    pos = jnp.arange(L, dtype=jnp.float32)
    expo = pos if reverse else (L - 1.0 - pos)
    w = jnp.exp(log_gamma[:, None] * expo)[None, :, :, None]
    return jnp.einsum('bhld,bhle->bhde', k.astype(jnp.float32) * w, v.astype(jnp.float32))


def retention_branch(q, k, v, g, log_gamma, gn_w, s_fwd, s_bwd):
    out_f, fin_f = retention_chunked(q, k, v, log_gamma[0], s_fwd, strict=False)
    out_b, fin_b = retention_chunked(jnp.flip(q, 2), jnp.flip(k, 2), jnp.flip(v, 2),
                                     log_gamma[1], s_bwd, strict=True)
    y = out_f + jnp.flip(out_b, 2)
    mu = jnp.mean(y, axis=-1, keepdims=True)
    var = jnp.mean(jnp.square(y - mu), axis=-1, keepdims=True)
    y = (y - mu) * lax.rsqrt(var + EPS)
    y = merge_heads(y).astype(g.dtype) * gn_w
    return y * jax.nn.silu(g), fin_f, fin_b


def sink_softmax(logits, sink):
    m = jnp.maximum(jnp.max(logits, axis=-1, keepdims=True), sink)
    p = jnp.exp(logits - m)
    return p / (jnp.sum(p, axis=-1, keepdims=True) + jnp.exp(sink - m))


def band_blocks(t):
    B, K, L, d = t.shape
    nb = L // ATT_BLOCK
    tp = jnp.pad(t, ((0, 0), (0, 0), (ATT_BLOCK, ATT_BLOCK), (0, 0))).reshape(B, K, nb + 2, ATT_BLOCK, d)
    return jnp.concatenate([tp[:, :, 0:nb], tp[:, :, 1:nb + 1], tp[:, :, 2:nb + 2]], axis=3)


def windowed_gqa(q, k, v, k_ctx, v_ctx, sink):
    B, Hq, L, dh = q.shape
    Hkv = k.shape[1]
    G = Hq // Hkv
    nb = L // ATT_BLOCK
    Lc = k_ctx.shape[2]
    qb = q.astype(jnp.float32).reshape(B, Hkv, G, nb, ATT_BLOCK, dh) * (dh ** -0.5)
    kb = band_blocks(k.astype(jnp.float32))
    vb = band_blocks(v.astype(jnp.float32))
    qpos = jnp.arange(nb)[:, None, None] * ATT_BLOCK + jnp.arange(ATT_BLOCK)[None, :, None]
    kpos = jnp.arange(nb)[:, None, None] * ATT_BLOCK - ATT_BLOCK + jnp.arange(3 * ATT_BLOCK)[None, None, :]
    valid = (jnp.abs(qpos - kpos) <= WINDOW) & (kpos >= 0) & (kpos < L)
    s_loc = jnp.where(valid, jnp.einsum('bkgnqd,bknjd->bkgnqj', qb, kb), NEG)
    s_ctx = jnp.einsum('bkgnqd,bkcd->bkgnqc', qb, k_ctx.astype(jnp.float32))
    p = sink_softmax(jnp.concatenate([s_ctx, s_loc], axis=-1),
                     sink.astype(jnp.float32).reshape(1, Hkv, G, 1, 1, 1))
    out = (jnp.einsum('bkgnqc,bkcd->bkgnqd', p[..., :Lc], v_ctx.astype(jnp.float32))
           + jnp.einsum('bkgnqj,bknjd->bkgnqd', p[..., Lc:], vb))
    return out.reshape(B, Hq, L, dh).astype(q.dtype)


def context_gqa(q, k, v, sink):
    B, Hq, Lc, dh = q.shape
    Hkv = k.shape[1]
    G = Hq // Hkv
    qg = q.astype(jnp.float32).reshape(B, Hkv, G, Lc, dh) * (dh ** -0.5)
    s = jnp.einsum('bkgqd,bkcd->bkgqc', qg, k.astype(jnp.float32))
    p = sink_softmax(s, sink.astype(jnp.float32).reshape(1, Hkv, G, 1, 1))
    out = jnp.einsum('bkgqc,bkcd->bkgqd', p, v.astype(jnp.float32))
    return out.reshape(B, Hq, Lc, dh).astype(q.dtype)


def setup_inputs(seed: int = 0) -> dict:
    key = jax.random.key(seed)
    ks = jax.random.split(key, 12)
    f32 = jnp.float32
    x = jax.random.normal(ks[0], (BATCH, SEQ, D_MODEL), f32)
    c = jax.random.normal(ks[1], (BATCH, D_MODEL), f32)
    ctx = jax.random.normal(ks[2], (BATCH, CTX_LEN, D_MODEL), f32)
    c_ctx = jax.random.normal(ks[3], (D_MODEL,), f32)
    w_ada = jax.random.normal(ks[4], (DEPTH, D_MODEL, 3 * D_MODEL), f32) * (0.5 * D_MODEL ** -0.5)
    b_ada = jax.random.normal(ks[5], (DEPTH, 3 * D_MODEL), f32) * 0.02
    w_in = jax.random.normal(ks[6], (DEPTH, D_MODEL, IN_COLS), f32) * (D_MODEL ** -0.5)
    base_logit = jnp.log(2.0 ** (5.0 + jnp.arange(RET_HEADS, dtype=f32)) - 1.0)
    ret_decay_logit = base_logit[None, None, :] + 0.1 * jax.random.normal(ks[7], (DEPTH, 2, RET_HEADS), f32)
    ret_gn_w = 1.0 + 0.02 * jax.random.normal(ks[8], (DEPTH, RET_W), f32)
    att_sink = 0.5 * jax.random.normal(ks[9], (DEPTH, ATT_HEADS), f32)
    w_out = jax.random.normal(ks[10], (DEPTH, D_MIX, D_MODEL), f32) * (D_MIX ** -0.5)
    final_norm_w = 1.0 + 0.02 * jax.random.normal(ks[11], (D_MODEL,), f32)
    return {"x": x, "c": c, "ctx": ctx, "c_ctx": c_ctx, "w_ada": w_ada, "b_ada": b_ada,
            "w_in": w_in, "ret_decay_logit": ret_decay_logit, "ret_gn_w": ret_gn_w,
            "att_sink": att_sink, "w_out": w_out, "final_norm_w": final_norm_w}


def reference(x, c, ctx, c_ctx, w_ada, b_ada, w_in, ret_decay_logit, ret_gn_w, att_sink, w_out, final_norm_w):
    B, L, _ = x.shape
    ROWS = L // GRID_W
    rows = jnp.broadcast_to(jnp.arange(ROWS, dtype=jnp.int32)[:, None], (ROWS, GRID_W)).reshape(-1)
    cols = jnp.broadcast_to(jnp.arange(GRID_W, dtype=jnp.int32)[None, :], (ROWS, GRID_W)).reshape(-1)

    for l in range(DEPTH):
        shift, scale, gate = jnp.split(jax.nn.silu(c) @ w_ada[l] + b_ada[l], 3, axis=-1)
        shift_c, scale_c, gate_c = jnp.split(jax.nn.silu(c_ctx) @ w_ada[l] + b_ada[l], 3, axis=-1)
        h = rms_norm(x) * (1.0 + scale[:, None, :]) + shift[:, None, :]
        hc = rms_norm(ctx) * (1.0 + scale_c) + shift_c

        rq, rk, rv, rg, aq, ak, av, ag = project(h, w_in[l])
        crq, crk, crv, crg, caq, cak, cav, cag = project(hc, w_in[l])
        rq, rk = axial_rope(rq, rows, cols), axial_rope(rk, rows, cols)
        aq, ak = axial_rope(aq, rows, cols), axial_rope(ak, rows, cols)
        log_gamma = jax.nn.log_sigmoid(ret_decay_logit[l].astype(jnp.float32))

        if l < DEPTH - 1:
            zero = jnp.zeros((B, RET_HEADS, RET_DK, RET_DV), jnp.float32)
            ret_c, s_fwd, s_bwd = retention_branch(crq, crk, crv, crg, log_gamma, ret_gn_w[l], zero, zero)
            att_c = merge_heads(context_gqa(caq, cak, cav, att_sink[l])) * jax.nn.silu(cag)
            ctx_next = ctx + gate_c * (jnp.concatenate([ret_c, att_c], axis=-1) @ w_out[l])
        else:
            s_fwd = retention_final_state(crk, crv, log_gamma[0], reverse=False)
            s_bwd = retention_final_state(crk, crv, log_gamma[1], reverse=True)
            ctx_next = ctx

        ret_x, _, _ = retention_branch(rq, rk, rv, rg, log_gamma, ret_gn_w[l], s_fwd, s_bwd)
        att_x = merge_heads(windowed_gqa(aq, ak, av, cak, cav, att_sink[l])) * jax.nn.silu(ag)
        mixed = jnp.concatenate([ret_x, att_x], axis=-1) @ w_out[l]
        x = x + gate[:, None, :] * mixed
        ctx = ctx_next

    return rms_norm(x) * final_norm_w
```

```cpp
#include <hip/hip_runtime.h>
#include <hip/hip_cooperative_groups.h>
#include <cstdio>
namespace cg = cooperative_groups;

#ifndef MK_ONE_LAUNCH
#define MK_ONE_LAUNCH 0
#endif

typedef unsigned short bf16_t;
#define NT 512
#define MROWS 34816
#define KVROWS 4352
#define LDS_BYTES 131072

struct Params {
    const float *x, *c, *ctx, *c_ctx, *w_ada, *b_ada, *w_in, *decay, *gn_w, *sink, *w_out, *fnw;
    float* out;
    float* mod;
    float2* tab128;
    float2* tab64;
    bf16_t *h, *rq, *rk, *rv, *rg, *aq, *ak, *av, *ag, *Kf, *Kb, *Rf, *Rb, *mixed;
};

__device__ __forceinline__ float bf2f(bf16_t b) { return __uint_as_float(((unsigned)b) << 16); }
__device__ __forceinline__ bf16_t f2bf(float f) { unsigned u = __float_as_uint(f); u += 0x7FFFu + ((u >> 16) & 1u); return (bf16_t)(u >> 16); }
__device__ __forceinline__ unsigned pack2(float lo, float hi) { return (unsigned)f2bf(lo) | ((unsigned)f2bf(hi) << 16); }
__device__ __forceinline__ void store8(bf16_t* dst, const float* o) {
    uint4 u; u.x = pack2(o[0], o[1]); u.y = pack2(o[2], o[3]); u.z = pack2(o[4], o[5]); u.w = pack2(o[6], o[7]);
    *(uint4*)dst = u;
}
__device__ __forceinline__ void load8(const bf16_t* src, float* o) {
    const uint4 u = *(const uint4*)src;
    o[0] = __uint_as_float(u.x << 16); o[1] = __uint_as_float(u.x & 0xffff0000u);
    o[2] = __uint_as_float(u.y << 16); o[3] = __uint_as_float(u.y & 0xffff0000u);
    o[4] = __uint_as_float(u.z << 16); o[5] = __uint_as_float(u.z & 0xffff0000u);
    o[6] = __uint_as_float(u.w << 16); o[7] = __uint_as_float(u.w & 0xffff0000u);
}
__device__ __forceinline__ float silu_f(float v) { return v / (1.f + __expf(-v)); }
__device__ __forceinline__ float wave_sum(float v) {
#pragma unroll
    for (int o = 32; o >= 1; o >>= 1) v += __shfl_xor(v, o);
    return v;
}
__device__ __forceinline__ float lgam(const Params& p, int dir, int h) { return -log1pf(expf(-p.decay[dir * 4 + h])); }

__device__ __forceinline__ int ocol_in(int sg) {
    if (sg < 1024) { const int s = sg & 127; return (sg & ~127) + ((s >> 5) << 4) + (((s >> 3) & 3) << 2) + (s & 3) + (((s >> 2) & 1) << 6); }
    if (sg >= 2048 && sg < 2688) { const int s = sg & 63; return (sg & ~63) + ((s >> 5) << 4) + (((s >> 3) & 3) << 2) + (s & 3) + (((s >> 2) & 1) << 5); }
    return sg;
}

__device__ __forceinline__ void epi_in8(const Params& p, int row, int s0, const float* v) {
    const bool isc = row >= 32768;
    int b, t;
    if (isc) { const int r = row - 32768; b = r >> 8; t = r & 255; } else { b = row >> 12; t = row & 4095; }
    const int gr = (t >> 6) & 63, gc = t & 63;
    float o[8];
    if (s0 < 1024) {
        const bool isk = s0 >= 512;
        if (!isk && isc) return;
        const int head = (s0 >> 7) & 3, s = s0 & 127, wc = s >> 5, fq = (s >> 3) & 3;
        const float scl = isk ? 0.08838834764831845f : 1.f;
        if (isc) {
#pragma unroll
            for (int i = 0; i < 8; ++i) o[i] = v[i] * scl;
        } else {
            const int pos = wc < 2 ? gr : gc;
            const float2* tb = p.tab128 + pos * 32 + (wc & 1) * 16 + fq * 4;
#pragma unroll
            for (int j = 0; j < 4; ++j) { const float2 cs = tb[j]; const float x1 = v[j] * scl, x2 = v[4 + j] * scl; o[j] = x1 * cs.x - x2 * cs.y; o[4 + j] = x1 * cs.y + x2 * cs.x; }
        }
        bf16_t* dst = isk ? p.rk + ((size_t)(b * 4 + head) * KVROWS + (isc ? 4096 + t : t)) * 128 + s
                          : p.rq + ((size_t)(b * 4 + head) * 4096 + t) * 128 + s;
        store8(dst, o);
    } else if (s0 < 1536) {
        const int head = (s0 - 1024) >> 7, s = s0 & 127;
        store8(p.rv + ((size_t)(b * 4 + head) * KVROWS + (isc ? 4096 + t : t)) * 128 + s, v);
    } else if (s0 < 2048) {
        if (isc) return;
#pragma unroll
        for (int i = 0; i < 8; ++i) o[i] = silu_f(v[i]);
        store8(p.rg + (size_t)row * 512 + (s0 - 1536), o);
    } else if (s0 < 2688) {
        const bool isk = s0 >= 2560;
        if (!isk && isc) return;
        const int head = isk ? (s0 - 2560) >> 6 : (s0 - 2048) >> 6, s = s0 & 63, w = s >> 5, fq = (s >> 3) & 3;
        const float scl = isk ? 1.f : 0.125f;
        if (isc) {
#pragma unroll
            for (int i = 0; i < 8; ++i) o[i] = v[i];
        } else {
            const int pos = w == 0 ? gr : gc;
            const float2* tb = p.tab64 + pos * 16 + fq * 4;
#pragma unroll
            for (int j = 0; j < 4; ++j) { const float2 cs = tb[j]; const float x1 = v[j] * scl, x2 = v[4 + j] * scl; o[j] = x1 * cs.x - x2 * cs.y; o[4 + j] = x1 * cs.y + x2 * cs.x; }
        }
        bf16_t* dst = isk ? p.ak + ((size_t)(b * 2 + head) * KVROWS + (isc ? t : 256 + t)) * 64 + s
                          : p.aq + ((size_t)(b * 8 + head) * 4096 + t) * 64 + s;
        store8(dst, o);
    } else if (s0 < 2816) {
        const int head = (s0 - 2688) >> 6, s = s0 & 63;
        store8(p.av + ((size_t)(b * 2 + head) * KVROWS + (isc ? t : 256 + t)) * 64 + s, v);
    } else {
        if (isc) return;
#pragma unroll
        for (int i = 0; i < 8; ++i) o[i] = silu_f(v[i]);
        store8(p.ag + (size_t)row * 512 + (s0 - 2816), o);
    }
}

__device__ void ph_mod(const Params& p, float* lds) {
    if (blockIdx.x < 6) {
        for (int i = threadIdx.x; i < 9 * 1024; i += NT) {
            const int v = i >> 10, k = i & 1023;
            const float cv = v < 8 ? p.c[v * 1024 + k] : p.c_ctx[k];
            lds[i] = cv / (1.f + expf(-cv));
        }
        __syncthreads();
        for (int item = blockIdx.x; item < 6; item += gridDim.x) {
            const int col = item * NT + threadIdx.x;
            float acc[9];
#pragma unroll
            for (int v = 0; v < 9; ++v) acc[v] = 0.f;
            for (int k = 0; k < 1024; ++k) {
                const float w = p.w_ada[(size_t)k * 3072 + col];
#pragma unroll
                for (int v = 0; v < 9; ++v) acc[v] += lds[v * 1024 + k] * w;
            }
            const float bb = p.b_ada[col];
#pragma unroll
            for (int v = 0; v < 9; ++v) p.mod[v * 3072 + col] = acc[v] + bb;
        }
    }
    const int gt = blockIdx.x * NT + threadIdx.x;
    if (gt < 2048) { const int pos = gt >> 5, f = gt & 31; const float a = (float)pos * powf(10000.f, -(float)f / 32.f); p.tab128[gt] = make_float2(cosf(a), sinf(a)); }
    else if (gt < 3072) { const int g2 = gt - 2048, pos = g2 >> 4, f = g2 & 15; const float a = (float)pos * powf(10000.f, -(float)f / 16.f); p.tab64[g2] = make_float2(cosf(a), sinf(a)); }
}

__device__ void ph_h(const Params& p) {
    const int wave = threadIdx.x >> 6, lane = threadIdx.x & 63;
    for (int row = blockIdx.x * 8 + wave; row < MROWS; row += gridDim.x * 8) {
        const float* src; int v;
        if (row < 32768) { src = p.x + (size_t)row * 1024; v = row >> 12; } else { src = p.ctx + (size_t)(row - 32768) * 1024; v = 8; }
        float4 xv[4]; float ss = 0.f;
#pragma unroll
        for (int i = 0; i < 4; ++i) { xv[i] = *(const float4*)(src + i * 256 + lane * 4); ss += xv[i].x * xv[i].x + xv[i].y * xv[i].y + xv[i].z * xv[i].z + xv[i].w * xv[i].w; }
        ss = wave_sum(ss);
        const float rstd = rsqrtf(ss * (1.f / 1024.f) + 1e-6f);
        const float* sh = p.mod + v * 3072; const float* sc = sh + 1024;
#pragma unroll
        for (int i = 0; i < 4; ++i) {
            const int col = i * 256 + lane * 4;
            const float4 s4 = *(const float4*)(sc + col), h4 = *(const float4*)(sh + col);
            uint2 u;
            u.x = pack2(xv[i].x * rstd * (1.f + s4.x) + h4.x, xv[i].y * rstd * (1.f + s4.y) + h4.y);
            u.y = pack2(xv[i].z * rstd * (1.f + s4.z) + h4.z, xv[i].w * rstd * (1.f + s4.w) + h4.w);
            *(uint2*)(p.h + (size_t)row * 1024 + col) = u;
        }
    }
}

template <int MODE> __device__ void ph_gemm_naive(const Params& p, float* lds) {
    const bf16_t* A = MODE == 0 ? p.h : p.mixed;
    const float* Bm = MODE == 0 ? p.w_in : p.w_out;
    constexpr int ldb = MODE == 0 ? 3328 : 1024;
    constexpr int nrt = (MODE == 0 ? MROWS : 32768) / 64, nct = ldb / 128;
    float* As = lds;
    float* Bs = lds + 32 * 65;
    const int tid = threadIdx.x, ty = tid >> 4, tx = tid & 15;
    for (int tile = blockIdx.x; tile < nrt * nct; tile += gridDim.x) {
        const int rt = tile / nct, ct = tile % nct;
        float acc[2][8];
#pragma unroll
        for (int r = 0; r < 2; ++r)
#pragma unroll
            for (int t = 0; t < 8; ++t) acc[r][t] = 0.f;
        int bc[8];
#pragma unroll
        for (int i = 0; i < 8; ++i) { const int cc = (tid + NT * i) & 127; const int sg = ct * 128 + cc; bc[i] = MODE == 0 ? ocol_in(sg) : sg; }
        for (int k0 = 0; k0 < 1024; k0 += 32) {
#pragma unroll
            for (int i = 0; i < 4; ++i) { const int e = tid + NT * i, r = e >> 5, kk = e & 31; As[kk * 65 + r] = bf2f(A[(size_t)(rt * 64 + r) * 1024 + k0 + kk]); }
#pragma unroll
            for (int i = 0; i < 8; ++i) { const int e = tid + NT * i, kk = e >> 7, cc = e & 127; Bs[kk * 129 + cc] = Bm[(size_t)(k0 + kk) * ldb + bc[i]]; }
            __syncthreads();
#pragma unroll 4
            for (int kk = 0; kk < 32; ++kk) {
                const float a0 = As[kk * 65 + ty * 2], a1 = As[kk * 65 + ty * 2 + 1];
#pragma unroll
                for (int t = 0; t < 8; ++t) { const float bv = Bs[kk * 129 + tx * 8 + t]; acc[0][t] += a0 * bv; acc[1][t] += a1 * bv; }
            }
            __syncthreads();
        }
#pragma unroll
        for (int r = 0; r < 2; ++r) {
            const int row = rt * 64 + ty * 2 + r, s0 = ct * 128 + tx * 8;
            if (MODE == 0) epi_in8(p, row, s0, acc[r]);
            else {
                const int b = row >> 12;
                const float* gate = p.mod + b * 3072 + 2048 + s0;
                const float* xr = p.x + (size_t)row * 1024 + s0;
                float* orow = p.out + (size_t)row * 1024 + s0;
#pragma unroll
                for (int t = 0; t < 8; ++t) orow[t] = xr[t] + gate[t] * acc[r][t];
            }
        }
    }
}

__device__ void ph_states_naive(const Params& p) {
    for (int item = blockIdx.x; item < 32 * 34; item += gridDim.x) {
        const int bh = item / 34, c = item % 34, h = bh & 3;
        const float lgf = lgam(p, 0, h), lgb = lgam(p, 1, h);
        const bf16_t* K = p.rk + ((size_t)bh * KVROWS + c * 128) * 128;
        const bf16_t* V = p.rv + ((size_t)bh * KVROWS + c * 128) * 128;
        const int e = threadIdx.x & 127, dg = threadIdx.x >> 7;
        float af[32], ab[32];
#pragma unroll
        for (int i = 0; i < 32; ++i) { af[i] = 0.f; ab[i] = 0.f; }
        for (int j = 0; j < 128; ++j) {
            const float vv = bf2f(V[j * 128 + e]);
            const float wf = expf(lgf * (float)(127 - j)) * vv, wb = expf(lgb * (float)j) * vv;
#pragma unroll
            for (int d8 = 0; d8 < 4; ++d8) {
                float kk[8]; load8(K + j * 128 + dg * 32 + d8 * 8, kk);
#pragma unroll
                for (int i = 0; i < 8; ++i) { af[d8 * 8 + i] += wf * kk[i]; ab[d8 * 8 + i] += wb * kk[i]; }
            }
        }
        bf16_t* of = p.Kf + ((size_t)item * 128 + e) * 128 + dg * 32;
        bf16_t* ob = p.Kb + ((size_t)item * 128 + e) * 128 + dg * 32;
#pragma unroll
        for (int d8 = 0; d8 < 4; ++d8) { store8(of + d8 * 8, af + d8 * 8); store8(ob + d8 * 8, ab + d8 * 8); }
    }
}

__device__ void ph_scan(const Params& p) {
    for (int idx = blockIdx.x * NT + threadIdx.x; idx < 32 * 16384; idx += gridDim.x * NT) {
        const int bh = idx >> 14, el = idx & 16383, h = bh & 3;
        const float gfC = expf(lgam(p, 0, h) * 128.f), gbC = expf(lgam(p, 1, h) * 128.f);
        const bf16_t* kf = p.Kf + (size_t)bh * 34 * 16384 + el;
        const bf16_t* kb = p.Kb + (size_t)bh * 34 * 16384 + el;
        bf16_t* rf = p.Rf + (size_t)bh * 32 * 16384 + el;
        bf16_t* rb = p.Rb + (size_t)bh * 32 * 16384 + el;
        float R = bf2f(kf[32 * 16384]); R = gfC * R + bf2f(kf[33 * 16384]);
        for (int n = 0; n < 32; ++n) { rf[(size_t)n * 16384] = f2bf(R); R = gfC * R + bf2f(kf[(size_t)n * 16384]); }
        R = bf2f(kb[33 * 16384]); R = gbC * R + bf2f(kb[32 * 16384]);
        for (int n = 31; n >= 0; --n) { rb[(size_t)n * 16384] = f2bf(R); R = gbC * R + bf2f(kb[(size_t)n * 16384]); }
    }
}

__device__ void ph_retout_naive(const Params& p, float* S) {
    for (int item = blockIdx.x; item < 1024; item += gridDim.x) {
        const int bh = item >> 5, n = item & 31, b = bh >> 2, h = bh & 3;
        const float lgf = lgam(p, 0, h), lgb = lgam(p, 1, h);
        const bf16_t* Q = p.rq + ((size_t)bh * 4096 + n * 128) * 128;
        const bf16_t* K = p.rk + ((size_t)bh * KVROWS + n * 128) * 128;
        const bf16_t* V = p.rv + ((size_t)bh * KVROWS + n * 128) * 128;
        const bf16_t* RF = p.Rf + (size_t)(bh * 32 + n) * 16384;
        const bf16_t* RB = p.Rb + (size_t)(bh * 32 + n) * 16384;
        const int i = threadIdx.x >> 2, q4 = threadIdx.x & 3;
        for (int jj = 0; jj < 32; ++jj) {
            const int j = q4 * 32 + jj;
            float dot = 0.f;
#pragma unroll 4
            for (int d8 = 0; d8 < 16; ++d8) {
                float a[8], bb[8]; load8(Q + i * 128 + d8 * 8, a); load8(K + j * 128 + d8 * 8, bb);
#pragma unroll
                for (int t = 0; t < 8; ++t) dot += a[t] * bb[t];
            }
            const float dec = j <= i ? expf(lgf * (float)(i - j)) : expf(lgb * (float)(j - i));
            S[i * 128 + ((j + i) & 127)] = dot * dec;
        }
        __syncthreads();
        float y[32];
#pragma unroll
        for (int t = 0; t < 32; ++t) y[t] = 0.f;
        const int e0 = q4 * 32;
        for (int j = 0; j < 128; ++j) {
            const float s = S[i * 128 + ((j + i) & 127)];
#pragma unroll
            for (int e8 = 0; e8 < 4; ++e8) {
                float vv[8]; load8(V + j * 128 + e0 + e8 * 8, vv);
#pragma unroll
                for (int t = 0; t < 8; ++t) y[e8 * 8 + t] += s * vv[t];
            }
        }
        const float cf = expf(lgf * (float)(i + 1)), cb = expf(lgb * (float)(128 - i));
#pragma unroll 1
        for (int d8 = 0; d8 < 16; ++d8) {
            float a[8]; load8(Q + i * 128 + d8 * 8, a);
#pragma unroll
            for (int ee = 0; ee < 32; ++ee) {
                float rf[8], rb[8]; load8(RF + (e0 + ee) * 128 + d8 * 8, rf); load8(RB + (e0 + ee) * 128 + d8 * 8, rb);
                float sf = 0.f, sb = 0.f;
#pragma unroll
                for (int t = 0; t < 8; ++t) { sf += a[t] * rf[t]; sb += a[t] * rb[t]; }
                y[ee] += cf * sf + cb * sb;
            }
        }
        float sum = 0.f;
#pragma unroll
        for (int t = 0; t < 32; ++t) sum += y[t];
        sum += __shfl_xor(sum, 1); sum += __shfl_xor(sum, 2);
        const float mu = sum * (1.f / 128.f);
        float vs = 0.f;
#pragma unroll
        for (int t = 0; t < 32; ++t) { const float dlt = y[t] - mu; vs += dlt * dlt; }
        vs += __shfl_xor(vs, 1); vs += __shfl_xor(vs, 2);
        const float rs = rsqrtf(vs * (1.f / 128.f) + 1e-6f);
        const size_t row = (size_t)b * 4096 + n * 128 + i;
        const int col0 = h * 128 + e0;
#pragma unroll
        for (int e8 = 0; e8 < 4; ++e8) {
            float g[8], o[8]; load8(p.rg + row * 512 + col0 + e8 * 8, g);
#pragma unroll
            for (int t = 0; t < 8; ++t) o[t] = (y[e8 * 8 + t] - mu) * rs * p.gn_w[col0 + e8 * 8 + t] * g[t];
            store8(p.mixed + row * 1024 + col0 + e8 * 8, o);
        }
        __syncthreads();
    }
}

__device__ void ph_attn_naive(const Params& p) {
    for (int idx = blockIdx.x * NT + threadIdx.x; idx < 8 * 8 * 4096; idx += gridDim.x * NT) {
        const int t = idx & 4095, bq = idx >> 12, qh = bq & 7, b = bq >> 3, kvh = qh >> 2;
        float q[64], acc[64];
#pragma unroll
        for (int d8 = 0; d8 < 8; ++d8) load8(p.aq + ((size_t)bq * 4096 + t) * 64 + d8 * 8, q + d8 * 8);
#pragma unroll
        for (int e = 0; e < 64; ++e) acc[e] = 0.f;
        const bf16_t* Kb = p.ak + (size_t)(b * 2 + kvh) * KVROWS * 64;
        const bf16_t* Vb = p.av + (size_t)(b * 2 + kvh) * KVROWS * 64;
        float m = p.sink[qh], l = 1.f;
        const int lo = t - 128 < 0 ? 0 : t - 128, hi = t + 128 > 4095 ? 4095 : t + 128;
        const int nkeys = 256 + (hi - lo + 1);
        for (int kk = 0; kk < nkeys; ++kk) {
            const int krow = kk < 256 ? kk : lo + kk;
            float s = 0.f;
#pragma unroll
            for (int d8 = 0; d8 < 8; ++d8) {
                float kv[8]; load8(Kb + (size_t)krow * 64 + d8 * 8, kv);
#pragma unroll
                for (int i = 0; i < 8; ++i) s += q[d8 * 8 + i] * kv[i];
            }
            if (s > m) {
                const float sc = __expf(m - s); l *= sc;
#pragma unroll
                for (int e = 0; e < 64; ++e) acc[e] *= sc;
                m = s;
            }
            const float pe = __expf(s - m); l += pe;
#pragma unroll
            for (int d8 = 0; d8 < 8; ++d8) {
                float vv[8]; load8(Vb + (size_t)krow * 64 + d8 * 8, vv);
#pragma unroll
                for (int i = 0; i < 8; ++i) acc[d8 * 8 + i] += pe * vv[i];
            }
        }
        const float inv = 1.f / l;
        const size_t row = (size_t)b * 4096 + t;
#pragma unroll
        for (int d8 = 0; d8 < 8; ++d8) {
            float g[8], o[8]; load8(p.ag + row * 512 + qh * 64 + d8 * 8, g);
#pragma unroll
            for (int i = 0; i < 8; ++i) o[i] = acc[d8 * 8 + i] * inv * g[i];
            store8(p.mixed + row * 1024 + 512 + qh * 64 + d8 * 8, o);
        }
    }
}

__device__ void ph_final(const Params& p) {
    const int wave = threadIdx.x >> 6, lane = threadIdx.x & 63;
    for (int row = blockIdx.x * 8 + wave; row < 32768; row += gridDim.x * 8) {
        float* src = p.out + (size_t)row * 1024;
        float4 xv[4]; float ss = 0.f;
#pragma unroll
        for (int i = 0; i < 4; ++i) { xv[i] = *(const float4*)(src + i * 256 + lane * 4); ss += xv[i].x * xv[i].x + xv[i].y * xv[i].y + xv[i].z * xv[i].z + xv[i].w * xv[i].w; }
        ss = wave_sum(ss);
        const float rstd = rsqrtf(ss * (1.f / 1024.f) + 1e-6f);
#pragma unroll
        for (int i = 0; i < 4; ++i) {
            const int col = i * 256 + lane * 4;
            const float4 w4 = *(const float4*)(p.fnw + col);
            float4 o; o.x = xv[i].x * rstd * w4.x; o.y = xv[i].y * rstd * w4.y; o.z = xv[i].z * rstd * w4.z; o.w = xv[i].w * rstd * w4.w;
            *(float4*)(src + col) = o;
        }
    }
}

#define NPHASE 9
template <int PH> __device__ __forceinline__ void run_phase(const Params& p, float* lds) {
    if (PH == 0) ph_mod(p, lds);
    else if (PH == 1) ph_h(p);
    else if (PH == 2) ph_gemm_naive<0>(p, lds);
    else if (PH == 3) { ph_states_naive(p); ph_attn_naive(p); }
    else if (PH == 4) ph_scan(p);
    else if (PH == 5) ph_retout_naive(p, lds);
    else if (PH == 6) ph_gemm_naive<1>(p, lds);
    else if (PH == 7) ph_final(p);
}

template <int PH> __global__ __launch_bounds__(NT) void k_ph(Params p) {
    extern __shared__ __attribute__((aligned(16))) float lds[];
    run_phase<PH>(p, lds);
}

__global__ __launch_bounds__(NT) void k_mega(Params p) {
    extern __shared__ __attribute__((aligned(16))) float lds[];
    cg::grid_group grid = cg::this_grid();
    run_phase<0>(p, lds); grid.sync();
    run_phase<1>(p, lds); grid.sync();
    run_phase<2>(p, lds); grid.sync();
    run_phase<3>(p, lds); grid.sync();
    run_phase<4>(p, lds); grid.sync();
    run_phase<5>(p, lds); grid.sync();
    run_phase<6>(p, lds); grid.sync();
    run_phase<7>(p, lds);
}

template <int PH> static void launch_ph(const Params& p, int grid, hipStream_t stream) {
    static bool attr = false;
    if (!attr) { (void)hipFuncSetAttribute((const void*)k_ph<PH>, hipFuncAttributeMaxDynamicSharedMemorySize, LDS_BYTES); attr = true; }
    hipLaunchKernelGGL(k_ph<PH>, dim3(grid), dim3(NT), LDS_BYTES, stream, p);
}

extern "C" void kernel_launch(void* const* d_in, const int* in_sizes, int n_in, void* d_out, int out_size, void* d_ws, size_t ws_size, hipStream_t stream) {
    Params p{};
    p.x = (const float*)d_in[0]; p.c = (const float*)d_in[1]; p.ctx = (const float*)d_in[2]; p.c_ctx = (const float*)d_in[3];
    p.w_ada = (const float*)d_in[4]; p.b_ada = (const float*)d_in[5]; p.w_in = (const float*)d_in[6]; p.decay = (const float*)d_in[7];
    p.gn_w = (const float*)d_in[8]; p.sink = (const float*)d_in[9]; p.w_out = (const float*)d_in[10]; p.fnw = (const float*)d_in[11];
    p.out = (float*)d_out;
    unsigned char* w = (unsigned char*)d_ws; size_t off = 0;
    auto take = [&](size_t bytes) { unsigned char* r = w + off; off += (bytes + 255) & ~(size_t)255; return r; };
    p.mod = (float*)take(9 * 3072 * 4);
    p.tab128 = (float2*)take(64 * 32 * 8);
    p.tab64 = (float2*)take(64 * 16 * 8);
    p.h = (bf16_t*)take((size_t)MROWS * 1024 * 2);
    p.mixed = p.h;
    p.rq = (bf16_t*)take((size_t)32 * 4096 * 128 * 2);
    p.rk = (bf16_t*)take((size_t)32 * KVROWS * 128 * 2);
    p.rv = (bf16_t*)take((size_t)32 * KVROWS * 128 * 2);
    p.rg = (bf16_t*)take((size_t)32768 * 512 * 2);
    p.aq = (bf16_t*)take((size_t)64 * 4096 * 64 * 2);
    p.ak = (bf16_t*)take((size_t)16 * KVROWS * 64 * 2);
    p.av = (bf16_t*)take((size_t)16 * KVROWS * 64 * 2);
    p.ag = (bf16_t*)take((size_t)32768 * 512 * 2);
    p.Kf = (bf16_t*)take((size_t)32 * 34 * 16384 * 2);
    p.Kb = (bf16_t*)take((size_t)32 * 34 * 16384 * 2);
    p.Rf = (bf16_t*)take((size_t)32 * 32 * 16384 * 2);
    p.Rb = (bf16_t*)take((size_t)32 * 32 * 16384 * 2);
    if (off > ws_size) { fprintf(stderr, "kernel_launch: workspace too small (%zu > %zu)\n", off, ws_size); return; }
#if MK_ONE_LAUNCH
    static int grid_blocks = 0;
    if (!grid_blocks) {
        int dev = 0, cus = 0, per_cu = 0;
        (void)hipGetDevice(&dev);
        (void)hipDeviceGetAttribute(&cus, hipDeviceAttributeMultiprocessorCount, dev);
        (void)hipFuncSetAttribute((const void*)k_mega, hipFuncAttributeMaxDynamicSharedMemorySize, LDS_BYTES);
        (void)hipOccupancyMaxActiveBlocksPerMultiprocessor(&per_cu, (const void*)k_mega, NT, LDS_BYTES);
        if (per_cu < 1) per_cu = 1;
        grid_blocks = cus * per_cu;
    }
    void* args[] = {&p};
    hipError_t e = hipLaunchCooperativeKernel((const void*)k_mega, dim3(grid_blocks), dim3(NT), args, LDS_BYTES, stream);
    if (e != hipSuccess) fprintf(stderr, "cooperative launch failed: %s (grid %d)\n", hipGetErrorString(e), grid_blocks);
#else
    const int G = 1024;
    launch_ph<0>(p, G, stream); launch_ph<1>(p, G, stream); launch_ph<2>(p, G, stream); launch_ph<3>(p, G, stream);
    launch_ph<4>(p, G, stream); launch_ph<5>(p, G, stream); launch_ph<6>(p, G, stream); launch_ph<7>(p, G, stream);
#endif
}
```

```cpp
#include <hip/hip_runtime.h>
#include <hip/hip_cooperative_groups.h>
#include <cstdio>
namespace cg = cooperative_groups;

#ifndef MK_ONE_LAUNCH
#define MK_ONE_LAUNCH 1
#endif

typedef unsigned short bf16_t;
#define NT 512
#define MROWS 34816
#define KVROWS 4352
#define LDS_BYTES 131072

struct Params {
    const float *x, *c, *ctx, *c_ctx, *w_ada, *b_ada, *w_in, *decay, *gn_w, *sink, *w_out, *fnw;
    float* out;
    float* mod;
    float2* tab128;
    float2* tab64;
    bf16_t *h, *rq, *rk, *rv, *rg, *aq, *ak, *av, *ag, *Kf, *Kb, *Rf, *Rb, *mixed;
};

__device__ __forceinline__ float bf2f(bf16_t b) { return __uint_as_float(((unsigned)b) << 16); }
__device__ __forceinline__ bf16_t f2bf(float f) { unsigned u = __float_as_uint(f); u += 0x7FFFu + ((u >> 16) & 1u); return (bf16_t)(u >> 16); }
__device__ __forceinline__ unsigned pack2(float lo, float hi) { return (unsigned)f2bf(lo) | ((unsigned)f2bf(hi) << 16); }
__device__ __forceinline__ void store8(bf16_t* dst, const float* o) {
    uint4 u; u.x = pack2(o[0], o[1]); u.y = pack2(o[2], o[3]); u.z = pack2(o[4], o[5]); u.w = pack2(o[6], o[7]);
    *(uint4*)dst = u;
}
__device__ __forceinline__ void load8(const bf16_t* src, float* o) {
    const uint4 u = *(const uint4*)src;
    o[0] = __uint_as_float(u.x << 16); o[1] = __uint_as_float(u.x & 0xffff0000u);
    o[2] = __uint_as_float(u.y << 16); o[3] = __uint_as_float(u.y & 0xffff0000u);
    o[4] = __uint_as_float(u.z << 16); o[5] = __uint_as_float(u.z & 0xffff0000u);
    o[6] = __uint_as_float(u.w << 16); o[7] = __uint_as_float(u.w & 0xffff0000u);
}
__device__ __forceinline__ float silu_f(float v) { return v / (1.f + __expf(-v)); }
__device__ __forceinline__ float wave_sum(float v) {
#pragma unroll
    for (int o = 32; o >= 1; o >>= 1) v += __shfl_xor(v, o);
    return v;
}
__device__ __forceinline__ float lgam(const Params& p, int dir, int h) { return -log1pf(expf(-p.decay[dir * 4 + h])); }

__device__ __forceinline__ int ocol_in(int sg) {
    if (sg < 1024) { const int s = sg & 127; return (sg & ~127) + ((s >> 5) << 4) + (((s >> 3) & 3) << 2) + (s & 3) + (((s >> 2) & 1) << 6); }
    if (sg >= 2048 && sg < 2688) { const int s = sg & 63; return (sg & ~63) + ((s >> 5) << 4) + (((s >> 3) & 3) << 2) + (s & 3) + (((s >> 2) & 1) << 5); }
    return sg;
}

__device__ __forceinline__ void epi_in8(const Params& p, int row, int s0, const float* v) {
    const bool isc = row >= 32768;
    int b, t;
    if (isc) { const int r = row - 32768; b = r >> 8; t = r & 255; } else { b = row >> 12; t = row & 4095; }
    const int gr = (t >> 6) & 63, gc = t & 63;
    float o[8];
    if (s0 < 1024) {
        const bool isk = s0 >= 512;
        if (!isk && isc) return;
        const int head = (s0 >> 7) & 3, s = s0 & 127, wc = s >> 5, fq = (s >> 3) & 3;
        const float scl = isk ? 0.08838834764831845f : 1.f;
        if (isc) {
#pragma unroll
            for (int i = 0; i < 8; ++i) o[i] = v[i] * scl;
        } else {
            const int pos = wc < 2 ? gr : gc;
            const float2* tb = p.tab128 + pos * 32 + (wc & 1) * 16 + fq * 4;
#pragma unroll
            for (int j = 0; j < 4; ++j) { const float2 cs = tb[j]; const float x1 = v[j] * scl, x2 = v[4 + j] * scl; o[j] = x1 * cs.x - x2 * cs.y; o[4 + j] = x1 * cs.y + x2 * cs.x; }
        }
        bf16_t* dst = isk ? p.rk + ((size_t)(b * 4 + head) * KVROWS + (isc ? 4096 + t : t)) * 128 + s
                          : p.rq + ((size_t)(b * 4 + head) * 4096 + t) * 128 + s;
        store8(dst, o);
    } else if (s0 < 1536) {
        const int head = (s0 - 1024) >> 7, s = s0 & 127;
        store8(p.rv + ((size_t)(b * 4 + head) * KVROWS + (isc ? 4096 + t : t)) * 128 + s, v);
    } else if (s0 < 2048) {
        if (isc) return;
#pragma unroll
        for (int i = 0; i < 8; ++i) o[i] = silu_f(v[i]);
        store8(p.rg + (size_t)row * 512 + (s0 - 1536), o);
    } else if (s0 < 2688) {
        const bool isk = s0 >= 2560;
        if (!isk && isc) return;
        const int head = isk ? (s0 - 2560) >> 6 : (s0 - 2048) >> 6, s = s0 & 63, w = s >> 5, fq = (s >> 3) & 3;
        const float scl = isk ? 1.f : 0.125f;
        if (isc) {
#pragma unroll
            for (int i = 0; i < 8; ++i) o[i] = v[i];
        } else {
            const int pos = w == 0 ? gr : gc;
            const float2* tb = p.tab64 + pos * 16 + fq * 4;
#pragma unroll
            for (int j = 0; j < 4; ++j) { const float2 cs = tb[j]; const float x1 = v[j] * scl, x2 = v[4 + j] * scl; o[j] = x1 * cs.x - x2 * cs.y; o[4 + j] = x1 * cs.y + x2 * cs.x; }
        }
        bf16_t* dst = isk ? p.ak + ((size_t)(b * 2 + head) * KVROWS + (isc ? t : 256 + t)) * 64 + s
                          : p.aq + ((size_t)(b * 8 + head) * 4096 + t) * 64 + s;
        store8(dst, o);
    } else if (s0 < 2816) {
        const int head = (s0 - 2688) >> 6, s = s0 & 63;
        store8(p.av + ((size_t)(b * 2 + head) * KVROWS + (isc ? t : 256 + t)) * 64 + s, v);
    } else {
        if (isc) return;
#pragma unroll
        for (int i = 0; i < 8; ++i) o[i] = silu_f(v[i]);
        store8(p.ag + (size_t)row * 512 + (s0 - 2816), o);
    }
}

__device__ void ph_mod(const Params& p, float* lds) {
    if (blockIdx.x < 6) {
        for (int i = threadIdx.x; i < 9 * 1024; i += NT) {
            const int v = i >> 10, k = i & 1023;
            const float cv = v < 8 ? p.c[v * 1024 + k] : p.c_ctx[k];
            lds[i] = cv / (1.f + expf(-cv));
        }
        __syncthreads();
        for (int item = blockIdx.x; item < 6; item += gridDim.x) {
            const int col = item * NT + threadIdx.x;
            float acc[9];
#pragma unroll
            for (int v = 0; v < 9; ++v) acc[v] = 0.f;
            for (int k = 0; k < 1024; ++k) {
                const float w = p.w_ada[(size_t)k * 3072 + col];
#pragma unroll
                for (int v = 0; v < 9; ++v) acc[v] += lds[v * 1024 + k] * w;
            }
            const float bb = p.b_ada[col];
#pragma unroll
            for (int v = 0; v < 9; ++v) p.mod[v * 3072 + col] = acc[v] + bb;
        }
    }
    const int gt = blockIdx.x * NT + threadIdx.x;
    if (gt < 2048) { const int pos = gt >> 5, f = gt & 31; const float a = (float)pos * powf(10000.f, -(float)f / 32.f); p.tab128[gt] = make_float2(cosf(a), sinf(a)); }
    else if (gt < 3072) { const int g2 = gt - 2048, pos = g2 >> 4, f = g2 & 15; const float a = (float)pos * powf(10000.f, -(float)f / 16.f); p.tab64[g2] = make_float2(cosf(a), sinf(a)); }
}

__device__ void ph_h(const Params& p) {
    const int wave = threadIdx.x >> 6, lane = threadIdx.x & 63;
    for (int row = blockIdx.x * 8 + wave; row < MROWS; row += gridDim.x * 8) {
        const float* src; int v;
        if (row < 32768) { src = p.x + (size_t)row * 1024; v = row >> 12; } else { src = p.ctx + (size_t)(row - 32768) * 1024; v = 8; }
        float4 xv[4]; float ss = 0.f;
#pragma unroll
        for (int i = 0; i < 4; ++i) { xv[i] = *(const float4*)(src + i * 256 + lane * 4); ss += xv[i].x * xv[i].x + xv[i].y * xv[i].y + xv[i].z * xv[i].z + xv[i].w * xv[i].w; }
        ss = wave_sum(ss);
        const float rstd = rsqrtf(ss * (1.f / 1024.f) + 1e-6f);
        const float* sh = p.mod + v * 3072; const float* sc = sh + 1024;
#pragma unroll
        for (int i = 0; i < 4; ++i) {
            const int col = i * 256 + lane * 4;
            const float4 s4 = *(const float4*)(sc + col), h4 = *(const float4*)(sh + col);
            uint2 u;
            u.x = pack2(xv[i].x * rstd * (1.f + s4.x) + h4.x, xv[i].y * rstd * (1.f + s4.y) + h4.y);
            u.y = pack2(xv[i].z * rstd * (1.f + s4.z) + h4.z, xv[i].w * rstd * (1.f + s4.w) + h4.w);
            *(uint2*)(p.h + (size_t)row * 1024 + col) = u;
        }
    }
}

template <int MODE> __device__ void ph_gemm_naive(const Params& p, float* lds) {
    const bf16_t* A = MODE == 0 ? p.h : p.mixed;
    const float* Bm = MODE == 0 ? p.w_in : p.w_out;
    constexpr int ldb = MODE == 0 ? 3328 : 1024;
    constexpr int nrt = (MODE == 0 ? MROWS : 32768) / 64, nct = ldb / 128;
    float* As = lds;
    float* Bs = lds + 32 * 65;
    const int tid = threadIdx.x, ty = tid >> 4, tx = tid & 15;
    for (int tile = blockIdx.x; tile < nrt * nct; tile += gridDim.x) {
        const int rt = tile / nct, ct = tile % nct;
        float acc[2][8];
#pragma unroll
        for (int r = 0; r < 2; ++r)
#pragma unroll
            for (int t = 0; t < 8; ++t) acc[r][t] = 0.f;
        int bc[8];
#pragma unroll
        for (int i = 0; i < 8; ++i) { const int cc = (tid + NT * i) & 127; const int sg = ct * 128 + cc; bc[i] = MODE == 0 ? ocol_in(sg) : sg; }
        for (int k0 = 0; k0 < 1024; k0 += 32) {
#pragma unroll
            for (int i = 0; i < 4; ++i) { const int e = tid + NT * i, r = e >> 5, kk = e & 31; As[kk * 65 + r] = bf2f(A[(size_t)(rt * 64 + r) * 1024 + k0 + kk]); }
#pragma unroll
            for (int i = 0; i < 8; ++i) { const int e = tid + NT * i, kk = e >> 7, cc = e & 127; Bs[kk * 129 + cc] = Bm[(size_t)(k0 + kk) * ldb + bc[i]]; }
            __syncthreads();
#pragma unroll 4
            for (int kk = 0; kk < 32; ++kk) {
                const float a0 = As[kk * 65 + ty * 2], a1 = As[kk * 65 + ty * 2 + 1];
#pragma unroll
                for (int t = 0; t < 8; ++t) { const float bv = Bs[kk * 129 + tx * 8 + t]; acc[0][t] += a0 * bv; acc[1][t] += a1 * bv; }
            }
            __syncthreads();
        }
#pragma unroll
        for (int r = 0; r < 2; ++r) {
            const int row = rt * 64 + ty * 2 + r, s0 = ct * 128 + tx * 8;
            if (MODE == 0) epi_in8(p, row, s0, acc[r]);
            else {
                const int b = row >> 12;
                const float* gate = p.mod + b * 3072 + 2048 + s0;
                const float* xr = p.x + (size_t)row * 1024 + s0;
                float* orow = p.out + (size_t)row * 1024 + s0;
#pragma unroll
                for (int t = 0; t < 8; ++t) orow[t] = xr[t] + gate[t] * acc[r][t];
            }
        }
    }
}

__device__ void ph_states_naive(const Params& p) {
    for (int item = blockIdx.x; item < 32 * 34; item += gridDim.x) {
        const int bh = item / 34, c = item % 34, h = bh & 3;
        const float lgf = lgam(p, 0, h), lgb = lgam(p, 1, h);
        const bf16_t* K = p.rk + ((size_t)bh * KVROWS + c * 128) * 128;
        const bf16_t* V = p.rv + ((size_t)bh * KVROWS + c * 128) * 128;
        const int e = threadIdx.x & 127, dg = threadIdx.x >> 7;
        float af[32], ab[32];
#pragma unroll
        for (int i = 0; i < 32; ++i) { af[i] = 0.f; ab[i] = 0.f; }
        for (int j = 0; j < 128; ++j) {
            const float vv = bf2f(V[j * 128 + e]);
            const float wf = expf(lgf * (float)(127 - j)) * vv, wb = expf(lgb * (float)j) * vv;
#pragma unroll
            for (int d8 = 0; d8 < 4; ++d8) {
                float kk[8]; load8(K + j * 128 + dg * 32 + d8 * 8, kk);
#pragma unroll
                for (int i = 0; i < 8; ++i) { af[d8 * 8 + i] += wf * kk[i]; ab[d8 * 8 + i] += wb * kk[i]; }
            }
        }
        bf16_t* of = p.Kf + ((size_t)item * 128 + e) * 128 + dg * 32;
        bf16_t* ob = p.Kb + ((size_t)item * 128 + e) * 128 + dg * 32;
#pragma unroll
        for (int d8 = 0; d8 < 4; ++d8) { store8(of + d8 * 8, af + d8 * 8); store8(ob + d8 * 8, ab + d8 * 8); }
    }
}

__device__ void ph_scan(const Params& p) {
    for (int idx = blockIdx.x * NT + threadIdx.x; idx < 32 * 16384; idx += gridDim.x * NT) {
        const int bh = idx >> 14, el = idx & 16383, h = bh & 3;
        const float gfC = expf(lgam(p, 0, h) * 128.f), gbC = expf(lgam(p, 1, h) * 128.f);
        const bf16_t* kf = p.Kf + (size_t)bh * 34 * 16384 + el;
        const bf16_t* kb = p.Kb + (size_t)bh * 34 * 16384 + el;
        bf16_t* rf = p.Rf + (size_t)bh * 32 * 16384 + el;
        bf16_t* rb = p.Rb + (size_t)bh * 32 * 16384 + el;
        float R = bf2f(kf[32 * 16384]); R = gfC * R + bf2f(kf[33 * 16384]);
        for (int n = 0; n < 32; ++n) { rf[(size_t)n * 16384] = f2bf(R); R = gfC * R + bf2f(kf[(size_t)n * 16384]); }
        R = bf2f(kb[33 * 16384]); R = gbC * R + bf2f(kb[32 * 16384]);
        for (int n = 31; n >= 0; --n) { rb[(size_t)n * 16384] = f2bf(R); R = gbC * R + bf2f(kb[(size_t)n * 16384]); }
    }
}

__device__ void ph_retout_naive(const Params& p, float* S) {
    for (int item = blockIdx.x; item < 1024; item += gridDim.x) {
        const int bh = item >> 5, n = item & 31, b = bh >> 2, h = bh & 3;
        const float lgf = lgam(p, 0, h), lgb = lgam(p, 1, h);
        const bf16_t* Q = p.rq + ((size_t)bh * 4096 + n * 128) * 128;
        const bf16_t* K = p.rk + ((size_t)bh * KVROWS + n * 128) * 128;
        const bf16_t* V = p.rv + ((size_t)bh * KVROWS + n * 128) * 128;
        const bf16_t* RF = p.Rf + (size_t)(bh * 32 + n) * 16384;
        const bf16_t* RB = p.Rb + (size_t)(bh * 32 + n) * 16384;
        const int i = threadIdx.x >> 2, q4 = threadIdx.x & 3;
        for (int jj = 0; jj < 32; ++jj) {
            const int j = q4 * 32 + jj;
            float dot = 0.f;
#pragma unroll 4
            for (int d8 = 0; d8 < 16; ++d8) {
                float a[8], bb[8]; load8(Q + i * 128 + d8 * 8, a); load8(K + j * 128 + d8 * 8, bb);
#pragma unroll
                for (int t = 0; t < 8; ++t) dot += a[t] * bb[t];
            }
            const float dec = j <= i ? expf(lgf * (float)(i - j)) : expf(lgb * (float)(j - i));
            S[i * 128 + ((j + i) & 127)] = dot * dec;
        }
        __syncthreads();
        float y[32];
#pragma unroll
        for (int t = 0; t < 32; ++t) y[t] = 0.f;
        const int e0 = q4 * 32;
        for (int j = 0; j < 128; ++j) {
            const float s = S[i * 128 + ((j + i) & 127)];
#pragma unroll
            for (int e8 = 0; e8 < 4; ++e8) {
                float vv[8]; load8(V + j * 128 + e0 + e8 * 8, vv);
#pragma unroll
                for (int t = 0; t < 8; ++t) y[e8 * 8 + t] += s * vv[t];
            }
        }
        const float cf = expf(lgf * (float)(i + 1)), cb = expf(lgb * (float)(128 - i));
#pragma unroll 1
        for (int d8 = 0; d8 < 16; ++d8) {
            float a[8]; load8(Q + i * 128 + d8 * 8, a);
#pragma unroll
            for (int ee = 0; ee < 32; ++ee) {
                float rf[8], rb[8]; load8(RF + (e0 + ee) * 128 + d8 * 8, rf); load8(RB + (e0 + ee) * 128 + d8 * 8, rb);
                float sf = 0.f, sb = 0.f;
#pragma unroll
                for (int t = 0; t < 8; ++t) { sf += a[t] * rf[t]; sb += a[t] * rb[t]; }
                y[ee] += cf * sf + cb * sb;
            }
        }
        float sum = 0.f;
#pragma unroll
        for (int t = 0; t < 32; ++t) sum += y[t];
        sum += __shfl_xor(sum, 1); sum += __shfl_xor(sum, 2);
        const float mu = sum * (1.f / 128.f);
        float vs = 0.f;
#pragma unroll
        for (int t = 0; t < 32; ++t) { const float dlt = y[t] - mu; vs += dlt * dlt; }
        vs += __shfl_xor(vs, 1); vs += __shfl_xor(vs, 2);
        const float rs = rsqrtf(vs * (1.f / 128.f) + 1e-6f);
        const size_t row = (size_t)b * 4096 + n * 128 + i;
        const int col0 = h * 128 + e0;
#pragma unroll
        for (int e8 = 0; e8 < 4; ++e8) {
            float g[8], o[8]; load8(p.rg + row * 512 + col0 + e8 * 8, g);
#pragma unroll
            for (int t = 0; t < 8; ++t) o[t] = (y[e8 * 8 + t] - mu) * rs * p.gn_w[col0 + e8 * 8 + t] * g[t];
            store8(p.mixed + row * 1024 + col0 + e8 * 8, o);
        }
        __syncthreads();
    }
}

__device__ void ph_attn_naive(const Params& p) {
    for (int idx = blockIdx.x * NT + threadIdx.x; idx < 8 * 8 * 4096; idx += gridDim.x * NT) {
        const int t = idx & 4095, bq = idx >> 12, qh = bq & 7, b = bq >> 3, kvh = qh >> 2;
        float q[64], acc[64];
#pragma unroll
        for (int d8 = 0; d8 < 8; ++d8) load8(p.aq + ((size_t)bq * 4096 + t) * 64 + d8 * 8, q + d8 * 8);
#pragma unroll
        for (int e = 0; e < 64; ++e) acc[e] = 0.f;
        const bf16_t* Kb = p.ak + (size_t)(b * 2 + kvh) * KVROWS * 64;
        const bf16_t* Vb = p.av + (size_t)(b * 2 + kvh) * KVROWS * 64;
        float m = p.sink[qh], l = 1.f;
        const int lo = t - 128 < 0 ? 0 : t - 128, hi = t + 128 > 4095 ? 4095 : t + 128;
        const int nkeys = 256 + (hi - lo + 1);
        for (int kk = 0; kk < nkeys; ++kk) {
            const int krow = kk < 256 ? kk : lo + kk;
            float s = 0.f;
#pragma unroll
            for (int d8 = 0; d8 < 8; ++d8) {
                float kv[8]; load8(Kb + (size_t)krow * 64 + d8 * 8, kv);
#pragma unroll
                for (int i = 0; i < 8; ++i) s += q[d8 * 8 + i] * kv[i];
            }
            if (s > m) {
                const float sc = __expf(m - s); l *= sc;
#pragma unroll
                for (int e = 0; e < 64; ++e) acc[e] *= sc;
                m = s;
            }
            const float pe = __expf(s - m); l += pe;
#pragma unroll
            for (int d8 = 0; d8 < 8; ++d8) {
                float vv[8]; load8(Vb + (size_t)krow * 64 + d8 * 8, vv);
#pragma unroll
                for (int i = 0; i < 8; ++i) acc[d8 * 8 + i] += pe * vv[i];
            }
        }
        const float inv = 1.f / l;
        const size_t row = (size_t)b * 4096 + t;
#pragma unroll
        for (int d8 = 0; d8 < 8; ++d8) {
            float g[8], o[8]; load8(p.ag + row * 512 + qh * 64 + d8 * 8, g);
#pragma unroll
            for (int i = 0; i < 8; ++i) o[i] = acc[d8 * 8 + i] * inv * g[i];
            store8(p.mixed + row * 1024 + 512 + qh * 64 + d8 * 8, o);
        }
    }
}

__device__ void ph_final(const Params& p) {
    const int wave = threadIdx.x >> 6, lane = threadIdx.x & 63;
    for (int row = blockIdx.x * 8 + wave; row < 32768; row += gridDim.x * 8) {
        float* src = p.out + (size_t)row * 1024;
        float4 xv[4]; float ss = 0.f;
#pragma unroll
        for (int i = 0; i < 4; ++i) { xv[i] = *(const float4*)(src + i * 256 + lane * 4); ss += xv[i].x * xv[i].x + xv[i].y * xv[i].y + xv[i].z * xv[i].z + xv[i].w * xv[i].w; }
        ss = wave_sum(ss);
        const float rstd = rsqrtf(ss * (1.f / 1024.f) + 1e-6f);
#pragma unroll
        for (int i = 0; i < 4; ++i) {
            const int col = i * 256 + lane * 4;
            const float4 w4 = *(const float4*)(p.fnw + col);
            float4 o; o.x = xv[i].x * rstd * w4.x; o.y = xv[i].y * rstd * w4.y; o.z = xv[i].z * rstd * w4.z; o.w = xv[i].w * rstd * w4.w;
            *(float4*)(src + col) = o;
        }
    }
}

#define NPHASE 9
template <int PH> __device__ __forceinline__ void run_phase(const Params& p, float* lds) {
    if (PH == 0) ph_mod(p, lds);
    else if (PH == 1) ph_h(p);
    else if (PH == 2) ph_gemm_naive<0>(p, lds);
    else if (PH == 3) { ph_states_naive(p); ph_attn_naive(p); }
    else if (PH == 4) ph_scan(p);
    else if (PH == 5) ph_retout_naive(p, lds);
    else if (PH == 6) ph_gemm_naive<1>(p, lds);
    else if (PH == 7) ph_final(p);
}

template <int PH> __global__ __launch_bounds__(NT) void k_ph(Params p) {
    extern __shared__ __attribute__((aligned(16))) float lds[];
    run_phase<PH>(p, lds);
}

__global__ __launch_bounds__(NT) void k_mega(Params p) {
    extern __shared__ __attribute__((aligned(16))) float lds[];
    cg::grid_group grid = cg::this_grid();
    run_phase<0>(p, lds); grid.sync();
    run_phase<1>(p, lds); grid.sync();
    run_phase<2>(p, lds); grid.sync();
    run_phase<3>(p, lds); grid.sync();
    run_phase<4>(p, lds); grid.sync();
    run_phase<5>(p, lds); grid.sync();
    run_phase<6>(p, lds); grid.sync();
    run_phase<7>(p, lds);
}

template <int PH> static void launch_ph(const Params& p, int grid, hipStream_t stream) {
    static bool attr = false;
    if (!attr) { (void)hipFuncSetAttribute((const void*)k_ph<PH>, hipFuncAttributeMaxDynamicSharedMemorySize, LDS_BYTES); attr = true; }
    hipLaunchKernelGGL(k_ph<PH>, dim3(grid), dim3(NT), LDS_BYTES, stream, p);
}

extern "C" void kernel_launch(void* const* d_in, const int* in_sizes, int n_in, void* d_out, int out_size, void* d_ws, size_t ws_size, hipStream_t stream) {
    Params p{};
    p.x = (const float*)d_in[0]; p.c = (const float*)d_in[1]; p.ctx = (const float*)d_in[2]; p.c_ctx = (const float*)d_in[3];
    p.w_ada = (const float*)d_in[4]; p.b_ada = (const float*)d_in[5]; p.w_in = (const float*)d_in[6]; p.decay = (const float*)d_in[7];
    p.gn_w = (const float*)d_in[8]; p.sink = (const float*)d_in[9]; p.w_out = (const float*)d_in[10]; p.fnw = (const float*)d_in[11];
    p.out = (float*)d_out;
    unsigned char* w = (unsigned char*)d_ws; size_t off = 0;
    auto take = [&](size_t bytes) { unsigned char* r = w + off; off += (bytes + 255) & ~(size_t)255; return r; };
    p.mod = (float*)take(9 * 3072 * 4);
    p.tab128 = (float2*)take(64 * 32 * 8);
    p.tab64 = (float2*)take(64 * 16 * 8);
    p.h = (bf16_t*)take((size_t)MROWS * 1024 * 2);
    p.mixed = p.h;
    p.rq = (bf16_t*)take((size_t)32 * 4096 * 128 * 2);
    p.rk = (bf16_t*)take((size_t)32 * KVROWS * 128 * 2);
    p.rv = (bf16_t*)take((size_t)32 * KVROWS * 128 * 2);
    p.rg = (bf16_t*)take((size_t)32768 * 512 * 2);
    p.aq = (bf16_t*)take((size_t)64 * 4096 * 64 * 2);
    p.ak = (bf16_t*)take((size_t)16 * KVROWS * 64 * 2);
    p.av = (bf16_t*)take((size_t)16 * KVROWS * 64 * 2);
    p.ag = (bf16_t*)take((size_t)32768 * 512 * 2);
    p.Kf = (bf16_t*)take((size_t)32 * 34 * 16384 * 2);
    p.Kb = (bf16_t*)take((size_t)32 * 34 * 16384 * 2);
    p.Rf = (bf16_t*)take((size_t)32 * 32 * 16384 * 2);
    p.Rb = (bf16_t*)take((size_t)32 * 32 * 16384 * 2);
    if (off > ws_size) { fprintf(stderr, "kernel_launch: workspace too small (%zu > %zu)\n", off, ws_size); return; }
#if MK_ONE_LAUNCH
    static int grid_blocks = 0;
    if (!grid_blocks) {
        int dev = 0, cus = 0, per_cu = 0;
        (void)hipGetDevice(&dev);
        (void)hipDeviceGetAttribute(&cus, hipDeviceAttributeMultiprocessorCount, dev);
        (void)hipFuncSetAttribute((const void*)k_mega, hipFuncAttributeMaxDynamicSharedMemorySize, LDS_BYTES);
        (void)hipOccupancyMaxActiveBlocksPerMultiprocessor(&per_cu, (const void*)k_mega, NT, LDS_BYTES);
        if (per_cu < 1) per_cu = 1;
        grid_blocks = cus * per_cu;
    }
    void* args[] = {&p};
    hipError_t e = hipLaunchCooperativeKernel((const void*)k_mega, dim3(grid_blocks), dim3(NT), args, LDS_BYTES, stream);
    if (e != hipSuccess) fprintf(stderr, "cooperative launch failed: %s (grid %d)\n", hipGetErrorString(e), grid_blocks);
#else
    const int G = 1024;
    launch_ph<0>(p, G, stream); launch_ph<1>(p, G, stream); launch_ph<2>(p, G, stream); launch_ph<3>(p, G, stream);
    launch_ph<4>(p, G, stream); launch_ph<5>(p, G, stream); launch_ph<6>(p, G, stream); launch_ph<7>(p, G, stream);
#endif
}
```

```cpp
#include <hip/hip_runtime.h>
#include <hip/hip_cooperative_groups.h>
#include <cstdio>
namespace cg = cooperative_groups;

#ifndef MK_ONE_LAUNCH
#define MK_ONE_LAUNCH 1
#endif

typedef unsigned short bf16_t;
#define NT 512
#define MROWS 34816
#define KVROWS 4352
#define LDS_BYTES 131072

struct Params {
    const float *x, *c, *ctx, *c_ctx, *w_ada, *b_ada, *w_in, *decay, *gn_w, *sink, *w_out, *fnw;
    float* out;
    float* mod;
    float2* tab128;
    float2* tab64;
    bf16_t *h, *rq, *rk, *rv, *rg, *aq, *ak, *av, *ag, *Kf, *Kb, *Rf, *Rb, *mixed, *WinT, *WoutT;
};

__device__ __forceinline__ float bf2f(bf16_t b) { return __uint_as_float(((unsigned)b) << 16); }
__device__ __forceinline__ bf16_t f2bf(float f) { unsigned u = __float_as_uint(f); u += 0x7FFFu + ((u >> 16) & 1u); return (bf16_t)(u >> 16); }
__device__ __forceinline__ unsigned pack2(float lo, float hi) { return (unsigned)f2bf(lo) | ((unsigned)f2bf(hi) << 16); }
__device__ __forceinline__ void store8(bf16_t* dst, const float* o) {
    uint4 u; u.x = pack2(o[0], o[1]); u.y = pack2(o[2], o[3]); u.z = pack2(o[4], o[5]); u.w = pack2(o[6], o[7]);
    *(uint4*)dst = u;
}
__device__ __forceinline__ void load8(const bf16_t* src, float* o) {
    const uint4 u = *(const uint4*)src;
    o[0] = __uint_as_float(u.x << 16); o[1] = __uint_as_float(u.x & 0xffff0000u);
    o[2] = __uint_as_float(u.y << 16); o[3] = __uint_as_float(u.y & 0xffff0000u);
    o[4] = __uint_as_float(u.z << 16); o[5] = __uint_as_float(u.z & 0xffff0000u);
    o[6] = __uint_as_float(u.w << 16); o[7] = __uint_as_float(u.w & 0xffff0000u);
}
__device__ __forceinline__ float silu_f(float v) { return v / (1.f + __expf(-v)); }
__device__ __forceinline__ float wave_sum(float v) {
#pragma unroll
    for (int o = 32; o >= 1; o >>= 1) v += __shfl_xor(v, o);
    return v;
}
__device__ __forceinline__ float lgam(const Params& p, int dir, int h) { return -log1pf(expf(-p.decay[dir * 4 + h])); }

__device__ __forceinline__ int ocol_in(int sg) {
    if (sg < 1024) { const int s = sg & 127; return (sg & ~127) + ((s >> 5) << 4) + (((s >> 3) & 3) << 2) + (s & 3) + (((s >> 2) & 1) << 6); }
    if (sg >= 2048 && sg < 2688) { const int s = sg & 63; return (sg & ~63) + ((s >> 5) << 4) + (((s >> 3) & 3) << 2) + (s & 3) + (((s >> 2) & 1) << 5); }
    return sg;
}

__device__ __forceinline__ void epi_in8(const Params& p, int row, int s0, const float* v) {
    const bool isc = row >= 32768;
    int b, t;
    if (isc) { const int r = row - 32768; b = r >> 8; t = r & 255; } else { b = row >> 12; t = row & 4095; }
    const int gr = (t >> 6) & 63, gc = t & 63;
    float o[8];
    if (s0 < 1024) {
        const bool isk = s0 >= 512;
        if (!isk && isc) return;
        const int head = (s0 >> 7) & 3, s = s0 & 127, wc = s >> 5, fq = (s >> 3) & 3;
        const float scl = isk ? 0.08838834764831845f : 1.f;
        if (isc) {
#pragma unroll
            for (int i = 0; i < 8; ++i) o[i] = v[i] * scl;
        } else {
            const int pos = wc < 2 ? gr : gc;
            const float2* tb = p.tab128 + pos * 32 + (wc & 1) * 16 + fq * 4;
#pragma unroll
            for (int j = 0; j < 4; ++j) { const float2 cs = tb[j]; const float x1 = v[j] * scl, x2 = v[4 + j] * scl; o[j] = x1 * cs.x - x2 * cs.y; o[4 + j] = x1 * cs.y + x2 * cs.x; }
        }
        bf16_t* dst = isk ? p.rk + ((size_t)(b * 4 + head) * KVROWS + (isc ? 4096 + t : t)) * 128 + s
                          : p.rq + ((size_t)(b * 4 + head) * 4096 + t) * 128 + s;
        store8(dst, o);
    } else if (s0 < 1536) {
        const int head = (s0 - 1024) >> 7, s = s0 & 127;
        store8(p.rv + ((size_t)(b * 4 + head) * KVROWS + (isc ? 4096 + t : t)) * 128 + s, v);
    } else if (s0 < 2048) {
        if (isc) return;
#pragma unroll
        for (int i = 0; i < 8; ++i) o[i] = silu_f(v[i]);
        store8(p.rg + (size_t)row * 512 + (s0 - 1536), o);
    } else if (s0 < 2688) {
        const bool isk = s0 >= 2560;
        if (!isk && isc) return;
        const int head = isk ? (s0 - 2560) >> 6 : (s0 - 2048) >> 6, s = s0 & 63, w = s >> 5, fq = (s >> 3) & 3;
        const float scl = isk ? 1.f : 0.125f;
        if (isc) {
#pragma unroll
            for (int i = 0; i < 8; ++i) o[i] = v[i];
        } else {
            const int pos = w == 0 ? gr : gc;
            const float2* tb = p.tab64 + pos * 16 + fq * 4;
#pragma unroll
            for (int j = 0; j < 4; ++j) { const float2 cs = tb[j]; const float x1 = v[j] * scl, x2 = v[4 + j] * scl; o[j] = x1 * cs.x - x2 * cs.y; o[4 + j] = x1 * cs.y + x2 * cs.x; }
        }
        bf16_t* dst = isk ? p.ak + ((size_t)(b * 2 + head) * KVROWS + (isc ? t : 256 + t)) * 64 + s
                          : p.aq + ((size_t)(b * 8 + head) * 4096 + t) * 64 + s;
        store8(dst, o);
    } else if (s0 < 2816) {
        const int head = (s0 - 2688) >> 6, s = s0 & 63;
        store8(p.av + ((size_t)(b * 2 + head) * KVROWS + (isc ? t : 256 + t)) * 64 + s, v);
    } else {
        if (isc) return;
#pragma unroll
        for (int i = 0; i < 8; ++i) o[i] = silu_f(v[i]);
        store8(p.ag + (size_t)row * 512 + (s0 - 2816), o);
    }
}

__device__ void ph_mod(const Params& p, float* lds) {
    if (blockIdx.x < 6) {
        for (int i = threadIdx.x; i < 9 * 1024; i += NT) {
            const int v = i >> 10, k = i & 1023;
            const float cv = v < 8 ? p.c[v * 1024 + k] : p.c_ctx[k];
            lds[i] = cv / (1.f + expf(-cv));
        }
        __syncthreads();
        for (int item = blockIdx.x; item < 6; item += gridDim.x) {
            const int col = item * NT + threadIdx.x;
            float acc[9];
#pragma unroll
            for (int v = 0; v < 9; ++v) acc[v] = 0.f;
            for (int k = 0; k < 1024; ++k) {
                const float w = p.w_ada[(size_t)k * 3072 + col];
#pragma unroll
                for (int v = 0; v < 9; ++v) acc[v] += lds[v * 1024 + k] * w;
            }
            const float bb = p.b_ada[col];
#pragma unroll
            for (int v = 0; v < 9; ++v) p.mod[v * 3072 + col] = acc[v] + bb;
        }
    }
    const int gt = blockIdx.x * NT + threadIdx.x;
    if (gt < 2048) { const int pos = gt >> 5, f = gt & 31; const float a = (float)pos * powf(10000.f, -(float)f / 32.f); p.tab128[gt] = make_float2(cosf(a), sinf(a)); }
    else if (gt < 3072) { const int g2 = gt - 2048, pos = g2 >> 4, f = g2 & 15; const float a = (float)pos * powf(10000.f, -(float)f / 16.f); p.tab64[g2] = make_float2(cosf(a), sinf(a)); }
}

__device__ void ph_h(const Params& p) {
    const int wave = threadIdx.x >> 6, lane = threadIdx.x & 63;
    for (int row = blockIdx.x * 8 + wave; row < MROWS; row += gridDim.x * 8) {
        const float* src; int v;
        if (row < 32768) { src = p.x + (size_t)row * 1024; v = row >> 12; } else { src = p.ctx + (size_t)(row - 32768) * 1024; v = 8; }
        float4 xv[4]; float ss = 0.f;
#pragma unroll
        for (int i = 0; i < 4; ++i) { xv[i] = *(const float4*)(src + i * 256 + lane * 4); ss += xv[i].x * xv[i].x + xv[i].y * xv[i].y + xv[i].z * xv[i].z + xv[i].w * xv[i].w; }
        ss = wave_sum(ss);
        const float rstd = rsqrtf(ss * (1.f / 1024.f) + 1e-6f);
        const float* sh = p.mod + v * 3072; const float* sc = sh + 1024;
#pragma unroll
        for (int i = 0; i < 4; ++i) {
            const int col = i * 256 + lane * 4;
            const float4 s4 = *(const float4*)(sc + col), h4 = *(const float4*)(sh + col);
            uint2 u;
            u.x = pack2(xv[i].x * rstd * (1.f + s4.x) + h4.x, xv[i].y * rstd * (1.f + s4.y) + h4.y);
            u.y = pack2(xv[i].z * rstd * (1.f + s4.z) + h4.z, xv[i].w * rstd * (1.f + s4.w) + h4.w);
            *(uint2*)(p.h + (size_t)row * 1024 + col) = u;
        }
    }
}

template <int MODE> __device__ void ph_gemm_naive(const Params& p, float* lds) {
    const bf16_t* A = MODE == 0 ? p.h : p.mixed;
    const float* Bm = MODE == 0 ? p.w_in : p.w_out;
    constexpr int ldb = MODE == 0 ? 3328 : 1024;
    constexpr int nrt = (MODE == 0 ? MROWS : 32768) / 64, nct = ldb / 128;
    float* As = lds;
    float* Bs = lds + 32 * 65;
    const int tid = threadIdx.x, ty = tid >> 4, tx = tid & 15;
    for (int tile = blockIdx.x; tile < nrt * nct; tile += gridDim.x) {
        const int rt = tile / nct, ct = tile % nct;
        float acc[2][8];
#pragma unroll
        for (int r = 0; r < 2; ++r)
#pragma unroll
            for (int t = 0; t < 8; ++t) acc[r][t] = 0.f;
        int bc[8];
#pragma unroll
        for (int i = 0; i < 8; ++i) { const int cc = (tid + NT * i) & 127; const int sg = ct * 128 + cc; bc[i] = MODE == 0 ? ocol_in(sg) : sg; }
        for (int k0 = 0; k0 < 1024; k0 += 32) {
#pragma unroll
            for (int i = 0; i < 4; ++i) { const int e = tid + NT * i, r = e >> 5, kk = e & 31; As[kk * 65 + r] = bf2f(A[(size_t)(rt * 64 + r) * 1024 + k0 + kk]); }
#pragma unroll
            for (int i = 0; i < 8; ++i) { const int e = tid + NT * i, kk = e >> 7, cc = e & 127; Bs[kk * 129 + cc] = Bm[(size_t)(k0 + kk) * ldb + bc[i]]; }
            __syncthreads();
#pragma unroll 4
            for (int kk = 0; kk < 32; ++kk) {
                const float a0 = As[kk * 65 + ty * 2], a1 = As[kk * 65 + ty * 2 + 1];
#pragma unroll
                for (int t = 0; t < 8; ++t) { const float bv = Bs[kk * 129 + tx * 8 + t]; acc[0][t] += a0 * bv; acc[1][t] += a1 * bv; }
            }
            __syncthreads();
        }
#pragma unroll
        for (int r = 0; r < 2; ++r) {
            const int row = rt * 64 + ty * 2 + r, s0 = ct * 128 + tx * 8;
            if (MODE == 0) epi_in8(p, row, s0, acc[r]);
            else {
                const int b = row >> 12;
                const float* gate = p.mod + b * 3072 + 2048 + s0;
                const float* xr = p.x + (size_t)row * 1024 + s0;
                float* orow = p.out + (size_t)row * 1024 + s0;
#pragma unroll
                for (int t = 0; t < 8; ++t) orow[t] = xr[t] + gate[t] * acc[r][t];
            }
        }
    }
}


__device__ void ph_wconv(const Params& p, float* lds) {
    const int tid = threadIdx.x;
    for (int item = blockIdx.x; item < 544; item += gridDim.x) {
        const bool isin = item < 416; const int it = isin ? item : item - 416;
        const int win = it >> 4, kb = it & 15; const int ld = isin ? 3328 : 1024;
        const float* W = (isin ? p.w_in : p.w_out) + (size_t)(kb * 64) * ld + win * 128;
#pragma unroll
        for (int i = 0; i < 16; ++i) { const int e = tid + NT * i, k = e >> 7, c = e & 127; lds[k * 129 + c] = W[(size_t)k * ld + c]; }
        __syncthreads();
#pragma unroll
        for (int i = 0; i < 2; ++i) {
            const int e = tid + NT * i, pp = e >> 3, k8 = e & 7;
            const int pglob = win * 128 + pp;
            int col = pp;
            if (isin) {
                const int pos = pglob & 255;
                const int slot = (pos & ~31) | (((pos >> 2) & 3) << 3) | (((pos >> 4) & 1) << 2) | (pos & 3);
                col = ocol_in((pglob & ~255) + slot) - win * 128;
            }
            float o[8];
#pragma unroll
            for (int t = 0; t < 8; ++t) o[t] = lds[(k8 * 8 + t) * 129 + col];
            store8((isin ? p.WinT : p.WoutT) + (size_t)pglob * 1024 + kb * 64 + k8 * 8, o);
        }
        __syncthreads();
    }
}

namespace pg8 {
#define PG8_LAS __attribute__((address_space(3)))
typedef short bf16x8 __attribute__((ext_vector_type(8)));
typedef float f32x4 __attribute__((ext_vector_type(4)));
constexpr int BM = 256, BK = 64, HALF = 128, HTB = HALF * BK * 2, STAGE_BYTES = 8 * HTB, NXCD = 8, WGM = 8;
__device__ __forceinline__ int lds_byte(int r, int c) { const int st = (r >> 4) * 2 + (c >> 5), rr = r & 15, cc = c & 31, ob = rr * 64 + cc * 2; return st * 1024 + (ob ^ (((ob >> 9) & 1) << 5)); }
__device__ __forceinline__ void stage_rc(int b, int& R, int& C) { const int st = b / 1024, sb = b % 1024, swz = sb ^ (((sb >> 9) & 1) << 5); R = (st >> 1) * 16 + swz / 64; C = (st & 1) * 32 + (swz % 64) / 2; }
struct Unit { int pm, pn; };
struct Gemm { const bf16_t* A; const bf16_t* Bt; int K; };
__device__ __forceinline__ void static_unit(int wgid, int nM, int nN, Unit& u) {
    const int nwg = nM * nN;
    { const int q = nwg / NXCD, r = nwg % NXCD, xcd = wgid % NXCD, off = wgid / NXCD; wgid = (xcd < r ? xcd * (q + 1) : r * (q + 1) + (xcd - r) * q) + off; }
    const int nig = WGM * nN, gid = wgid / nig, fm = gid * WGM, gsz = (nM - fm) < WGM ? (nM - fm) : WGM;
    u.pm = fm + ((wgid % nig) % gsz); u.pn = (wgid % nig) / gsz;
}
struct SchedIn {
    int G, c;
    __device__ __forceinline__ bool next(int i, Unit& u) const {
        const int L = i * G + c;
        if (L < 1664) { static_unit(L, 128, 13, u); return true; }
        if (L < 1704) { const int q = L - 1664, r = q % 5; u.pm = 128 + q / 5; u.pn = r < 4 ? 2 + r : 10; return true; }
        return false;
    }
};
struct SchedOut {
    int G, c;
    __device__ __forceinline__ bool next(int i, Unit& u) const {
        const int L = i * G + c;
        if (L < 512) { static_unit(L, 128, 4, u); return true; }
        return false;
    }
};
struct EpiIn {
    const Params* p;
    __device__ __forceinline__ void operator()(const f32x4 (&acc)[2][2][4][2], const Unit& u, int wr, int wc, int fr, int fq) const {
#pragma unroll
        for (int ai = 0; ai < 2; ++ai)
#pragma unroll
            for (int m = 0; m < 4; ++m) {
                const int row = u.pm * BM + ai * HALF + wr * 64 + m * 16 + fr;
#pragma unroll
                for (int bj = 0; bj < 2; ++bj) {
                    const int s0 = u.pn * BM + bj * HALF + wc * 32 + fq * 8;
                    float v[8];
#pragma unroll
                    for (int j = 0; j < 4; ++j) { v[j] = acc[ai][bj][m][0][j]; v[4 + j] = acc[ai][bj][m][1][j]; }
                    epi_in8(*p, row, s0, v);
                }
            }
    }
};
struct EpiOut {
    const Params* p;
    __device__ __forceinline__ void operator()(const f32x4 (&acc)[2][2][4][2], const Unit& u, int wr, int wc, int fr, int fq) const {
        const int b = (u.pm * BM) >> 12;
        f32x4 gv[2][2];
#pragma unroll
        for (int bj = 0; bj < 2; ++bj)
#pragma unroll
            for (int n = 0; n < 2; ++n) gv[bj][n] = *(const f32x4*)(p->mod + b * 3072 + 2048 + u.pn * BM + bj * HALF + wc * 32 + n * 16 + fq * 4);
#pragma unroll
        for (int ai = 0; ai < 2; ++ai)
#pragma unroll
            for (int m = 0; m < 4; ++m) {
                const size_t rowoff = (size_t)(u.pm * BM + ai * HALF + wr * 64 + m * 16 + fr) * 1024 + u.pn * BM + wc * 32 + fq * 4;
#pragma unroll
                for (int bj = 0; bj < 2; ++bj)
#pragma unroll
                    for (int n = 0; n < 2; ++n) {
                        const f32x4 xv = *(const f32x4*)(p->x + rowoff + bj * HALF + n * 16);
                        *(f32x4*)(p->out + rowoff + bj * HALF + n * 16) = xv + gv[bj][n] * acc[ai][bj][m][n];
                    }
            }
    }
};

template <class Epi, class Sched>
__device__ __forceinline__ void gemm_phase(PG8_LAS unsigned char* lds, const Gemm g, const Sched& S, const Epi& E) {
    const int tid = threadIdx.x, wid = __builtin_amdgcn_readfirstlane(tid >> 6), lane = tid & 63, wr = wid >> 2, wc = wid & 3, fr = lane & 15, fq = lane >> 4;
    const int K = g.K, nt = K / BK;
    unsigned voffA[2];
#pragma unroll
    for (int i = 0; i < 2; ++i) { int R, C; stage_rc(tid * 16 + i * 8192, R, C); voffA[i] = (unsigned)(R * K + C) * 2u; }
    const size_t kstep = (size_t)(BK * 2);
    const size_t hstep = (size_t)HALF * K * 2;
    const size_t tstep = 2 * hstep;
    const unsigned ldsw = (unsigned)wid * 1024u;
    const int aoff = lds_byte(wr * 64 + fr, fq * 8), boff = lds_byte(wc * 32 + fr, fq * 8);
#define PG8_SA(b, h) (((b) * 2 + (h)) * HTB)
#define PG8_SB(b, h) ((4 + (b) * 2 + (h)) * HTB)
#define PG8_STAGE(bufoff, gbase) do { _Pragma("unroll") for (int _i = 0; _i < 2; ++_i) \
        __builtin_amdgcn_global_load_lds((const unsigned*)((const char*)(gbase) + voffA[_i]), (PG8_LAS unsigned*)(lds + (bufoff) + ldsw + _i * 8192), 16, 0, 0); } while (0)
#define PG8_LDA(dst, b, h) do { _Pragma("unroll") for (int m = 0; m < 4; ++m) _Pragma("unroll") for (int k = 0; k < 2; ++k) dst[m][k] = *(const PG8_LAS bf16x8*)(lds + PG8_SA(b, h) + aoff + m * 2048 + k * 1024); } while (0)
#define PG8_LDB(dst, b, h) do { _Pragma("unroll") for (int n = 0; n < 2; ++n) _Pragma("unroll") for (int k = 0; k < 2; ++k) dst[n][k] = *(const PG8_LAS bf16x8*)(lds + PG8_SB(b, h) + boff + n * 2048 + k * 1024); } while (0)
#define PG8_MMA(ai, bj, At, Bt) do { __builtin_amdgcn_s_setprio(1); _Pragma("unroll") for (int m = 0; m < 4; ++m) _Pragma("unroll") for (int n = 0; n < 2; ++n) _Pragma("unroll") for (int k = 0; k < 2; ++k) \
        acc[ai][bj][m][n] = __builtin_amdgcn_mfma_f32_16x16x32_bf16(Bt[n][k], At[m][k], acc[ai][bj][m][n], 0, 0, 0); __builtin_amdgcn_s_setprio(0); } while (0)
#define PG8_WAIT_V(n) asm volatile("s_waitcnt vmcnt(" #n ")" ::: "memory")
#define PG8_WAIT_L(n) asm volatile("s_waitcnt lgkmcnt(" #n ")" ::: "memory")
#define PG8_BAR __builtin_amdgcn_s_barrier()
#define PG8_SCHED __builtin_amdgcn_sched_barrier(0)
    Unit cur, nxt; int ui = 0;
    if (!S.next(0, cur)) return;
    f32x4 acc[2][2][4][2];
#pragma unroll
    for (int a = 0; a < 2; ++a)
#pragma unroll
        for (int b = 0; b < 2; ++b)
#pragma unroll
            for (int m = 0; m < 4; ++m)
#pragma unroll
                for (int n = 0; n < 2; ++n) acc[a][b][m][n] = (f32x4){0.f, 0.f, 0.f, 0.f};
    bf16x8 At[4][2], B0[2][2], B1[2][2];
    const char* cA = (const char*)g.A + (size_t)cur.pm * tstep; const char* cB = (const char*)g.Bt + (size_t)cur.pn * tstep;
    PG8_STAGE(PG8_SB(0, 0), cB); PG8_STAGE(PG8_SA(0, 0), cA); PG8_STAGE(PG8_SB(0, 1), cB + hstep); PG8_STAGE(PG8_SA(0, 1), cA + hstep);
    if (wr == 1) PG8_BAR;
    PG8_WAIT_V(4); PG8_BAR;
    PG8_STAGE(PG8_SB(1, 0), cB + kstep); PG8_STAGE(PG8_SA(1, 0), cA + kstep); PG8_STAGE(PG8_SB(1, 1), cB + hstep + kstep);
    PG8_WAIT_V(6); PG8_BAR;
    for (;;) {
        const bool has_next = S.next(ui + 1, nxt);
        const char* nA = has_next ? (const char*)g.A + (size_t)nxt.pm * tstep : cA; const char* nB = has_next ? (const char*)g.Bt + (size_t)nxt.pn * tstep : cB;
        for (int t = 0; t < nt; t += 2) {
            const bool last = (t == nt - 2);
            const char* a1 = cA + (size_t)(t + 1) * kstep;
            const char* a2 = last ? nA : cA + (size_t)(t + 2) * kstep; const char* b2 = last ? nB : cB + (size_t)(t + 2) * kstep;
            const char* a3 = a2 + kstep; const char* b3 = b2 + kstep;
            PG8_LDB(B0, 0, 0); PG8_SCHED; PG8_LDA(At, 0, 0); PG8_STAGE(PG8_SA(1, 1), a1 + hstep);
            PG8_WAIT_L(8); PG8_BAR; PG8_WAIT_L(0); PG8_MMA(0, 0, At, B0); PG8_BAR; PG8_SCHED;
            PG8_LDB(B1, 0, 1); PG8_STAGE(PG8_SB(0, 0), b2);
            PG8_BAR; PG8_WAIT_L(0); PG8_MMA(0, 1, At, B1); PG8_BAR;
            PG8_LDA(At, 0, 1); PG8_STAGE(PG8_SA(0, 0), a2);
            PG8_BAR; PG8_WAIT_L(0); PG8_MMA(1, 0, At, B0); PG8_BAR; PG8_SCHED;
            PG8_STAGE(PG8_SB(0, 1), b2 + hstep);
            PG8_WAIT_V(6); PG8_BAR; PG8_MMA(1, 1, At, B1); PG8_BAR;
            PG8_LDB(B0, 1, 0); PG8_SCHED; PG8_LDA(At, 1, 0); PG8_STAGE(PG8_SA(0, 1), a2 + hstep);
            PG8_WAIT_L(8); PG8_BAR; PG8_WAIT_L(0); PG8_MMA(0, 0, At, B0); PG8_BAR; PG8_SCHED;
            PG8_LDB(B1, 1, 1); PG8_STAGE(PG8_SB(1, 0), b3);
            PG8_BAR; PG8_WAIT_L(0); PG8_MMA(0, 1, At, B1); PG8_BAR;
            PG8_LDA(At, 1, 1); PG8_STAGE(PG8_SA(1, 0), a3);
            PG8_BAR; PG8_WAIT_L(0); PG8_MMA(1, 0, At, B0); PG8_BAR; PG8_SCHED;
            PG8_STAGE(PG8_SB(1, 1), b3 + hstep);
            PG8_WAIT_V(6); PG8_BAR; PG8_MMA(1, 1, At, B1); PG8_BAR;
        }
        E(acc, cur, wr, wc, fr, fq);
        if (!has_next) break;
#pragma unroll
        for (int a = 0; a < 2; ++a)
#pragma unroll
            for (int b = 0; b < 2; ++b)
#pragma unroll
                for (int m = 0; m < 4; ++m)
#pragma unroll
                    for (int n = 0; n < 2; ++n) acc[a][b][m][n] = (f32x4){0.f, 0.f, 0.f, 0.f};
        cur = nxt; cA = nA; cB = nB; ++ui;
    }
    PG8_WAIT_V(0);
    if (wr == 0) PG8_BAR;
    PG8_BAR;
#undef PG8_SA
#undef PG8_SB
#undef PG8_STAGE
#undef PG8_LDA
#undef PG8_LDB
#undef PG8_MMA
#undef PG8_WAIT_V
#undef PG8_WAIT_L
#undef PG8_BAR
#undef PG8_SCHED
}
}

__device__ __forceinline__ void ph_gemm_in(const Params& p, float* lds) {
    pg8::Gemm g{p.h, p.WinT, 1024}; pg8::SchedIn S{(int)gridDim.x, (int)blockIdx.x}; pg8::EpiIn E{&p};
    pg8::gemm_phase(( PG8_LAS unsigned char*)lds, g, S, E);
}
__device__ __forceinline__ void ph_gemm_out(const Params& p, float* lds) {
    pg8::Gemm g{p.mixed, p.WoutT, 1024}; pg8::SchedOut S{(int)gridDim.x, (int)blockIdx.x}; pg8::EpiOut E{&p};
    pg8::gemm_phase((PG8_LAS unsigned char*)lds, g, S, E);
}

__device__ void ph_states_naive(const Params& p) {
    for (int item = blockIdx.x; item < 32 * 34; item += gridDim.x) {
        const int bh = item / 34, c = item % 34, h = bh & 3;
        const float lgf = lgam(p, 0, h), lgb = lgam(p, 1, h);
        const bf16_t* K = p.rk + ((size_t)bh * KVROWS + c * 128) * 128;
        const bf16_t* V = p.rv + ((size_t)bh * KVROWS + c * 128) * 128;
        const int e = threadIdx.x & 127, dg = threadIdx.x >> 7;
        float af[32], ab[32];
#pragma unroll
        for (int i = 0; i < 32; ++i) { af[i] = 0.f; ab[i] = 0.f; }
        for (int j = 0; j < 128; ++j) {
            const float vv = bf2f(V[j * 128 + e]);
            const float wf = expf(lgf * (float)(127 - j)) * vv, wb = expf(lgb * (float)j) * vv;
#pragma unroll
            for (int d8 = 0; d8 < 4; ++d8) {
                float kk[8]; load8(K + j * 128 + dg * 32 + d8 * 8, kk);
#pragma unroll
                for (int i = 0; i < 8; ++i) { af[d8 * 8 + i] += wf * kk[i]; ab[d8 * 8 + i] += wb * kk[i]; }
            }
        }
        bf16_t* of = p.Kf + ((size_t)item * 128 + e) * 128 + dg * 32;
        bf16_t* ob = p.Kb + ((size_t)item * 128 + e) * 128 + dg * 32;
#pragma unroll
        for (int d8 = 0; d8 < 4; ++d8) { store8(of + d8 * 8, af + d8 * 8); store8(ob + d8 * 8, ab + d8 * 8); }
    }
}

__device__ void ph_scan(const Params& p) {
    for (int idx = blockIdx.x * NT + threadIdx.x; idx < 32 * 16384; idx += gridDim.x * NT) {
        const int bh = idx >> 14, el = idx & 16383, h = bh & 3;
        const float gfC = expf(lgam(p, 0, h) * 128.f), gbC = expf(lgam(p, 1, h) * 128.f);
        const bf16_t* kf = p.Kf + (size_t)bh * 34 * 16384 + el;
        const bf16_t* kb = p.Kb + (size_t)bh * 34 * 16384 + el;
        bf16_t* rf = p.Rf + (size_t)bh * 32 * 16384 + el;
        bf16_t* rb = p.Rb + (size_t)bh * 32 * 16384 + el;
        float R = bf2f(kf[32 * 16384]); R = gfC * R + bf2f(kf[33 * 16384]);
        for (int n = 0; n < 32; ++n) { rf[(size_t)n * 16384] = f2bf(R); R = gfC * R + bf2f(kf[(size_t)n * 16384]); }
        R = bf2f(kb[33 * 16384]); R = gbC * R + bf2f(kb[32 * 16384]);
        for (int n = 31; n >= 0; --n) { rb[(size_t)n * 16384] = f2bf(R); R = gbC * R + bf2f(kb[(size_t)n * 16384]); }
    }
}

__device__ void ph_retout_naive(const Params& p, float* S) {
    for (int item = blockIdx.x; item < 1024; item += gridDim.x) {
        const int bh = item >> 5, n = item & 31, b = bh >> 2, h = bh & 3;
        const float lgf = lgam(p, 0, h), lgb = lgam(p, 1, h);
        const bf16_t* Q = p.rq + ((size_t)bh * 4096 + n * 128) * 128;
        const bf16_t* K = p.rk + ((size_t)bh * KVROWS + n * 128) * 128;
        const bf16_t* V = p.rv + ((size_t)bh * KVROWS + n * 128) * 128;
        const bf16_t* RF = p.Rf + (size_t)(bh * 32 + n) * 16384;
        const bf16_t* RB = p.Rb + (size_t)(bh * 32 + n) * 16384;
        const int i = threadIdx.x >> 2, q4 = threadIdx.x & 3;
        for (int jj = 0; jj < 32; ++jj) {
            const int j = q4 * 32 + jj;
            float dot = 0.f;
#pragma unroll 4
            for (int d8 = 0; d8 < 16; ++d8) {
                float a[8], bb[8]; load8(Q + i * 128 + d8 * 8, a); load8(K + j * 128 + d8 * 8, bb);
#pragma unroll
                for (int t = 0; t < 8; ++t) dot += a[t] * bb[t];
            }
            const float dec = j <= i ? expf(lgf * (float)(i - j)) : expf(lgb * (float)(j - i));
            S[i * 128 + ((j + i) & 127)] = dot * dec;
        }
        __syncthreads();
        float y[32];
#pragma unroll
        for (int t = 0; t < 32; ++t) y[t] = 0.f;
        const int e0 = q4 * 32;
        for (int j = 0; j < 128; ++j) {
            const float s = S[i * 128 + ((j + i) & 127)];
#pragma unroll
            for (int e8 = 0; e8 < 4; ++e8) {
                float vv[8]; load8(V + j * 128 + e0 + e8 * 8, vv);
#pragma unroll
                for (int t = 0; t < 8; ++t) y[e8 * 8 + t] += s * vv[t];
            }
        }
        const float cf = expf(lgf * (float)(i + 1)), cb = expf(lgb * (float)(128 - i));
#pragma unroll 1
        for (int d8 = 0; d8 < 16; ++d8) {
            float a[8]; load8(Q + i * 128 + d8 * 8, a);
#pragma unroll
            for (int ee = 0; ee < 32; ++ee) {
                float rf[8], rb[8]; load8(RF + (e0 + ee) * 128 + d8 * 8, rf); load8(RB + (e0 + ee) * 128 + d8 * 8, rb);
                float sf = 0.f, sb = 0.f;
#pragma unroll
                for (int t = 0; t < 8; ++t) { sf += a[t] * rf[t]; sb += a[t] * rb[t]; }
                y[ee] += cf * sf + cb * sb;
            }
        }
        float sum = 0.f;
#pragma unroll
        for (int t = 0; t < 32; ++t) sum += y[t];
        sum += __shfl_xor(sum, 1); sum += __shfl_xor(sum, 2);
        const float mu = sum * (1.f / 128.f);
        float vs = 0.f;
#pragma unroll
        for (int t = 0; t < 32; ++t) { const float dlt = y[t] - mu; vs += dlt * dlt; }
        vs += __shfl_xor(vs, 1); vs += __shfl_xor(vs, 2);
        const float rs = rsqrtf(vs * (1.f / 128.f) + 1e-6f);
        const size_t row = (size_t)b * 4096 + n * 128 + i;
        const int col0 = h * 128 + e0;
#pragma unroll
        for (int e8 = 0; e8 < 4; ++e8) {
            float g[8], o[8]; load8(p.rg + row * 512 + col0 + e8 * 8, g);
#pragma unroll
            for (int t = 0; t < 8; ++t) o[t] = (y[e8 * 8 + t] - mu) * rs * p.gn_w[col0 + e8 * 8 + t] * g[t];
            store8(p.mixed + row * 1024 + col0 + e8 * 8, o);
        }
        __syncthreads();
    }
}

__device__ void ph_attn_naive(const Params& p) {
    for (int idx = blockIdx.x * NT + threadIdx.x; idx < 8 * 8 * 4096; idx += gridDim.x * NT) {
        const int t = idx & 4095, bq = idx >> 12, qh = bq & 7, b = bq >> 3, kvh = qh >> 2;
        float q[64], acc[64];
#pragma unroll
        for (int d8 = 0; d8 < 8; ++d8) load8(p.aq + ((size_t)bq * 4096 + t) * 64 + d8 * 8, q + d8 * 8);
#pragma unroll
        for (int e = 0; e < 64; ++e) acc[e] = 0.f;
        const bf16_t* Kb = p.ak + (size_t)(b * 2 + kvh) * KVROWS * 64;
        const bf16_t* Vb = p.av + (size_t)(b * 2 + kvh) * KVROWS * 64;
        float m = p.sink[qh], l = 1.f;
        const int lo = t - 128 < 0 ? 0 : t - 128, hi = t + 128 > 4095 ? 4095 : t + 128;
        const int nkeys = 256 + (hi - lo + 1);
        for (int kk = 0; kk < nkeys; ++kk) {
            const int krow = kk < 256 ? kk : lo + kk;
            float s = 0.f;
#pragma unroll
            for (int d8 = 0; d8 < 8; ++d8) {
                float kv[8]; load8(Kb + (size_t)krow * 64 + d8 * 8, kv);
#pragma unroll
                for (int i = 0; i < 8; ++i) s += q[d8 * 8 + i] * kv[i];
            }
            if (s > m) {
                const float sc = __expf(m - s); l *= sc;
#pragma unroll
                for (int e = 0; e < 64; ++e) acc[e] *= sc;
                m = s;
            }
            const float pe = __expf(s - m); l += pe;
#pragma unroll
            for (int d8 = 0; d8 < 8; ++d8) {
                float vv[8]; load8(Vb + (size_t)krow * 64 + d8 * 8, vv);
#pragma unroll
                for (int i = 0; i < 8; ++i) acc[d8 * 8 + i] += pe * vv[i];
            }
        }
        const float inv = 1.f / l;
        const size_t row = (size_t)b * 4096 + t;
#pragma unroll
        for (int d8 = 0; d8 < 8; ++d8) {
            float g[8], o[8]; load8(p.ag + row * 512 + qh * 64 + d8 * 8, g);
#pragma unroll
            for (int i = 0; i < 8; ++i) o[i] = acc[d8 * 8 + i] * inv * g[i];
            store8(p.mixed + row * 1024 + 512 + qh * 64 + d8 * 8, o);
        }
    }
}

__device__ void ph_final(const Params& p) {
    const int wave = threadIdx.x >> 6, lane = threadIdx.x & 63;
    for (int row = blockIdx.x * 8 + wave; row < 32768; row += gridDim.x * 8) {
        float* src = p.out + (size_t)row * 1024;
        float4 xv[4]; float ss = 0.f;
#pragma unroll
        for (int i = 0; i < 4; ++i) { xv[i] = *(const float4*)(src + i * 256 + lane * 4); ss += xv[i].x * xv[i].x + xv[i].y * xv[i].y + xv[i].z * xv[i].z + xv[i].w * xv[i].w; }
        ss = wave_sum(ss);
        const float rstd = rsqrtf(ss * (1.f / 1024.f) + 1e-6f);
#pragma unroll
        for (int i = 0; i < 4; ++i) {
            const int col = i * 256 + lane * 4;
            const float4 w4 = *(const float4*)(p.fnw + col);
            float4 o; o.x = xv[i].x * rstd * w4.x; o.y = xv[i].y * rstd * w4.y; o.z = xv[i].z * rstd * w4.z; o.w = xv[i].w * rstd * w4.w;
            *(float4*)(src + col) = o;
        }
    }
}

#define NPHASE 9
template <int PH> __device__ __forceinline__ void run_phase(const Params& p, float* lds) {
    if (PH == 0) { ph_mod(p, lds); __syncthreads(); ph_wconv(p, lds); }
    else if (PH == 1) ph_h(p);
    else if (PH == 2) ph_gemm_in(p, lds);
    else if (PH == 3) { ph_states_naive(p); ph_attn_naive(p); }
    else if (PH == 4) ph_scan(p);
    else if (PH == 5) ph_retout_naive(p, lds);
    else if (PH == 6) ph_gemm_out(p, lds);
    else if (PH == 7) ph_final(p);
}

template <int PH> __global__ __launch_bounds__(NT) void k_ph(Params p) {
    extern __shared__ __attribute__((aligned(16))) float lds[];
    run_phase<PH>(p, lds);
}

__global__ __launch_bounds__(NT) void k_mega(Params p) {
    extern __shared__ __attribute__((aligned(16))) float lds[];
    cg::grid_group grid = cg::this_grid();
    run_phase<0>(p, lds); grid.sync();
    run_phase<1>(p, lds); grid.sync();
    run_phase<2>(p, lds); grid.sync();
    run_phase<3>(p, lds); grid.sync();
    run_phase<4>(p, lds); grid.sync();
    run_phase<5>(p, lds); grid.sync();
    run_phase<6>(p, lds); grid.sync();
    run_phase<7>(p, lds);
}

template <int PH> static void launch_ph(const Params& p, int grid, hipStream_t stream) {
    static bool attr = false;
    if (!attr) { (void)hipFuncSetAttribute((const void*)k_ph<PH>, hipFuncAttributeMaxDynamicSharedMemorySize, LDS_BYTES); attr = true; }
    hipLaunchKernelGGL(k_ph<PH>, dim3(grid), dim3(NT), LDS_BYTES, stream, p);
}

extern "C" void kernel_launch(void* const* d_in, const int* in_sizes, int n_in, void* d_out, int out_size, void* d_ws, size_t ws_size, hipStream_t stream) {
    Params p{};
    p.x = (const float*)d_in[0]; p.c = (const float*)d_in[1]; p.ctx = (const float*)d_in[2]; p.c_ctx = (const float*)d_in[3];
    p.w_ada = (const float*)d_in[4]; p.b_ada = (const float*)d_in[5]; p.w_in = (const float*)d_in[6]; p.decay = (const float*)d_in[7];
    p.gn_w = (const float*)d_in[8]; p.sink = (const float*)d_in[9]; p.w_out = (const float*)d_in[10]; p.fnw = (const float*)d_in[11];
    p.out = (float*)d_out;
    unsigned char* w = (unsigned char*)d_ws; size_t off = 0;
    auto take = [&](size_t bytes) { unsigned char* r = w + off; off += (bytes + 255) & ~(size_t)255; return r; };
    p.mod = (float*)take(9 * 3072 * 4);
    p.tab128 = (float2*)take(64 * 32 * 8);
    p.tab64 = (float2*)take(64 * 16 * 8);
    p.h = (bf16_t*)take((size_t)MROWS * 1024 * 2);
    p.mixed = p.h;
    p.rq = (bf16_t*)take((size_t)32 * 4096 * 128 * 2);
    p.rk = (bf16_t*)take((size_t)32 * KVROWS * 128 * 2);
    p.rv = (bf16_t*)take((size_t)32 * KVROWS * 128 * 2);
    p.rg = (bf16_t*)take((size_t)32768 * 512 * 2);
    p.aq = (bf16_t*)take((size_t)64 * 4096 * 64 * 2);
    p.ak = (bf16_t*)take((size_t)16 * KVROWS * 64 * 2);
    p.av = (bf16_t*)take((size_t)16 * KVROWS * 64 * 2);
    p.ag = (bf16_t*)take((size_t)32768 * 512 * 2);
    p.Kf = (bf16_t*)take((size_t)32 * 34 * 16384 * 2);
    p.Kb = (bf16_t*)take((size_t)32 * 34 * 16384 * 2);
    p.Rf = (bf16_t*)take((size_t)32 * 32 * 16384 * 2);
    p.Rb = (bf16_t*)take((size_t)32 * 32 * 16384 * 2);
    p.WinT = (bf16_t*)take((size_t)3328 * 1024 * 2);
    p.WoutT = (bf16_t*)take((size_t)1024 * 1024 * 2);
    if (off > ws_size) { fprintf(stderr, "kernel_launch: workspace too small (%zu > %zu)\n", off, ws_size); return; }
#if MK_ONE_LAUNCH
    static int grid_blocks = 0;
    if (!grid_blocks) {
        int dev = 0, cus = 0, per_cu = 0;
        (void)hipGetDevice(&dev);
        (void)hipDeviceGetAttribute(&cus, hipDeviceAttributeMultiprocessorCount, dev);
        (void)hipFuncSetAttribute((const void*)k_mega, hipFuncAttributeMaxDynamicSharedMemorySize, LDS_BYTES);
        (void)hipOccupancyMaxActiveBlocksPerMultiprocessor(&per_cu, (const void*)k_mega, NT, LDS_BYTES);
        if (per_cu < 1) per_cu = 1;
        grid_blocks = cus * per_cu;
    }
    void* args[] = {&p};
    hipError_t e = hipLaunchCooperativeKernel((const void*)k_mega, dim3(grid_blocks), dim3(NT), args, LDS_BYTES, stream);
    if (e != hipSuccess) fprintf(stderr, "cooperative launch failed: %s (grid %d)\n", hipGetErrorString(e), grid_blocks);
#else
    const int G = 1024;
    launch_ph<0>(p, G, stream); launch_ph<1>(p, G, stream); launch_ph<2>(p, G, stream); launch_ph<3>(p, G, stream);
    launch_ph<4>(p, G, stream); launch_ph<5>(p, G, stream); launch_ph<6>(p, G, stream); launch_ph<7>(p, G, stream);
#endif
}
```

```cpp
#include <hip/hip_runtime.h>
#include <hip/hip_cooperative_groups.h>
#include <cstdio>
namespace cg = cooperative_groups;

#ifndef MK_ONE_LAUNCH
#define MK_ONE_LAUNCH 1
#endif

typedef unsigned short bf16_t;
#define NT 512
#define MROWS 34816
#define KVROWS 4352
#define LDS_BYTES 131072

struct Params {
    const float *x, *c, *ctx, *c_ctx, *w_ada, *b_ada, *w_in, *decay, *gn_w, *sink, *w_out, *fnw;
    float* out;
    float* mod;
    float2* tab128;
    float2* tab64;
    bf16_t *h, *rq, *rk, *rv, *rg, *aq, *ak, *av, *ag, *Kf, *Kb, *Rf, *Rb, *mixed, *WinT, *WoutT;
};

__device__ __forceinline__ int otid() { int t = threadIdx.x; asm volatile("" : "+v"(t)); return t; }
__device__ __forceinline__ float bf2f(bf16_t b) { return __uint_as_float(((unsigned)b) << 16); }
__device__ __forceinline__ bf16_t f2bf(float f) { unsigned u = __float_as_uint(f); u += 0x7FFFu + ((u >> 16) & 1u); return (bf16_t)(u >> 16); }
typedef __bf16 bf2_t __attribute__((ext_vector_type(2)));
typedef float fl2_t __attribute__((ext_vector_type(2)));
__device__ __forceinline__ unsigned pack2(float lo, float hi) { fl2_t v = {lo, hi}; bf2_t b = __builtin_convertvector(v, bf2_t); return *(unsigned*)&b; }
__device__ __forceinline__ void store8(bf16_t* dst, const float* o) {
    uint4 u; u.x = pack2(o[0], o[1]); u.y = pack2(o[2], o[3]); u.z = pack2(o[4], o[5]); u.w = pack2(o[6], o[7]);
    *(uint4*)dst = u;
}
__device__ __forceinline__ void load8(const bf16_t* src, float* o) {
    const uint4 u = *(const uint4*)src;
    o[0] = __uint_as_float(u.x << 16); o[1] = __uint_as_float(u.x & 0xffff0000u);
    o[2] = __uint_as_float(u.y << 16); o[3] = __uint_as_float(u.y & 0xffff0000u);
    o[4] = __uint_as_float(u.z << 16); o[5] = __uint_as_float(u.z & 0xffff0000u);
    o[6] = __uint_as_float(u.w << 16); o[7] = __uint_as_float(u.w & 0xffff0000u);
}
__device__ __forceinline__ float silu_f(float v) { return v / (1.f + __expf(-v)); }
__device__ __forceinline__ float wave_sum(float v) {
#pragma unroll
    for (int o = 32; o >= 1; o >>= 1) v += __shfl_xor(v, o);
    return v;
}
__device__ __forceinline__ float lgam(const Params& p, int dir, int h) { return -log1pf(expf(-p.decay[dir * 4 + h])); }

__device__ __forceinline__ int ocol_in(int sg) {
    if (sg < 1024) { const int s = sg & 127; return (sg & ~127) + ((s >> 5) << 4) + (((s >> 3) & 3) << 2) + (s & 3) + (((s >> 2) & 1) << 6); }
    if (sg >= 2048 && sg < 2688) { const int s = sg & 63; return (sg & ~63) + ((s >> 5) << 4) + (((s >> 3) & 3) << 2) + (s & 3) + (((s >> 2) & 1) << 5); }
    return sg;
}

__device__ __forceinline__ void epi_in8(const Params& p, int row, int s0, const float* v) {
    const bool isc = row >= 32768;
    int b, t;
    if (isc) { const int r = row - 32768; b = r >> 8; t = r & 255; } else { b = row >> 12; t = row & 4095; }
    const int gr = (t >> 6) & 63, gc = t & 63;
    float o[8];
    if (s0 < 1024) {
        const bool isk = s0 >= 512;
        if (!isk && isc) return;
        const int head = (s0 >> 7) & 3, s = s0 & 127, wc = s >> 5, fq = (s >> 3) & 3;
        const float scl = isk ? 0.08838834764831845f : 1.f;
        if (isc) {
#pragma unroll
            for (int i = 0; i < 8; ++i) o[i] = v[i] * scl;
        } else {
            const int pos = wc < 2 ? gr : gc;
            const float2* tb = p.tab128 + pos * 32 + (wc & 1) * 16 + fq * 4;
#pragma unroll
            for (int j = 0; j < 4; ++j) { const float2 cs = tb[j]; const float x1 = v[j] * scl, x2 = v[4 + j] * scl; o[j] = x1 * cs.x - x2 * cs.y; o[4 + j] = x1 * cs.y + x2 * cs.x; }
        }
        bf16_t* dst = isk ? p.rk + ((size_t)(b * 4 + head) * KVROWS + (isc ? 4096 + t : t)) * 128 + s
                          : p.rq + ((size_t)(b * 4 + head) * 4096 + t) * 128 + s;
        store8(dst, o);
    } else if (s0 < 1536) {
        const int head = (s0 - 1024) >> 7, s = s0 & 127;
        store8(p.rv + ((size_t)(b * 4 + head) * KVROWS + (isc ? 4096 + t : t)) * 128 + s, v);
    } else if (s0 < 2048) {
        if (isc) return;
#pragma unroll
        for (int i = 0; i < 8; ++i) o[i] = silu_f(v[i]);
        store8(p.rg + (size_t)row * 512 + (s0 - 1536), o);
    } else if (s0 < 2688) {
        const bool isk = s0 >= 2560;
        if (!isk && isc) return;
        const int head = isk ? (s0 - 2560) >> 6 : (s0 - 2048) >> 6, s = s0 & 63, w = s >> 5, fq = (s >> 3) & 3;
        const float scl = isk ? 1.f : 0.125f;
        if (isc) {
#pragma unroll
            for (int i = 0; i < 8; ++i) o[i] = v[i];
        } else {
            const int pos = w == 0 ? gr : gc;
            const float2* tb = p.tab64 + pos * 16 + fq * 4;
#pragma unroll
            for (int j = 0; j < 4; ++j) { const float2 cs = tb[j]; const float x1 = v[j] * scl, x2 = v[4 + j] * scl; o[j] = x1 * cs.x - x2 * cs.y; o[4 + j] = x1 * cs.y + x2 * cs.x; }
        }
        bf16_t* dst = isk ? p.ak + ((size_t)(b * 2 + head) * KVROWS + (isc ? t : 256 + t)) * 64 + s
                          : p.aq + ((size_t)(b * 8 + head) * 4096 + t) * 64 + s;
        store8(dst, o);
    } else if (s0 < 2816) {
        const int head = (s0 - 2688) >> 6, s = s0 & 63;
        store8(p.av + ((size_t)(b * 2 + head) * KVROWS + (isc ? t : 256 + t)) * 64 + s, v);
    } else {
        if (isc) return;
#pragma unroll
        for (int i = 0; i < 8; ++i) o[i] = silu_f(v[i]);
        store8(p.ag + (size_t)row * 512 + (s0 - 2816), o);
    }
}

__device__ void ph_mod(const Params& p, float* lds) {
    if (blockIdx.x < 6) {
        for (int i = threadIdx.x; i < 9 * 1024; i += NT) {
            const int v = i >> 10, k = i & 1023;
            const float cv = v < 8 ? p.c[v * 1024 + k] : p.c_ctx[k];
            lds[i] = cv / (1.f + expf(-cv));
        }
        __syncthreads();
        for (int item = blockIdx.x; item < 6; item += gridDim.x) {
            const int col = item * NT + threadIdx.x;
            float acc[9];
#pragma unroll
            for (int v = 0; v < 9; ++v) acc[v] = 0.f;
            for (int k = 0; k < 1024; ++k) {
                const float w = p.w_ada[(size_t)k * 3072 + col];
#pragma unroll
                for (int v = 0; v < 9; ++v) acc[v] += lds[v * 1024 + k] * w;
            }
            const float bb = p.b_ada[col];
#pragma unroll
            for (int v = 0; v < 9; ++v) p.mod[v * 3072 + col] = acc[v] + bb;
        }
    }
    const int gt = blockIdx.x * NT + threadIdx.x;
    if (gt < 2048) { const int pos = gt >> 5, f = gt & 31; const float a = (float)pos * powf(10000.f, -(float)f / 32.f); p.tab128[gt] = make_float2(cosf(a), sinf(a)); }
    else if (gt < 3072) { const int g2 = gt - 2048, pos = g2 >> 4, f = g2 & 15; const float a = (float)pos * powf(10000.f, -(float)f / 16.f); p.tab64[g2] = make_float2(cosf(a), sinf(a)); }
}

__device__ void ph_h(const Params& p) {
    const int tid = otid(), wave = tid >> 6, lane = tid & 63;
    for (int row = blockIdx.x * 8 + wave; row < MROWS; row += gridDim.x * 8) {
        const float* src; int v;
        if (row < 32768) { src = p.x + (size_t)row * 1024; v = row >> 12; } else { src = p.ctx + (size_t)(row - 32768) * 1024; v = 8; }
        float4 xv[4]; float ss = 0.f;
#pragma unroll
        for (int i = 0; i < 4; ++i) { xv[i] = *(const float4*)(src + i * 256 + lane * 4); ss += xv[i].x * xv[i].x + xv[i].y * xv[i].y + xv[i].z * xv[i].z + xv[i].w * xv[i].w; }
        ss = wave_sum(ss);
        const float rstd = rsqrtf(ss * (1.f / 1024.f) + 1e-6f);
        const float* sh = p.mod + v * 3072; const float* sc = sh + 1024;
#pragma unroll
        for (int i = 0; i < 4; ++i) {
            const int col = i * 256 + lane * 4;
            const float4 s4 = *(const float4*)(sc + col), h4 = *(const float4*)(sh + col);
            uint2 u;
            u.x = pack2(xv[i].x * rstd * (1.f + s4.x) + h4.x, xv[i].y * rstd * (1.f + s4.y) + h4.y);
            u.y = pack2(xv[i].z * rstd * (1.f + s4.z) + h4.z, xv[i].w * rstd * (1.f + s4.w) + h4.w);
            *(uint2*)(p.h + (size_t)row * 1024 + col) = u;
        }
    }
}

template <int MODE> __device__ void ph_gemm_naive(const Params& p, float* lds) {
    const bf16_t* A = MODE == 0 ? p.h : p.mixed;
    const float* Bm = MODE == 0 ? p.w_in : p.w_out;
    constexpr int ldb = MODE == 0 ? 3328 : 1024;
    constexpr int nrt = (MODE == 0 ? MROWS : 32768) / 64, nct = ldb / 128;
    float* As = lds;
    float* Bs = lds + 32 * 65;
    const int tid = threadIdx.x, ty = tid >> 4, tx = tid & 15;
    for (int tile = blockIdx.x; tile < nrt * nct; tile += gridDim.x) {
        const int rt = tile / nct, ct = tile % nct;
        float acc[2][8];
#pragma unroll
        for (int r = 0; r < 2; ++r)
#pragma unroll
            for (int t = 0; t < 8; ++t) acc[r][t] = 0.f;
        int bc[8];
#pragma unroll
        for (int i = 0; i < 8; ++i) { const int cc = (tid + NT * i) & 127; const int sg = ct * 128 + cc; bc[i] = MODE == 0 ? ocol_in(sg) : sg; }
        for (int k0 = 0; k0 < 1024; k0 += 32) {
#pragma unroll
            for (int i = 0; i < 4; ++i) { const int e = tid + NT * i, r = e >> 5, kk = e & 31; As[kk * 65 + r] = bf2f(A[(size_t)(rt * 64 + r) * 1024 + k0 + kk]); }
#pragma unroll
            for (int i = 0; i < 8; ++i) { const int e = tid + NT * i, kk = e >> 7, cc = e & 127; Bs[kk * 129 + cc] = Bm[(size_t)(k0 + kk) * ldb + bc[i]]; }
            __syncthreads();
#pragma unroll 4
            for (int kk = 0; kk < 32; ++kk) {
                const float a0 = As[kk * 65 + ty * 2], a1 = As[kk * 65 + ty * 2 + 1];
#pragma unroll
                for (int t = 0; t < 8; ++t) { const float bv = Bs[kk * 129 + tx * 8 + t]; acc[0][t] += a0 * bv; acc[1][t] += a1 * bv; }
            }
            __syncthreads();
        }
#pragma unroll
        for (int r = 0; r < 2; ++r) {
            const int row = rt * 64 + ty * 2 + r, s0 = ct * 128 + tx * 8;
            if (MODE == 0) epi_in8(p, row, s0, acc[r]);
            else {
                const int b = row >> 12;
                const float* gate = p.mod + b * 3072 + 2048 + s0;
                const float* xr = p.x + (size_t)row * 1024 + s0;
                float* orow = p.out + (size_t)row * 1024 + s0;
#pragma unroll
                for (int t = 0; t < 8; ++t) orow[t] = xr[t] + gate[t] * acc[r][t];
            }
        }
    }
}


__device__ void ph_wconv(const Params& p, float* lds) {
    const int tid = otid();
    for (int item = blockIdx.x; item < 544; item += gridDim.x) {
        const bool isin = item < 416; const int it = isin ? item : item - 416;
        const int win = it >> 4, kb = it & 15; const int ld = isin ? 3328 : 1024;
        const float* W = (isin ? p.w_in : p.w_out) + (size_t)(kb * 64) * ld + win * 128;
#pragma unroll
        for (int i = 0; i < 16; ++i) { const int e = tid + NT * i, k = e >> 7, c = e & 127; lds[k * 129 + c] = W[(size_t)k * ld + c]; }
        __syncthreads();
#pragma unroll
        for (int i = 0; i < 2; ++i) {
            const int e = tid + NT * i, pp = e >> 3, k8 = e & 7;
            const int pglob = win * 128 + pp;
            int col = pp;
            if (isin) {
                const int pos = pglob & 255;
                const int slot = (pos & ~31) | (((pos >> 2) & 3) << 3) | (((pos >> 4) & 1) << 2) | (pos & 3);
                col = ocol_in((pglob & ~255) + slot) - win * 128;
            }
            float o[8];
#pragma unroll
            for (int t = 0; t < 8; ++t) o[t] = lds[(k8 * 8 + t) * 129 + col];
            store8((isin ? p.WinT : p.WoutT) + (size_t)pglob * 1024 + kb * 64 + k8 * 8, o);
        }
        __syncthreads();
    }
}

namespace pg8 {
#define PG8_LAS __attribute__((address_space(3)))
typedef short bf16x8 __attribute__((ext_vector_type(8)));
typedef float f32x4 __attribute__((ext_vector_type(4)));
constexpr int BM = 256, BK = 64, HALF = 128, HTB = HALF * BK * 2, STAGE_BYTES = 8 * HTB, NXCD = 8, WGM = 8;
__device__ __forceinline__ int lds_byte(int r, int c) { const int st = (r >> 4) * 2 + (c >> 5), rr = r & 15, cc = c & 31, ob = rr * 64 + cc * 2; return st * 1024 + (ob ^ (((ob >> 9) & 1) << 5)); }
__device__ __forceinline__ void stage_rc(int b, int& R, int& C) { const int st = b / 1024, sb = b % 1024, swz = sb ^ (((sb >> 9) & 1) << 5); R = (st >> 1) * 16 + swz / 64; C = (st & 1) * 32 + (swz % 64) / 2; }
struct Unit { int pm, pn; };
struct Gemm { const bf16_t* A; const bf16_t* Bt; int K; };
__device__ __forceinline__ void static_unit(int wgid, int nM, int nN, Unit& u) {
    const int nwg = nM * nN;
    { const int q = nwg / NXCD, r = nwg % NXCD, xcd = wgid % NXCD, off = wgid / NXCD; wgid = (xcd < r ? xcd * (q + 1) : r * (q + 1) + (xcd - r) * q) + off; }
    const int nig = WGM * nN, gid = wgid / nig, fm = gid * WGM, gsz = (nM - fm) < WGM ? (nM - fm) : WGM;
    u.pm = fm + ((wgid % nig) % gsz); u.pn = (wgid % nig) / gsz;
}
struct SchedIn {
    int G, c;
    __device__ __forceinline__ bool next(int i, Unit& u) const {
        const int L = i * G + c;
        if (L < 1664) { static_unit(L, 128, 13, u); return true; }
        if (L < 1704) { const int q = L - 1664, r = q % 5; u.pm = 128 + q / 5; u.pn = r < 4 ? 2 + r : 10; return true; }
        return false;
    }
};
struct SchedOut {
    int G, c;
    __device__ __forceinline__ bool next(int i, Unit& u) const {
        const int L = i * G + c;
        if (L < 512) { static_unit(L, 128, 4, u); return true; }
        return false;
    }
};
struct EpiIn {
    const Params* p;
    __device__ __forceinline__ void operator()(const f32x4 (&acc)[2][2][4][2], const Unit& u, int wr, int wc, int fr, int fq) const {
#pragma unroll
        for (int ai = 0; ai < 2; ++ai)
#pragma unroll
            for (int m = 0; m < 4; ++m) {
                const int row = u.pm * BM + ai * HALF + wr * 64 + m * 16 + fr;
#pragma unroll
                for (int bj = 0; bj < 2; ++bj) {
                    const int s0 = u.pn * BM + bj * HALF + wc * 32 + fq * 8;
                    float v[8];
#pragma unroll
                    for (int j = 0; j < 4; ++j) { v[j] = acc[ai][bj][m][0][j]; v[4 + j] = acc[ai][bj][m][1][j]; }
                    epi_in8(*p, row, s0, v);
                }
            }
    }
};
struct EpiOut {
    const Params* p;
    __device__ __forceinline__ void operator()(const f32x4 (&acc)[2][2][4][2], const Unit& u, int wr, int wc, int fr, int fq) const {
        const int b = (u.pm * BM) >> 12;
        f32x4 gv[2][2];
#pragma unroll
        for (int bj = 0; bj < 2; ++bj)
#pragma unroll
            for (int n = 0; n < 2; ++n) gv[bj][n] = *(const f32x4*)(p->mod + b * 3072 + 2048 + u.pn * BM + bj * HALF + wc * 32 + n * 16 + fq * 4);
#pragma unroll
        for (int ai = 0; ai < 2; ++ai)
#pragma unroll
            for (int m = 0; m < 4; ++m) {
                const size_t rowoff = (size_t)(u.pm * BM + ai * HALF + wr * 64 + m * 16 + fr) * 1024 + u.pn * BM + wc * 32 + fq * 4;
#pragma unroll
                for (int bj = 0; bj < 2; ++bj)
#pragma unroll
                    for (int n = 0; n < 2; ++n) {
                        const f32x4 xv = *(const f32x4*)(p->x + rowoff + bj * HALF + n * 16);
                        *(f32x4*)(p->out + rowoff + bj * HALF + n * 16) = xv + gv[bj][n] * acc[ai][bj][m][n];
                    }
            }
    }
};

template <class Epi, class Sched>
__device__ __forceinline__ void gemm_phase(PG8_LAS unsigned char* lds, const Gemm g, const Sched& S, const Epi& E) {
    const int tid = otid(), wid = __builtin_amdgcn_readfirstlane(tid >> 6), lane = tid & 63, wr = wid >> 2, wc = wid & 3, fr = lane & 15, fq = lane >> 4;
    const int K = g.K, nt = K / BK;
    unsigned voffA[2];
#pragma unroll
    for (int i = 0; i < 2; ++i) { int R, C; stage_rc(tid * 16 + i * 8192, R, C); voffA[i] = (unsigned)(R * K + C) * 2u; }
    const size_t kstep = (size_t)(BK * 2);
    const size_t hstep = (size_t)HALF * K * 2;
    const size_t tstep = 2 * hstep;
    const unsigned ldsw = (unsigned)wid * 1024u;
    const int aoff = lds_byte(wr * 64 + fr, fq * 8), boff = lds_byte(wc * 32 + fr, fq * 8);
#define PG8_SA(b, h) (((b) * 2 + (h)) * HTB)
#define PG8_SB(b, h) ((4 + (b) * 2 + (h)) * HTB)
#define PG8_STAGE(bufoff, gbase) do { _Pragma("unroll") for (int _i = 0; _i < 2; ++_i) \
        __builtin_amdgcn_global_load_lds((const unsigned*)((const char*)(gbase) + voffA[_i]), (PG8_LAS unsigned*)(lds + (bufoff) + ldsw + _i * 8192), 16, 0, 0); } while (0)
#define PG8_LDA(dst, b, h) do { _Pragma("unroll") for (int m = 0; m < 4; ++m) _Pragma("unroll") for (int k = 0; k < 2; ++k) dst[m][k] = *(const PG8_LAS bf16x8*)(lds + PG8_SA(b, h) + aoff + m * 2048 + k * 1024); } while (0)
#define PG8_LDB(dst, b, h) do { _Pragma("unroll") for (int n = 0; n < 2; ++n) _Pragma("unroll") for (int k = 0; k < 2; ++k) dst[n][k] = *(const PG8_LAS bf16x8*)(lds + PG8_SB(b, h) + boff + n * 2048 + k * 1024); } while (0)
#define PG8_MMA(ai, bj, At, Bt) do { __builtin_amdgcn_s_setprio(1); _Pragma("unroll") for (int m = 0; m < 4; ++m) _Pragma("unroll") for (int n = 0; n < 2; ++n) _Pragma("unroll") for (int k = 0; k < 2; ++k) \
        acc[ai][bj][m][n] = __builtin_amdgcn_mfma_f32_16x16x32_bf16(Bt[n][k], At[m][k], acc[ai][bj][m][n], 0, 0, 0); __builtin_amdgcn_s_setprio(0); } while (0)
#define PG8_WAIT_V(n) asm volatile("s_waitcnt vmcnt(" #n ")" ::: "memory")
#define PG8_WAIT_L(n) asm volatile("s_waitcnt lgkmcnt(" #n ")" ::: "memory")
#define PG8_BAR __builtin_amdgcn_s_barrier()
#define PG8_SCHED __builtin_amdgcn_sched_barrier(0)
    Unit cur, nxt; int ui = 0;
    if (!S.next(0, cur)) return;
    f32x4 acc[2][2][4][2];
#pragma unroll
    for (int a = 0; a < 2; ++a)
#pragma unroll
        for (int b = 0; b < 2; ++b)
#pragma unroll
            for (int m = 0; m < 4; ++m)
#pragma unroll
                for (int n = 0; n < 2; ++n) acc[a][b][m][n] = (f32x4){0.f, 0.f, 0.f, 0.f};
    bf16x8 At[4][2], B0[2][2], B1[2][2];
    const char* cA = (const char*)g.A + (size_t)cur.pm * tstep; const char* cB = (const char*)g.Bt + (size_t)cur.pn * tstep;
    PG8_STAGE(PG8_SB(0, 0), cB); PG8_STAGE(PG8_SA(0, 0), cA); PG8_STAGE(PG8_SB(0, 1), cB + hstep); PG8_STAGE(PG8_SA(0, 1), cA + hstep);
    if (wr == 1) PG8_BAR;
    PG8_WAIT_V(4); PG8_BAR;
    PG8_STAGE(PG8_SB(1, 0), cB + kstep); PG8_STAGE(PG8_SA(1, 0), cA + kstep); PG8_STAGE(PG8_SB(1, 1), cB + hstep + kstep);
    PG8_WAIT_V(6); PG8_BAR;
    for (;;) {
        const bool has_next = S.next(ui + 1, nxt);
        const char* nA = has_next ? (const char*)g.A + (size_t)nxt.pm * tstep : cA; const char* nB = has_next ? (const char*)g.Bt + (size_t)nxt.pn * tstep : cB;
        for (int t = 0; t < nt; t += 2) {
            const bool last = (t == nt - 2);
            const char* a1 = cA + (size_t)(t + 1) * kstep;
            const char* a2 = last ? nA : cA + (size_t)(t + 2) * kstep; const char* b2 = last ? nB : cB + (size_t)(t + 2) * kstep;
            const char* a3 = a2 + kstep; const char* b3 = b2 + kstep;
            PG8_LDB(B0, 0, 0); PG8_SCHED; PG8_LDA(At, 0, 0); PG8_STAGE(PG8_SA(1, 1), a1 + hstep);
            PG8_WAIT_L(8); PG8_BAR; PG8_WAIT_L(0); PG8_MMA(0, 0, At, B0); PG8_BAR; PG8_SCHED;
            PG8_LDB(B1, 0, 1); PG8_STAGE(PG8_SB(0, 0), b2);
            PG8_BAR; PG8_WAIT_L(0); PG8_MMA(0, 1, At, B1); PG8_BAR;
            PG8_LDA(At, 0, 1); PG8_STAGE(PG8_SA(0, 0), a2);
            PG8_BAR; PG8_WAIT_L(0); PG8_MMA(1, 0, At, B0); PG8_BAR; PG8_SCHED;
            PG8_STAGE(PG8_SB(0, 1), b2 + hstep);
            PG8_WAIT_V(6); PG8_BAR; PG8_MMA(1, 1, At, B1); PG8_BAR;
            PG8_LDB(B0, 1, 0); PG8_SCHED; PG8_LDA(At, 1, 0); PG8_STAGE(PG8_SA(0, 1), a2 + hstep);
            PG8_WAIT_L(8); PG8_BAR; PG8_WAIT_L(0); PG8_MMA(0, 0, At, B0); PG8_BAR; PG8_SCHED;
            PG8_LDB(B1, 1, 1); PG8_STAGE(PG8_SB(1, 0), b3);
            PG8_BAR; PG8_WAIT_L(0); PG8_MMA(0, 1, At, B1); PG8_BAR;
            PG8_LDA(At, 1, 1); PG8_STAGE(PG8_SA(1, 0), a3);
            PG8_BAR; PG8_WAIT_L(0); PG8_MMA(1, 0, At, B0); PG8_BAR; PG8_SCHED;
            PG8_STAGE(PG8_SB(1, 1), b3 + hstep);
            PG8_WAIT_V(6); PG8_BAR; PG8_MMA(1, 1, At, B1); PG8_BAR;
        }
        E(acc, cur, wr, wc, fr, fq);
        if (!has_next) break;
#pragma unroll
        for (int a = 0; a < 2; ++a)
#pragma unroll
            for (int b = 0; b < 2; ++b)
#pragma unroll
                for (int m = 0; m < 4; ++m)
#pragma unroll
                    for (int n = 0; n < 2; ++n) acc[a][b][m][n] = (f32x4){0.f, 0.f, 0.f, 0.f};
        cur = nxt; cA = nA; cB = nB; ++ui;
    }
    PG8_WAIT_V(0);
    if (wr == 0) PG8_BAR;
    PG8_BAR;
#undef PG8_SA
#undef PG8_SB
#undef PG8_STAGE
#undef PG8_LDA
#undef PG8_LDB
#undef PG8_MMA
#undef PG8_WAIT_V
#undef PG8_WAIT_L
#undef PG8_BAR
#undef PG8_SCHED
}
}

__device__ __forceinline__ void ph_gemm_in(const Params& p, float* lds) {
    pg8::Gemm g{p.h, p.WinT, 1024}; pg8::SchedIn S{(int)gridDim.x, (int)blockIdx.x}; pg8::EpiIn E{&p};
    pg8::gemm_phase(( PG8_LAS unsigned char*)lds, g, S, E);
}
__device__ __forceinline__ void ph_gemm_out(const Params& p, float* lds) {
    pg8::Gemm g{p.mixed, p.WoutT, 1024}; pg8::SchedOut S{(int)gridDim.x, (int)blockIdx.x}; pg8::EpiOut E{&p};
    pg8::gemm_phase((PG8_LAS unsigned char*)lds, g, S, E);
}


#define LAS __attribute__((address_space(3)))
typedef LAS unsigned char* ldsp;
typedef short bf16x8_t __attribute__((ext_vector_type(8)));
typedef float f32x4_t __attribute__((ext_vector_type(4)));
typedef unsigned u32x4_t __attribute__((ext_vector_type(4)));
typedef unsigned u32x2_t __attribute__((ext_vector_type(2)));
#define MFMA16(a, b, c) __builtin_amdgcn_mfma_f32_16x16x32_bf16(a, b, c, 0, 0, 0)
__device__ __forceinline__ int toff(int r, int c) { return r * 256 + ((((c >> 3) ^ (r & 15)) << 4) | ((c & 7) << 1)); }
__device__ __forceinline__ bf16x8_t ldfrag(ldsp tile, int r, int kk, int fq) { return *(const LAS bf16x8_t*)(tile + toff(r, 32 * kk + 8 * fq)); }
__device__ __forceinline__ void stage_tile(ldsp dst, const bf16_t* src, int tid) {
#pragma unroll
    for (int i = 0; i < 4; ++i) { const int idx = tid + NT * i, r = idx >> 4, c = idx & 15; const u32x4_t v = *(const u32x4_t*)(src + (size_t)idx * 8); *(LAS u32x4_t*)(dst + r * 256 + ((c ^ (r & 15)) << 4)) = v; }
}
__device__ __forceinline__ void stage_tileT(ldsp dst, const bf16_t* src, int tid) {
    const int jj = tid & 63, c0 = tid >> 6;
#pragma unroll
    for (int ps = 0; ps < 2; ++ps) {
        const int c = c0 + 8 * ps;
        const u32x4_t aw = *(const u32x4_t*)(src + (2 * jj) * 128 + c * 8), bw = *(const u32x4_t*)(src + (2 * jj + 1) * 128 + c * 8);
#pragma unroll
        for (int i = 0; i < 8; ++i) {
            const int e = 8 * c + i;
            const unsigned lo = (i & 1) ? (aw[i >> 1] >> 16) : (aw[i >> 1] & 0xffffu), hi = (i & 1) ? (bw[i >> 1] & 0xffff0000u) : (bw[i >> 1] << 16);
            *(LAS unsigned*)(dst + e * 256 + ((((jj >> 2) ^ (e & 15)) << 4) | ((jj & 3) << 2))) = lo | hi;
        }
    }
}

__device__ void ph_states(const Params& p, ldsp lds) {
    const int tid = otid(), w = tid >> 6, lane = tid & 63, fr = lane & 15, fq = lane >> 4;
    ldsp bKf = lds, bKb = lds + 32768, bV = lds + 65536;
    for (int item = blockIdx.x; item < 32 * 34; item += gridDim.x) {
        const int bh = item / 34, c = item % 34, h = bh & 3;
        const float lgf = lgam(p, 0, h), lgb = lgam(p, 1, h);
        const bf16_t* K = p.rk + ((size_t)bh * KVROWS + c * 128) * 128;
        const bf16_t* V = p.rv + ((size_t)bh * KVROWS + c * 128) * 128;
        stage_tileT(bV, V, tid);
        {
            const int jj = tid & 63, c0 = tid >> 6;
            const float wf0 = __expf(lgf * (float)(127 - 2 * jj)), wf1 = __expf(lgf * (float)(126 - 2 * jj));
            const float wb0 = __expf(lgb * (float)(2 * jj)), wb1 = __expf(lgb * (float)(2 * jj + 1));
#pragma unroll
            for (int ps = 0; ps < 2; ++ps) {
                const int cc = c0 + 8 * ps;
                float a[8], b[8]; load8(K + (2 * jj) * 128 + cc * 8, a); load8(K + (2 * jj + 1) * 128 + cc * 8, b);
#pragma unroll
                for (int i = 0; i < 8; ++i) {
                    const int e = 8 * cc + i, off = e * 256 + ((((jj >> 2) ^ (e & 15)) << 4) | ((jj & 3) << 2));
                    *(LAS unsigned*)(bKf + off) = pack2(a[i] * wf0, b[i] * wf1);
                    *(LAS unsigned*)(bKb + off) = pack2(a[i] * wb0, b[i] * wb1);
                }
            }
        }
        __syncthreads();
        f32x4_t af[8], ab[8];
#pragma unroll
        for (int i = 0; i < 8; ++i) { af[i] = (f32x4_t){0.f, 0.f, 0.f, 0.f}; ab[i] = (f32x4_t){0.f, 0.f, 0.f, 0.f}; }
#pragma unroll 1
        for (int kk = 0; kk < 4; ++kk) {
            const bf16x8_t xf = ldfrag(bKf, 16 * w + fr, kk, fq), xb = ldfrag(bKb, 16 * w + fr, kk, fq);
#pragma unroll
            for (int nt = 0; nt < 8; ++nt) { const bf16x8_t bv = ldfrag(bV, 16 * nt + fr, kk, fq); af[nt] = MFMA16(xf, bv, af[nt]); ab[nt] = MFMA16(xb, bv, ab[nt]); }
        }
#pragma unroll
        for (int nt = 0; nt < 8; ++nt) {
            const size_t o = ((size_t)item * 128 + 16 * nt + fr) * 128 + 16 * w + 4 * fq;
            uint2 u; u.x = pack2(af[nt][0], af[nt][1]); u.y = pack2(af[nt][2], af[nt][3]); *(uint2*)(p.Kf + o) = u;
            u.x = pack2(ab[nt][0], ab[nt][1]); u.y = pack2(ab[nt][2], ab[nt][3]); *(uint2*)(p.Kb + o) = u;
        }
        __syncthreads();
    }
}

__device__ void ph_retout(const Params& p, ldsp lds) {
    const int tid = otid(), w = tid >> 6, lane = tid & 63, fr = lane & 15, fq = lane >> 4;
    ldsp bQ = lds, bK = lds + 32768, bV = lds + 65536, bR = lds + 98304;
    for (int item = blockIdx.x; item < 1024; item += gridDim.x) {
        const int bh = item >> 5, n = item & 31, b = bh >> 2, h = bh & 3;
        const float lgf = lgam(p, 0, h), lgb = lgam(p, 1, h);
        const bf16_t* Q = p.rq + ((size_t)bh * 4096 + n * 128) * 128;
        const bf16_t* K = p.rk + ((size_t)bh * KVROWS + n * 128) * 128;
        const bf16_t* V = p.rv + ((size_t)bh * KVROWS + n * 128) * 128;
        const bf16_t* RF = p.Rf + (size_t)(bh * 32 + n) * 16384;
        const bf16_t* RB = p.Rb + (size_t)(bh * 32 + n) * 16384;
        stage_tile(bQ, Q, tid); stage_tile(bK, K, tid); stage_tileT(bV, V, tid); stage_tile(bR, RF, tid);
        __syncthreads();
        f32x4_t s[8];
#pragma unroll
        for (int i = 0; i < 8; ++i) s[i] = (f32x4_t){0.f, 0.f, 0.f, 0.f};
#pragma unroll 1
        for (int kk = 0; kk < 4; ++kk) {
            const bf16x8_t a = ldfrag(bK, 16 * w + fr, kk, fq);
#pragma unroll
            for (int nt = 0; nt < 8; ++nt) { const bf16x8_t bq = ldfrag(bQ, 16 * nt + fr, kk, fq); s[nt] = MFMA16(a, bq, s[nt]); }
        }
        u32x4_t rbreg[4];
#pragma unroll
        for (int i = 0; i < 4; ++i) rbreg[i] = *(const u32x4_t*)(RB + (size_t)(tid + NT * i) * 8);
        __syncthreads();
#pragma unroll
        for (int nt = 0; nt < 8; ++nt) {
            const int i = 16 * nt + fr; float o[4];
#pragma unroll
            for (int r = 0; r < 4; ++r) { const int dlt = i - (16 * w + 4 * fq + r); const float dec = dlt >= 0 ? __expf(lgf * (float)dlt) : __expf(lgb * (float)(-dlt)); o[r] = s[nt][r] * dec; }
            u32x2_t u; u.x = pack2(o[0], o[1]); u.y = pack2(o[2], o[3]);
            *(LAS u32x2_t*)(bK + toff(i, 16 * w + 4 * fq)) = u;
        }
        __syncthreads();
        f32x4_t y[8], ca[8];
#pragma unroll
        for (int i = 0; i < 8; ++i) { y[i] = (f32x4_t){0.f, 0.f, 0.f, 0.f}; ca[i] = (f32x4_t){0.f, 0.f, 0.f, 0.f}; }
#pragma unroll 1
        for (int kk = 0; kk < 4; ++kk) {
            const bf16x8_t bs = ldfrag(bK, 16 * w + fr, kk, fq), bq = ldfrag(bQ, 16 * w + fr, kk, fq);
#pragma unroll
            for (int mt = 0; mt < 8; ++mt) {
                y[mt] = MFMA16(ldfrag(bV, 16 * mt + fr, kk, fq), bs, y[mt]);
                ca[mt] = MFMA16(ldfrag(bR, 16 * mt + fr, kk, fq), bq, ca[mt]);
            }
        }
        const int ip = 16 * w + fr;
        {
            const float cfs = __expf(lgf * (float)(ip + 1));
#pragma unroll
            for (int mt = 0; mt < 8; ++mt) { y[mt] += cfs * ca[mt]; ca[mt] = (f32x4_t){0.f, 0.f, 0.f, 0.f}; }
        }
        __syncthreads();
#pragma unroll
        for (int i = 0; i < 4; ++i) { const int idx = tid + NT * i, r = idx >> 4, c = idx & 15; *(LAS u32x4_t*)(bV + r * 256 + ((c ^ (r & 15)) << 4)) = rbreg[i]; }
        __syncthreads();
#pragma unroll 1
        for (int kk = 0; kk < 4; ++kk) {
            const bf16x8_t bq = ldfrag(bQ, 16 * w + fr, kk, fq);
#pragma unroll
            for (int mt = 0; mt < 8; ++mt) ca[mt] = MFMA16(ldfrag(bV, 16 * mt + fr, kk, fq), bq, ca[mt]);
        }
        const float cbs = __expf(lgb * (float)(128 - ip));
        float sum = 0.f;
#pragma unroll
        for (int mt = 0; mt < 8; ++mt) { y[mt] += cbs * ca[mt]; sum += y[mt][0] + y[mt][1] + y[mt][2] + y[mt][3]; }
        sum += __shfl_xor(sum, 16); sum += __shfl_xor(sum, 32);
        const float mu = sum * (1.f / 128.f);
        float vs = 0.f;
#pragma unroll
        for (int mt = 0; mt < 8; ++mt)
#pragma unroll
            for (int r = 0; r < 4; ++r) { const float dl = y[mt][r] - mu; vs += dl * dl; }
        vs += __shfl_xor(vs, 16); vs += __shfl_xor(vs, 32);
        const float rs = rsqrtf(vs * (1.f / 128.f) + 1e-6f);
        const size_t row = (size_t)b * 4096 + n * 128 + ip;
#pragma unroll
        for (int mt = 0; mt < 8; ++mt) {
            const int col = h * 128 + 16 * mt + 4 * fq;
            const uint2 g = *(const uint2*)(p.rg + row * 512 + col);
            const float4 gw = *(const float4*)(p.gn_w + col);
            const float o0 = (y[mt][0] - mu) * rs * gw.x * __uint_as_float(g.x << 16), o1 = (y[mt][1] - mu) * rs * gw.y * __uint_as_float(g.x & 0xffff0000u);
            const float o2 = (y[mt][2] - mu) * rs * gw.z * __uint_as_float(g.y << 16), o3 = (y[mt][3] - mu) * rs * gw.w * __uint_as_float(g.y & 0xffff0000u);
            uint2 u; u.x = pack2(o0, o1); u.y = pack2(o2, o3);
            *(uint2*)(p.mixed + row * 1024 + col) = u;
        }
        __syncthreads();
    }
}


__device__ __forceinline__ int koff(int r, int c) { return r * 128 + ((((c >> 3) ^ ((r >> 1) & 7)) << 4) | ((c & 7) << 1)); }
__device__ void ph_attn(const Params& p, ldsp lds) {
    const int tid = otid(), w = tid >> 6, lane = tid & 63, fr = lane & 15, fq = lane >> 4;
    const int g = w >> 1, sub = w & 1;
    int cnt = 0;
    for (int item = blockIdx.x; item < 1024; item += gridDim.x) {
        const int half = item & 1, nb = (item >> 1) & 31, bk = item >> 6, qoff = 64 * half + 32 * sub, b = bk >> 1, kvh = bk & 1, qh = kvh * 4 + g;
        const bf16_t* Kg = p.ak + (size_t)bk * KVROWS * 64;
        const bf16_t* Vg = p.av + (size_t)bk * KVROWS * 64;
        bf16x8_t qf[2][2];
#pragma unroll
        for (int st = 0; st < 2; ++st)
#pragma unroll
            for (int kk = 0; kk < 2; ++kk) qf[st][kk] = *(const bf16x8_t*)(p.aq + ((size_t)(b * 8 + qh) * 4096 + nb * 128 + qoff + 16 * st + fr) * 64 + 32 * kk + 8 * fq);
        f32x4_t oacc[2][4]; float mrun[2], lrun[2];
        const float sink = p.sink[qh];
#pragma unroll
        for (int st = 0; st < 2; ++st) {
            mrun[st] = sink; lrun[st] = fq == 0 ? 1.f : 0.f;
#pragma unroll
            for (int mt = 0; mt < 4; ++mt) oacc[st][mt] = (f32x4_t){0.f, 0.f, 0.f, 0.f};
        }
#pragma unroll 1
        for (int ti = 0; ti < 5; ++ti) {
            if ((ti == 2 && nb == 0) || (ti == 4 && nb == 31)) continue;
            const int rowbase = ti < 2 ? ti * 128 : 256 + (nb + ti - 3) * 128;
            const int mode = ti == 2 ? 1 : (ti == 4 ? 2 : 0);
            ldsp kb = lds + (cnt & 1) * 32768, vb = kb + 16384; ++cnt;
#pragma unroll
            for (int i = 0; i < 2; ++i) {
                const int idx = tid + NT * i, r = idx >> 3, c = idx & 7;
                const u32x4_t v = *(const u32x4_t*)(Kg + (size_t)rowbase * 64 + (size_t)idx * 8);
                *(LAS u32x4_t*)(kb + r * 128 + ((c ^ ((r >> 1) & 7)) << 4)) = v;
            }
            {
                const int jj = tid & 63, c = tid >> 6;
                const u32x4_t aw = *(const u32x4_t*)(Vg + (size_t)(rowbase + 2 * jj) * 64 + c * 8), bw = *(const u32x4_t*)(Vg + (size_t)(rowbase + 2 * jj + 1) * 64 + c * 8);
#pragma unroll
                for (int i = 0; i < 8; ++i) {
                    const int e = 8 * c + i;
                    const unsigned lo = (i & 1) ? (aw[i >> 1] >> 16) : (aw[i >> 1] & 0xffffu), hi = (i & 1) ? (bw[i >> 1] & 0xffff0000u) : (bw[i >> 1] << 16);
                    *(LAS unsigned*)(vb + e * 256 + ((((jj >> 2) ^ (e & 15)) << 4) | ((jj & 3) << 2))) = lo | hi;
                }
            }
            __syncthreads();
#pragma unroll
            for (int st = 0; st < 2; ++st) {
                f32x4_t s[8];
#pragma unroll
                for (int mt = 0; mt < 8; ++mt) s[mt] = (f32x4_t){0.f, 0.f, 0.f, 0.f};
#pragma unroll
                for (int kk = 0; kk < 2; ++kk)
#pragma unroll
                    for (int mt = 0; mt < 8; ++mt) s[mt] = MFMA16(*(const LAS bf16x8_t*)(kb + koff(16 * mt + fr, 32 * kk + 8 * fq)), qf[st][kk], s[mt]);
                if (mode) {
                    const int qi = qoff + 16 * st + fr;
#pragma unroll
                    for (int mt = 0; mt < 8; ++mt)
#pragma unroll
                        for (int r = 0; r < 4; ++r) { const int kj = 16 * mt + 4 * fq + r; const bool ok = mode == 1 ? kj >= qi : kj <= qi; s[mt][r] = ok ? s[mt][r] : -1e30f; }
                }
                float mx = s[0][0];
#pragma unroll
                for (int mt = 0; mt < 8; ++mt)
#pragma unroll
                    for (int r = 0; r < 4; ++r) mx = fmaxf(mx, s[mt][r]);
                mx = fmaxf(mx, __shfl_xor(mx, 16)); mx = fmaxf(mx, __shfl_xor(mx, 32));
                const float mn = fmaxf(mrun[st], mx), sc = __expf(mrun[st] - mn);
                mrun[st] = mn;
                float ps = 0.f;
#pragma unroll
                for (int mt = 0; mt < 8; ++mt)
#pragma unroll
                    for (int r = 0; r < 4; ++r) { const float pv = __expf(s[mt][r] - mn); s[mt][r] = pv; ps += pv; }
                lrun[st] = lrun[st] * sc + ps;
#pragma unroll
                for (int mt = 0; mt < 4; ++mt) oacc[st][mt] *= sc;
#pragma unroll
                for (int kk = 0; kk < 4; ++kk) {
                    u32x4_t pu; pu.x = pack2(s[2 * kk][0], s[2 * kk][1]); pu.y = pack2(s[2 * kk][2], s[2 * kk][3]); pu.z = pack2(s[2 * kk + 1][0], s[2 * kk + 1][1]); pu.w = pack2(s[2 * kk + 1][2], s[2 * kk + 1][3]);
                    const bf16x8_t pf = __builtin_bit_cast(bf16x8_t, pu);
#pragma unroll
                    for (int mt = 0; mt < 4; ++mt) {
                        const u32x2_t lo = *(const LAS u32x2_t*)(vb + toff(16 * mt + fr, 32 * kk + 4 * fq)), hi = *(const LAS u32x2_t*)(vb + toff(16 * mt + fr, 32 * kk + 16 + 4 * fq));
                        u32x4_t au; au.x = lo.x; au.y = lo.y; au.z = hi.x; au.w = hi.y;
                        oacc[st][mt] = MFMA16(__builtin_bit_cast(bf16x8_t, au), pf, oacc[st][mt]);
                    }
                }
                __builtin_amdgcn_sched_barrier(0);
            }
        }
#pragma unroll
        for (int st = 0; st < 2; ++st) {
            float lt = lrun[st]; lt += __shfl_xor(lt, 16); lt += __shfl_xor(lt, 32);
            const float inv = 1.f / lt;
            const size_t row = (size_t)b * 4096 + nb * 128 + qoff + 16 * st + fr;
#pragma unroll
            for (int mt = 0; mt < 4; ++mt) {
                const int col = qh * 64 + 16 * mt + 4 * fq;
                const uint2 gt = *(const uint2*)(p.ag + row * 512 + col);
                const float o0 = oacc[st][mt][0] * inv * __uint_as_float(gt.x << 16), o1 = oacc[st][mt][1] * inv * __uint_as_float(gt.x & 0xffff0000u);
                const float o2 = oacc[st][mt][2] * inv * __uint_as_float(gt.y << 16), o3 = oacc[st][mt][3] * inv * __uint_as_float(gt.y & 0xffff0000u);
                uint2 u; u.x = pack2(o0, o1); u.y = pack2(o2, o3);
                *(uint2*)(p.mixed + row * 1024 + 512 + col) = u;
            }
        }
    }
    __syncthreads();
}

__device__ void ph_states_naive(const Params& p) {
    for (int item = blockIdx.x; item < 32 * 34; item += gridDim.x) {
        const int bh = item / 34, c = item % 34, h = bh & 3;
        const float lgf = lgam(p, 0, h), lgb = lgam(p, 1, h);
        const bf16_t* K = p.rk + ((size_t)bh * KVROWS + c * 128) * 128;
        const bf16_t* V = p.rv + ((size_t)bh * KVROWS + c * 128) * 128;
        const int e = threadIdx.x & 127, dg = threadIdx.x >> 7;
        float af[32], ab[32];
#pragma unroll
        for (int i = 0; i < 32; ++i) { af[i] = 0.f; ab[i] = 0.f; }
        for (int j = 0; j < 128; ++j) {
            const float vv = bf2f(V[j * 128 + e]);
            const float wf = expf(lgf * (float)(127 - j)) * vv, wb = expf(lgb * (float)j) * vv;
#pragma unroll
            for (int d8 = 0; d8 < 4; ++d8) {
                float kk[8]; load8(K + j * 128 + dg * 32 + d8 * 8, kk);
#pragma unroll
                for (int i = 0; i < 8; ++i) { af[d8 * 8 + i] += wf * kk[i]; ab[d8 * 8 + i] += wb * kk[i]; }
            }
        }
        bf16_t* of = p.Kf + ((size_t)item * 128 + e) * 128 + dg * 32;
        bf16_t* ob = p.Kb + ((size_t)item * 128 + e) * 128 + dg * 32;
#pragma unroll
        for (int d8 = 0; d8 < 4; ++d8) { store8(of + d8 * 8, af + d8 * 8); store8(ob + d8 * 8, ab + d8 * 8); }
    }
}

__device__ void ph_scan(const Params& p) {
    for (int idx = blockIdx.x * NT + otid(); idx < 32 * 4096; idx += gridDim.x * NT) {
        const int bh = idx >> 12, el = (idx & 4095) * 4, h = bh & 3;
        const float gfC = expf(lgam(p, 0, h) * 128.f), gbC = expf(lgam(p, 1, h) * 128.f);
        const bf16_t* kf = p.Kf + (size_t)bh * 34 * 16384 + el;
        const bf16_t* kb = p.Kb + (size_t)bh * 34 * 16384 + el;
        bf16_t* rf = p.Rf + (size_t)bh * 32 * 16384 + el;
        bf16_t* rb = p.Rb + (size_t)bh * 32 * 16384 + el;
        float R[4];
        auto ld4 = [](const bf16_t* s, float* o) { const uint2 u = *(const uint2*)s; o[0] = __uint_as_float(u.x << 16); o[1] = __uint_as_float(u.x & 0xffff0000u); o[2] = __uint_as_float(u.y << 16); o[3] = __uint_as_float(u.y & 0xffff0000u); };
        auto st4 = [](bf16_t* d, const float* o) { uint2 u; u.x = pack2(o[0], o[1]); u.y = pack2(o[2], o[3]); *(uint2*)d = u; };
        float t[4];
        ld4(kf + 32 * 16384, R); ld4(kf + 33 * 16384, t);
#pragma unroll
        for (int i = 0; i < 4; ++i) R[i] = gfC * R[i] + t[i];
#pragma unroll 4
        for (int n = 0; n < 32; ++n) {
            st4(rf + (size_t)n * 16384, R); ld4(kf + (size_t)n * 16384, t);
#pragma unroll
            for (int i = 0; i < 4; ++i) R[i] = gfC * R[i] + t[i];
        }
        ld4(kb + 33 * 16384, R); ld4(kb + 32 * 16384, t);
#pragma unroll
        for (int i = 0; i < 4; ++i) R[i] = gbC * R[i] + t[i];
#pragma unroll 4
        for (int n = 31; n >= 0; --n) {
            st4(rb + (size_t)n * 16384, R); ld4(kb + (size_t)n * 16384, t);
#pragma unroll
            for (int i = 0; i < 4; ++i) R[i] = gbC * R[i] + t[i];
        }
    }
}

__device__ void ph_retout_naive(const Params& p, float* S) {
    for (int item = blockIdx.x; item < 1024; item += gridDim.x) {
        const int bh = item >> 5, n = item & 31, b = bh >> 2, h = bh & 3;
        const float lgf = lgam(p, 0, h), lgb = lgam(p, 1, h);
        const bf16_t* Q = p.rq + ((size_t)bh * 4096 + n * 128) * 128;
        const bf16_t* K = p.rk + ((size_t)bh * KVROWS + n * 128) * 128;
        const bf16_t* V = p.rv + ((size_t)bh * KVROWS + n * 128) * 128;
        const bf16_t* RF = p.Rf + (size_t)(bh * 32 + n) * 16384;
        const bf16_t* RB = p.Rb + (size_t)(bh * 32 + n) * 16384;
        const int i = threadIdx.x >> 2, q4 = threadIdx.x & 3;
        for (int jj = 0; jj < 32; ++jj) {
            const int j = q4 * 32 + jj;
            float dot = 0.f;
#pragma unroll 4
            for (int d8 = 0; d8 < 16; ++d8) {
                float a[8], bb[8]; load8(Q + i * 128 + d8 * 8, a); load8(K + j * 128 + d8 * 8, bb);
#pragma unroll
                for (int t = 0; t < 8; ++t) dot += a[t] * bb[t];
            }
            const float dec = j <= i ? expf(lgf * (float)(i - j)) : expf(lgb * (float)(j - i));
            S[i * 128 + ((j + i) & 127)] = dot * dec;
        }
        __syncthreads();
        float y[32];
#pragma unroll
        for (int t = 0; t < 32; ++t) y[t] = 0.f;
        const int e0 = q4 * 32;
        for (int j = 0; j < 128; ++j) {
            const float s = S[i * 128 + ((j + i) & 127)];
#pragma unroll
            for (int e8 = 0; e8 < 4; ++e8) {
                float vv[8]; load8(V + j * 128 + e0 + e8 * 8, vv);
#pragma unroll
                for (int t = 0; t < 8; ++t) y[e8 * 8 + t] += s * vv[t];
            }
        }
        const float cf = expf(lgf * (float)(i + 1)), cb = expf(lgb * (float)(128 - i));
#pragma unroll 1
        for (int d8 = 0; d8 < 16; ++d8) {
            float a[8]; load8(Q + i * 128 + d8 * 8, a);
#pragma unroll
            for (int ee = 0; ee < 32; ++ee) {
                float rf[8], rb[8]; load8(RF + (e0 + ee) * 128 + d8 * 8, rf); load8(RB + (e0 + ee) * 128 + d8 * 8, rb);
                float sf = 0.f, sb = 0.f;
#pragma unroll
                for (int t = 0; t < 8; ++t) { sf += a[t] * rf[t]; sb += a[t] * rb[t]; }
                y[ee] += cf * sf + cb * sb;
            }
        }
        float sum = 0.f;
#pragma unroll
        for (int t = 0; t < 32; ++t) sum += y[t];
        sum += __shfl_xor(sum, 1); sum += __shfl_xor(sum, 2);
        const float mu = sum * (1.f / 128.f);
        float vs = 0.f;
#pragma unroll
        for (int t = 0; t < 32; ++t) { const float dlt = y[t] - mu; vs += dlt * dlt; }
        vs += __shfl_xor(vs, 1); vs += __shfl_xor(vs, 2);
        const float rs = rsqrtf(vs * (1.f / 128.f) + 1e-6f);
        const size_t row = (size_t)b * 4096 + n * 128 + i;
        const int col0 = h * 128 + e0;
#pragma unroll
        for (int e8 = 0; e8 < 4; ++e8) {
            float g[8], o[8]; load8(p.rg + row * 512 + col0 + e8 * 8, g);
#pragma unroll
            for (int t = 0; t < 8; ++t) o[t] = (y[e8 * 8 + t] - mu) * rs * p.gn_w[col0 + e8 * 8 + t] * g[t];
            store8(p.mixed + row * 1024 + col0 + e8 * 8, o);
        }
        __syncthreads();
    }
}

__device__ void ph_attn_naive(const Params& p) {
    for (int idx = blockIdx.x * NT + otid(); idx < 8 * 8 * 4096; idx += gridDim.x * NT) {
        const int t = idx & 4095, bq = idx >> 12, qh = bq & 7, b = bq >> 3, kvh = qh >> 2;
        float q[64], acc[64];
#pragma unroll
        for (int d8 = 0; d8 < 8; ++d8) load8(p.aq + ((size_t)bq * 4096 + t) * 64 + d8 * 8, q + d8 * 8);
#pragma unroll
        for (int e = 0; e < 64; ++e) acc[e] = 0.f;
        const bf16_t* Kb = p.ak + (size_t)(b * 2 + kvh) * KVROWS * 64;
        const bf16_t* Vb = p.av + (size_t)(b * 2 + kvh) * KVROWS * 64;
        float m = p.sink[qh], l = 1.f;
        const int lo = t - 128 < 0 ? 0 : t - 128, hi = t + 128 > 4095 ? 4095 : t + 128;
        const int nkeys = 256 + (hi - lo + 1);
        for (int kk = 0; kk < nkeys; ++kk) {
            const int krow = kk < 256 ? kk : lo + kk;
            float s = 0.f;
#pragma unroll
            for (int d8 = 0; d8 < 8; ++d8) {
                float kv[8]; load8(Kb + (size_t)krow * 64 + d8 * 8, kv);
#pragma unroll
                for (int i = 0; i < 8; ++i) s += q[d8 * 8 + i] * kv[i];
            }
            if (s > m) {
                const float sc = __expf(m - s); l *= sc;
#pragma unroll
                for (int e = 0; e < 64; ++e) acc[e] *= sc;
                m = s;
            }
            const float pe = __expf(s - m); l += pe;
#pragma unroll
            for (int d8 = 0; d8 < 8; ++d8) {
                float vv[8]; load8(Vb + (size_t)krow * 64 + d8 * 8, vv);
#pragma unroll
                for (int i = 0; i < 8; ++i) acc[d8 * 8 + i] += pe * vv[i];
            }
        }
        const float inv = 1.f / l;
        const size_t row = (size_t)b * 4096 + t;
#pragma unroll
        for (int d8 = 0; d8 < 8; ++d8) {
            float g[8], o[8]; load8(p.ag + row * 512 + qh * 64 + d8 * 8, g);
#pragma unroll
            for (int i = 0; i < 8; ++i) o[i] = acc[d8 * 8 + i] * inv * g[i];
            store8(p.mixed + row * 1024 + 512 + qh * 64 + d8 * 8, o);
        }
    }
}

__device__ void ph_final(const Params& p) {
    const int tid = otid(), wave = tid >> 6, lane = tid & 63;
    for (int row = blockIdx.x * 8 + wave; row < 32768; row += gridDim.x * 8) {
        float* src = p.out + (size_t)row * 1024;
        float4 xv[4]; float ss = 0.f;
#pragma unroll
        for (int i = 0; i < 4; ++i) { xv[i] = *(const float4*)(src + i * 256 + lane * 4); ss += xv[i].x * xv[i].x + xv[i].y * xv[i].y + xv[i].z * xv[i].z + xv[i].w * xv[i].w; }
        ss = wave_sum(ss);
        const float rstd = rsqrtf(ss * (1.f / 1024.f) + 1e-6f);
#pragma unroll
        for (int i = 0; i < 4; ++i) {
            const int col = i * 256 + lane * 4;
            const float4 w4 = *(const float4*)(p.fnw + col);
            float4 o; o.x = xv[i].x * rstd * w4.x; o.y = xv[i].y * rstd * w4.y; o.z = xv[i].z * rstd * w4.z; o.w = xv[i].w * rstd * w4.w;
            *(float4*)(src + col) = o;
        }
    }
}

#define NPHASE 9
template <int PH> __device__ __forceinline__ void run_phase(const Params& p, float* lds) {
    if (PH == 0) { ph_mod(p, lds); __syncthreads(); ph_wconv(p, lds); }
    else if (PH == 1) ph_h(p);
    else if (PH == 2) ph_gemm_in(p, lds);
    else if (PH == 3) { ph_states(p, (ldsp)lds); ph_attn(p, (ldsp)lds); }
    else if (PH == 4) ph_scan(p);
    else if (PH == 5) ph_retout(p, (ldsp)lds);
    else if (PH == 6) ph_gemm_out(p, lds);
    else if (PH == 7) ph_final(p);
}

template <int PH> __global__ __launch_bounds__(NT) void k_ph(Params p) {
    extern __shared__ __attribute__((aligned(16))) float lds[];
    run_phase<PH>(p, lds);
}

__global__ __launch_bounds__(NT) void k_mega(Params p) {
    extern __shared__ __attribute__((aligned(16))) float lds[];
    cg::grid_group grid = cg::this_grid();
    run_phase<0>(p, lds); grid.sync();
    run_phase<1>(p, lds); grid.sync();
    run_phase<2>(p, lds); grid.sync();
    run_phase<3>(p, lds); grid.sync();
    run_phase<4>(p, lds); grid.sync();
    run_phase<5>(p, lds); grid.sync();
    run_phase<6>(p, lds); grid.sync();
    run_phase<7>(p, lds);
}

template <int PH> static void launch_ph(const Params& p, int grid, hipStream_t stream) {
    static bool attr = false;
    if (!attr) { (void)hipFuncSetAttribute((const void*)k_ph<PH>, hipFuncAttributeMaxDynamicSharedMemorySize, LDS_BYTES); attr = true; }
    hipLaunchKernelGGL(k_ph<PH>, dim3(grid), dim3(NT), LDS_BYTES, stream, p);
}

extern "C" void kernel_launch(void* const* d_in, const int* in_sizes, int n_in, void* d_out, int out_size, void* d_ws, size_t ws_size, hipStream_t stream) {
    Params p{};
    p.x = (const float*)d_in[0]; p.c = (const float*)d_in[1]; p.ctx = (const float*)d_in[2]; p.c_ctx = (const float*)d_in[3];
    p.w_ada = (const float*)d_in[4]; p.b_ada = (const float*)d_in[5]; p.w_in = (const float*)d_in[6]; p.decay = (const float*)d_in[7];
    p.gn_w = (const float*)d_in[8]; p.sink = (const float*)d_in[9]; p.w_out = (const float*)d_in[10]; p.fnw = (const float*)d_in[11];
    p.out = (float*)d_out;
    unsigned char* w = (unsigned char*)d_ws; size_t off = 0;
    auto take = [&](size_t bytes) { unsigned char* r = w + off; off += (bytes + 255) & ~(size_t)255; return r; };
    p.mod = (float*)take(9 * 3072 * 4);
    p.tab128 = (float2*)take(64 * 32 * 8);
    p.tab64 = (float2*)take(64 * 16 * 8);
    p.h = (bf16_t*)take((size_t)MROWS * 1024 * 2);
    p.mixed = p.h;
    p.rq = (bf16_t*)take((size_t)32 * 4096 * 128 * 2);
    p.rk = (bf16_t*)take((size_t)32 * KVROWS * 128 * 2);
    p.rv = (bf16_t*)take((size_t)32 * KVROWS * 128 * 2);
    p.rg = (bf16_t*)take((size_t)32768 * 512 * 2);
    p.aq = (bf16_t*)take((size_t)64 * 4096 * 64 * 2);
    p.ak = (bf16_t*)take((size_t)16 * KVROWS * 64 * 2);
    p.av = (bf16_t*)take((size_t)16 * KVROWS * 64 * 2);
    p.ag = (bf16_t*)take((size_t)32768 * 512 * 2);
    p.Kf = (bf16_t*)take((size_t)32 * 34 * 16384 * 2);
    p.Kb = (bf16_t*)take((size_t)32 * 34 * 16384 * 2);
    p.Rf = (bf16_t*)take((size_t)32 * 32 * 16384 * 2);
    p.Rb = (bf16_t*)take((size_t)32 * 32 * 16384 * 2);
    p.WinT = (bf16_t*)take((size_t)3328 * 1024 * 2);
    p.WoutT = (bf16_t*)take((size_t)1024 * 1024 * 2);
    if (off > ws_size) { fprintf(stderr, "kernel_launch: workspace too small (%zu > %zu)\n", off, ws_size); return; }
#if MK_ONE_LAUNCH
    static int grid_blocks = 0;
    if (!grid_blocks) {
        int dev = 0, cus = 0, per_cu = 0;
        (void)hipGetDevice(&dev);
        (void)hipDeviceGetAttribute(&cus, hipDeviceAttributeMultiprocessorCount, dev);
        (void)hipFuncSetAttribute((const void*)k_mega, hipFuncAttributeMaxDynamicSharedMemorySize, LDS_BYTES);
        (void)hipOccupancyMaxActiveBlocksPerMultiprocessor(&per_cu, (const void*)k_mega, NT, LDS_BYTES);
        if (per_cu < 1) per_cu = 1;
        grid_blocks = cus * per_cu;
    }
    void* args[] = {&p};
    hipError_t e = hipLaunchCooperativeKernel((const void*)k_mega, dim3(grid_blocks), dim3(NT), args, LDS_BYTES, stream);
    if (e != hipSuccess) fprintf(stderr, "cooperative launch failed: %s (grid %d)\n", hipGetErrorString(e), grid_blocks);
#else
    const int G = 1024;
    launch_ph<0>(p, G, stream); launch_ph<1>(p, G, stream); launch_ph<2>(p, G, stream); launch_ph<3>(p, G, stream);
    launch_ph<4>(p, G, stream); launch_ph<5>(p, G, stream); launch_ph<6>(p, G, stream); launch_ph<7>(p, G, stream);
#endif
}
```

```cpp
#include <hip/hip_runtime.h>
#include <hip/hip_cooperative_groups.h>
#include <cstdio>
namespace cg = cooperative_groups;

#ifndef MK_ONE_LAUNCH
#define MK_ONE_LAUNCH 1
#endif

typedef unsigned short bf16_t;
#define NT 512
#define MROWS 34816
#define KVROWS 4352
#define LDS_GEMM 131072
#define LDS_BYTES (LDS_GEMM + 64)

struct Params {
    const float *x, *c, *ctx, *c_ctx, *w_ada, *b_ada, *w_in, *decay, *gn_w, *sink, *w_out, *fnw;
    float* out;
    float* mod;
    float2* tab128;
    float2* tab64;
    bf16_t *h, *rq, *rk, *rv, *rg, *aq, *ak, *av, *ag, *Kf, *Kb, *Rf, *Rb, *mixed, *WinT, *WoutT;
    unsigned* bar;
};

__device__ __forceinline__ int otid() { int t = threadIdx.x; asm volatile("" : "+v"(t)); return t; }
__device__ __forceinline__ float bf2f(bf16_t b) { return __uint_as_float(((unsigned)b) << 16); }
__device__ __forceinline__ bf16_t f2bf(float f) { unsigned u = __float_as_uint(f); u += 0x7FFFu + ((u >> 16) & 1u); return (bf16_t)(u >> 16); }
typedef __bf16 bf2_t __attribute__((ext_vector_type(2)));
typedef float fl2_t __attribute__((ext_vector_type(2)));
__device__ __forceinline__ unsigned pack2(float lo, float hi) { fl2_t v = {lo, hi}; bf2_t b = __builtin_convertvector(v, bf2_t); return *(unsigned*)&b; }
__device__ __forceinline__ void store8(bf16_t* dst, const float* o) {
    uint4 u; u.x = pack2(o[0], o[1]); u.y = pack2(o[2], o[3]); u.z = pack2(o[4], o[5]); u.w = pack2(o[6], o[7]);
    *(uint4*)dst = u;
}
__device__ __forceinline__ void load8(const bf16_t* src, float* o) {
    const uint4 u = *(const uint4*)src;
    o[0] = __uint_as_float(u.x << 16); o[1] = __uint_as_float(u.x & 0xffff0000u);
    o[2] = __uint_as_float(u.y << 16); o[3] = __uint_as_float(u.y & 0xffff0000u);
    o[4] = __uint_as_float(u.z << 16); o[5] = __uint_as_float(u.z & 0xffff0000u);
    o[6] = __uint_as_float(u.w << 16); o[7] = __uint_as_float(u.w & 0xffff0000u);
}
__device__ __forceinline__ float silu_f(float v) { return v / (1.f + __expf(-v)); }
__device__ __forceinline__ float wave_sum(float v) {
#pragma unroll
    for (int o = 32; o >= 1; o >>= 1) v += __shfl_xor(v, o);
    return v;
}
__device__ __forceinline__ float lgam(const Params& p, int dir, int h) { return -log1pf(expf(-p.decay[dir * 4 + h])); }

__device__ __forceinline__ int ocol_in(int sg) {
    if (sg < 1024) { const int s = sg & 127; return (sg & ~127) + ((s >> 5) << 4) + (((s >> 3) & 3) << 2) + (s & 3) + (((s >> 2) & 1) << 6); }
    if (sg >= 2048 && sg < 2688) { const int s = sg & 63; return (sg & ~63) + ((s >> 5) << 4) + (((s >> 3) & 3) << 2) + (s & 3) + (((s >> 2) & 1) << 5); }
    return sg;
}

__device__ __forceinline__ void epi_in8(const Params& p, int row, int s0, const float* v) {
    const bool isc = row >= 32768;
    int b, t;
    if (isc) { const int r = row - 32768; b = r >> 8; t = r & 255; } else { b = row >> 12; t = row & 4095; }
    const int gr = (t >> 6) & 63, gc = t & 63;
    float o[8];
    if (s0 < 1024) {
        const bool isk = s0 >= 512;
        if (!isk && isc) return;
        const int head = (s0 >> 7) & 3, s = s0 & 127, wc = s >> 5, fq = (s >> 3) & 3;
        const float scl = isk ? 0.08838834764831845f : 1.f;
        if (isc) {
#pragma unroll
            for (int i = 0; i < 8; ++i) o[i] = v[i] * scl;
        } else {
            const int pos = wc < 2 ? gr : gc;
            const float2* tb = p.tab128 + pos * 32 + (wc & 1) * 16 + fq * 4;
#pragma unroll
            for (int j = 0; j < 4; ++j) { const float2 cs = tb[j]; const float x1 = v[j] * scl, x2 = v[4 + j] * scl; o[j] = x1 * cs.x - x2 * cs.y; o[4 + j] = x1 * cs.y + x2 * cs.x; }
        }
        bf16_t* dst = isk ? p.rk + ((size_t)(b * 4 + head) * KVROWS + (isc ? 4096 + t : t)) * 128 + s
                          : p.rq + ((size_t)(b * 4 + head) * 4096 + t) * 128 + s;
        store8(dst, o);
    } else if (s0 < 1536) {
        const int head = (s0 - 1024) >> 7, s = s0 & 127;
        store8(p.rv + ((size_t)(b * 4 + head) * KVROWS + (isc ? 4096 + t : t)) * 128 + s, v);
    } else if (s0 < 2048) {
        if (isc) return;
#pragma unroll
        for (int i = 0; i < 8; ++i) o[i] = silu_f(v[i]);
        store8(p.rg + (size_t)row * 512 + (s0 - 1536), o);
    } else if (s0 < 2688) {
        const bool isk = s0 >= 2560;
        if (!isk && isc) return;
        const int head = isk ? (s0 - 2560) >> 6 : (s0 - 2048) >> 6, s = s0 & 63, w = s >> 5, fq = (s >> 3) & 3;
        const float scl = isk ? 1.f : 0.125f;
        if (isc) {
#pragma unroll
            for (int i = 0; i < 8; ++i) o[i] = v[i];
        } else {
            const int pos = w == 0 ? gr : gc;
            const float2* tb = p.tab64 + pos * 16 + fq * 4;
#pragma unroll
            for (int j = 0; j < 4; ++j) { const float2 cs = tb[j]; const float x1 = v[j] * scl, x2 = v[4 + j] * scl; o[j] = x1 * cs.x - x2 * cs.y; o[4 + j] = x1 * cs.y + x2 * cs.x; }
        }
        bf16_t* dst = isk ? p.ak + ((size_t)(b * 2 + head) * KVROWS + (isc ? t : 256 + t)) * 64 + s
                          : p.aq + ((size_t)(b * 8 + head) * 4096 + t) * 64 + s;
        store8(dst, o);
    } else if (s0 < 2816) {
        const int head = (s0 - 2688) >> 6, s = s0 & 63;
        store8(p.av + ((size_t)(b * 2 + head) * KVROWS + (isc ? t : 256 + t)) * 64 + s, v);
    } else {
        if (isc) return;
#pragma unroll
        for (int i = 0; i < 8; ++i) o[i] = silu_f(v[i]);
        store8(p.ag + (size_t)row * 512 + (s0 - 2816), o);
    }
}

__device__ void ph_mod(const Params& p, float* lds) {
    const int tid = otid();
    float* sc = lds;
    float* red = lds + 9216;
    if (blockIdx.x < 192) {
        for (int i = tid; i < 9 * 1024; i += NT) {
            const int v = i >> 10, k = i & 1023;
            const float cv = v < 8 ? p.c[v * 1024 + k] : p.c_ctx[k];
            sc[i] = cv / (1.f + expf(-cv));
        }
        __syncthreads();
        for (int item = blockIdx.x; item < 192; item += gridDim.x) {
            const int cl = tid & 15, kg = tid >> 4, col = item * 16 + cl;
            float acc[9];
#pragma unroll
            for (int v = 0; v < 9; ++v) acc[v] = 0.f;
#pragma unroll 4
            for (int kk = 0; kk < 32; ++kk) {
                const int k = kg * 32 + kk;
                const float w = p.w_ada[(size_t)k * 3072 + col];
#pragma unroll
                for (int v = 0; v < 9; ++v) acc[v] += sc[v * 1024 + k] * w;
            }
#pragma unroll
            for (int v = 0; v < 9; ++v) red[(kg * 9 + v) * 16 + cl] = acc[v];
            __syncthreads();
            if (tid < 144) {
                const int v = tid >> 4;
                float s = 0.f;
                for (int g2 = 0; g2 < 32; ++g2) s += red[(g2 * 9 + v) * 16 + cl];
                p.mod[v * 3072 + col] = s + p.b_ada[col];
            }
            __syncthreads();
        }
    }
    const int gt = blockIdx.x * NT + tid;
    if (gt < 2048) { const int pos = gt >> 5, f = gt & 31; const float a = (float)pos * powf(10000.f, -(float)f / 32.f); p.tab128[gt] = make_float2(cosf(a), sinf(a)); }
    else if (gt < 3072) { const int g2 = gt - 2048, pos = g2 >> 4, f = g2 & 15; const float a = (float)pos * powf(10000.f, -(float)f / 16.f); p.tab64[g2] = make_float2(cosf(a), sinf(a)); }
}

__device__ void ph_h(const Params& p) {
    const int tid = otid(), wave = tid >> 6, lane = tid & 63;
    for (int row = blockIdx.x * 8 + wave; row < MROWS; row += gridDim.x * 8) {
        const float* src; int v;
        if (row < 32768) { src = p.x + (size_t)row * 1024; v = row >> 12; } else { src = p.ctx + (size_t)(row - 32768) * 1024; v = 8; }
        float4 xv[4]; float ss = 0.f;
#pragma unroll
        for (int i = 0; i < 4; ++i) { xv[i] = *(const float4*)(src + i * 256 + lane * 4); ss += xv[i].x * xv[i].x + xv[i].y * xv[i].y + xv[i].z * xv[i].z + xv[i].w * xv[i].w; }
        ss = wave_sum(ss);
        const float rstd = rsqrtf(ss * (1.f / 1024.f) + 1e-6f);
        const float* sh = p.mod + v * 3072; const float* sc = sh + 1024;
#pragma unroll
        for (int i = 0; i < 4; ++i) {
            const int col = i * 256 + lane * 4;
            const float4 s4 = *(const float4*)(sc + col), h4 = *(const float4*)(sh + col);
            uint2 u;
            u.x = pack2(xv[i].x * rstd * (1.f + s4.x) + h4.x, xv[i].y * rstd * (1.f + s4.y) + h4.y);
            u.y = pack2(xv[i].z * rstd * (1.f + s4.z) + h4.z, xv[i].w * rstd * (1.f + s4.w) + h4.w);
            *(uint2*)(p.h + (size_t)row * 1024 + col) = u;
        }
    }
}

template <int MODE> __device__ void ph_gemm_naive(const Params& p, float* lds) {
    const bf16_t* A = MODE == 0 ? p.h : p.mixed;
    const float* Bm = MODE == 0 ? p.w_in : p.w_out;
    constexpr int ldb = MODE == 0 ? 3328 : 1024;
    constexpr int nrt = (MODE == 0 ? MROWS : 32768) / 64, nct = ldb / 128;
    float* As = lds;
    float* Bs = lds + 32 * 65;
    const int tid = threadIdx.x, ty = tid >> 4, tx = tid & 15;
    for (int tile = blockIdx.x; tile < nrt * nct; tile += gridDim.x) {
        const int rt = tile / nct, ct = tile % nct;
        float acc[2][8];
#pragma unroll
        for (int r = 0; r < 2; ++r)
#pragma unroll
            for (int t = 0; t < 8; ++t) acc[r][t] = 0.f;
        int bc[8];
#pragma unroll
        for (int i = 0; i < 8; ++i) { const int cc = (tid + NT * i) & 127; const int sg = ct * 128 + cc; bc[i] = MODE == 0 ? ocol_in(sg) : sg; }
        for (int k0 = 0; k0 < 1024; k0 += 32) {
#pragma unroll
            for (int i = 0; i < 4; ++i) { const int e = tid + NT * i, r = e >> 5, kk = e & 31; As[kk * 65 + r] = bf2f(A[(size_t)(rt * 64 + r) * 1024 + k0 + kk]); }
#pragma unroll
            for (int i = 0; i < 8; ++i) { const int e = tid + NT * i, kk = e >> 7, cc = e & 127; Bs[kk * 129 + cc] = Bm[(size_t)(k0 + kk) * ldb + bc[i]]; }
            __syncthreads();
#pragma unroll 4
            for (int kk = 0; kk < 32; ++kk) {
                const float a0 = As[kk * 65 + ty * 2], a1 = As[kk * 65 + ty * 2 + 1];
#pragma unroll
                for (int t = 0; t < 8; ++t) { const float bv = Bs[kk * 129 + tx * 8 + t]; acc[0][t] += a0 * bv; acc[1][t] += a1 * bv; }
            }
            __syncthreads();
        }
#pragma unroll
        for (int r = 0; r < 2; ++r) {
            const int row = rt * 64 + ty * 2 + r, s0 = ct * 128 + tx * 8;
            if (MODE == 0) epi_in8(p, row, s0, acc[r]);
            else {
                const int b = row >> 12;
                const float* gate = p.mod + b * 3072 + 2048 + s0;
                const float* xr = p.x + (size_t)row * 1024 + s0;
                float* orow = p.out + (size_t)row * 1024 + s0;
#pragma unroll
                for (int t = 0; t < 8; ++t) orow[t] = xr[t] + gate[t] * acc[r][t];
            }
        }
    }
}


__device__ void ph_wconv(const Params& p, float* lds) {
    const int tid = otid();
    for (int item = blockIdx.x; item < 544; item += gridDim.x) {
        const bool isin = item < 416; const int it = isin ? item : item - 416;
        const int win = it >> 4, kb = it & 15; const int ld = isin ? 3328 : 1024;
        const float* W = (isin ? p.w_in : p.w_out) + (size_t)(kb * 64) * ld + win * 128;
#pragma unroll
        for (int i = 0; i < 16; ++i) { const int e = tid + NT * i, k = e >> 7, c = e & 127; lds[k * 129 + c] = W[(size_t)k * ld + c]; }
        __syncthreads();
#pragma unroll
        for (int i = 0; i < 2; ++i) {
            const int e = tid + NT * i, pp = e >> 3, k8 = e & 7;
            const int pglob = win * 128 + pp;
            int col = pp;
            if (isin) {
                const int pos = pglob & 255;
                const int slot = (pos & ~31) | (((pos >> 2) & 3) << 3) | (((pos >> 4) & 1) << 2) | (pos & 3);
                col = ocol_in((pglob & ~255) + slot) - win * 128;
            }
            float o[8];
#pragma unroll
            for (int t = 0; t < 8; ++t) o[t] = lds[(k8 * 8 + t) * 129 + col];
            store8((isin ? p.WinT : p.WoutT) + (size_t)pglob * 1024 + kb * 64 + k8 * 8, o);
        }
        __syncthreads();
    }
}

namespace pg8 {
#define PG8_LAS __attribute__((address_space(3)))
typedef short bf16x8 __attribute__((ext_vector_type(8)));
typedef float f32x4 __attribute__((ext_vector_type(4)));
constexpr int BM = 256, BK = 64, HALF = 128, HTB = HALF * BK * 2, STAGE_BYTES = 8 * HTB, NXCD = 8, WGM = 8;
__device__ __forceinline__ int lds_byte(int r, int c) { const int st = (r >> 4) * 2 + (c >> 5), rr = r & 15, cc = c & 31, ob = rr * 64 + cc * 2; return st * 1024 + (ob ^ (((ob >> 9) & 1) << 5)); }
__device__ __forceinline__ void stage_rc(int b, int& R, int& C) { const int st = b / 1024, sb = b % 1024, swz = sb ^ (((sb >> 9) & 1) << 5); R = (st >> 1) * 16 + swz / 64; C = (st & 1) * 32 + (swz % 64) / 2; }
struct Unit { int pm, pn; };
struct Gemm { const bf16_t* A; const bf16_t* Bt; int K; };
__device__ __forceinline__ void static_unit(int wgid, int nM, int nN, Unit& u) {
    const int nwg = nM * nN;
    { const int q = nwg / NXCD, r = nwg % NXCD, xcd = wgid % NXCD, off = wgid / NXCD; wgid = (xcd < r ? xcd * (q + 1) : r * (q + 1) + (xcd - r) * q) + off; }
    const int nig = WGM * nN, gid = wgid / nig, fm = gid * WGM, gsz = (nM - fm) < WGM ? (nM - fm) : WGM;
    u.pm = fm + ((wgid % nig) % gsz); u.pn = (wgid % nig) / gsz;
}
struct SchedIn {
    int G, c;
    __device__ __forceinline__ bool next(int i, Unit& u) const {
        const int L = i * G + c;
        if (L < 1664) { static_unit(L, 128, 13, u); return true; }
        if (L < 1704) { const int q = L - 1664, r = q % 5; u.pm = 128 + q / 5; u.pn = r < 4 ? 2 + r : 10; return true; }
        return false;
    }
};
struct SchedOut {
    int G, c;
    __device__ __forceinline__ bool next(int i, Unit& u) const {
        const int L = i * G + c;
        if (L < 512) { static_unit(L, 128, 4, u); return true; }
        return false;
    }
};
struct EpiIn {
    const Params* p;
    __device__ __forceinline__ void operator()(const f32x4 (&acc)[2][2][4][2], const Unit& u, int wr, int wc, int fr, int fq) const {
#pragma unroll
        for (int ai = 0; ai < 2; ++ai)
#pragma unroll
            for (int m = 0; m < 4; ++m) {
                const int row = u.pm * BM + ai * HALF + wr * 64 + m * 16 + fr;
#pragma unroll
                for (int bj = 0; bj < 2; ++bj) {
                    const int s0 = u.pn * BM + bj * HALF + wc * 32 + fq * 8;
                    float v[8];
#pragma unroll
                    for (int j = 0; j < 4; ++j) { v[j] = acc[ai][bj][m][0][j]; v[4 + j] = acc[ai][bj][m][1][j]; }
                    epi_in8(*p, row, s0, v);
                }
            }
    }
};
struct EpiOut {
    const Params* p;
    __device__ __forceinline__ void operator()(const f32x4 (&acc)[2][2][4][2], const Unit& u, int wr, int wc, int fr, int fq) const {
        const int b = (u.pm * BM) >> 12;
        f32x4 gv[2][2];
#pragma unroll
        for (int bj = 0; bj < 2; ++bj)
#pragma unroll
            for (int n = 0; n < 2; ++n) gv[bj][n] = *(const f32x4*)(p->mod + b * 3072 + 2048 + u.pn * BM + bj * HALF + wc * 32 + n * 16 + fq * 4);
#pragma unroll
        for (int ai = 0; ai < 2; ++ai)
#pragma unroll
            for (int m = 0; m < 4; ++m) {
                const size_t rowoff = (size_t)(u.pm * BM + ai * HALF + wr * 64 + m * 16 + fr) * 1024 + u.pn * BM + wc * 32 + fq * 4;
#pragma unroll
                for (int bj = 0; bj < 2; ++bj)
#pragma unroll
                    for (int n = 0; n < 2; ++n) {
                        const f32x4 xv = *(const f32x4*)(p->x + rowoff + bj * HALF + n * 16);
                        *(f32x4*)(p->out + rowoff + bj * HALF + n * 16) = xv + gv[bj][n] * acc[ai][bj][m][n];
                    }
            }
    }
};

template <class Epi, class Sched>
__device__ __forceinline__ void gemm_phase(PG8_LAS unsigned char* lds, const Gemm g, const Sched& S, const Epi& E) {
    const int tid = otid(), wid = __builtin_amdgcn_readfirstlane(tid >> 6), lane = tid & 63, wr = wid >> 2, wc = wid & 3, fr = lane & 15, fq = lane >> 4;
    const int K = g.K, nt = K / BK;
    unsigned voffA[2];
#pragma unroll
    for (int i = 0; i < 2; ++i) { int R, C; stage_rc(tid * 16 + i * 8192, R, C); voffA[i] = (unsigned)(R * K + C) * 2u; }
    const size_t kstep = (size_t)(BK * 2);
    const size_t hstep = (size_t)HALF * K * 2;
    const size_t tstep = 2 * hstep;
    const unsigned ldsw = (unsigned)wid * 1024u;
    const int aoff = lds_byte(wr * 64 + fr, fq * 8), boff = lds_byte(wc * 32 + fr, fq * 8);
#define PG8_SA(b, h) (((b) * 2 + (h)) * HTB)
#define PG8_SB(b, h) ((4 + (b) * 2 + (h)) * HTB)
#define PG8_STAGE(bufoff, gbase) do { _Pragma("unroll") for (int _i = 0; _i < 2; ++_i) \
        __builtin_amdgcn_global_load_lds((const unsigned*)((const char*)(gbase) + voffA[_i]), (PG8_LAS unsigned*)(lds + (bufoff) + ldsw + _i * 8192), 16, 0, 0); } while (0)
#define PG8_LDA(dst, b, h) do { _Pragma("unroll") for (int m = 0; m < 4; ++m) _Pragma("unroll") for (int k = 0; k < 2; ++k) dst[m][k] = *(const PG8_LAS bf16x8*)(lds + PG8_SA(b, h) + aoff + m * 2048 + k * 1024); } while (0)
#define PG8_LDB(dst, b, h) do { _Pragma("unroll") for (int n = 0; n < 2; ++n) _Pragma("unroll") for (int k = 0; k < 2; ++k) dst[n][k] = *(const PG8_LAS bf16x8*)(lds + PG8_SB(b, h) + boff + n * 2048 + k * 1024); } while (0)
#define PG8_MMA(ai, bj, At, Bt) do { __builtin_amdgcn_s_setprio(1); _Pragma("unroll") for (int m = 0; m < 4; ++m) _Pragma("unroll") for (int n = 0; n < 2; ++n) _Pragma("unroll") for (int k = 0; k < 2; ++k) \
        acc[ai][bj][m][n] = __builtin_amdgcn_mfma_f32_16x16x32_bf16(Bt[n][k], At[m][k], acc[ai][bj][m][n], 0, 0, 0); __builtin_amdgcn_s_setprio(0); } while (0)
#define PG8_WAIT_V(n) asm volatile("s_waitcnt vmcnt(" #n ")" ::: "memory")
#define PG8_WAIT_L(n) asm volatile("s_waitcnt lgkmcnt(" #n ")" ::: "memory")
#define PG8_BAR __builtin_amdgcn_s_barrier()
#define PG8_SCHED __builtin_amdgcn_sched_barrier(0)
    Unit cur, nxt; int ui = 0;
    if (!S.next(0, cur)) return;
    f32x4 acc[2][2][4][2];
#pragma unroll
    for (int a = 0; a < 2; ++a)
#pragma unroll
        for (int b = 0; b < 2; ++b)
#pragma unroll
            for (int m = 0; m < 4; ++m)
#pragma unroll
                for (int n = 0; n < 2; ++n) acc[a][b][m][n] = (f32x4){0.f, 0.f, 0.f, 0.f};
    bf16x8 At[4][2], B0[2][2], B1[2][2];
    const char* cA = (const char*)g.A + (size_t)cur.pm * tstep; const char* cB = (const char*)g.Bt + (size_t)cur.pn * tstep;
    PG8_STAGE(PG8_SB(0, 0), cB); PG8_STAGE(PG8_SA(0, 0), cA); PG8_STAGE(PG8_SB(0, 1), cB + hstep); PG8_STAGE(PG8_SA(0, 1), cA + hstep);
    if (wr == 1) PG8_BAR;
    PG8_WAIT_V(4); PG8_BAR;
    PG8_STAGE(PG8_SB(1, 0), cB + kstep); PG8_STAGE(PG8_SA(1, 0), cA + kstep); PG8_STAGE(PG8_SB(1, 1), cB + hstep + kstep);
    PG8_WAIT_V(6); PG8_BAR;
    for (;;) {
        const bool has_next = S.next(ui + 1, nxt);
        const char* nA = has_next ? (const char*)g.A + (size_t)nxt.pm * tstep : cA; const char* nB = has_next ? (const char*)g.Bt + (size_t)nxt.pn * tstep : cB;
        for (int t = 0; t < nt; t += 2) {
            const bool last = (t == nt - 2);
            const char* a1 = cA + (size_t)(t + 1) * kstep;
            const char* a2 = last ? nA : cA + (size_t)(t + 2) * kstep; const char* b2 = last ? nB : cB + (size_t)(t + 2) * kstep;
            const char* a3 = a2 + kstep; const char* b3 = b2 + kstep;
            PG8_LDB(B0, 0, 0); PG8_SCHED; PG8_LDA(At, 0, 0); PG8_STAGE(PG8_SA(1, 1), a1 + hstep);
            PG8_WAIT_L(8); PG8_BAR; PG8_WAIT_L(0); PG8_MMA(0, 0, At, B0); PG8_BAR; PG8_SCHED;
            PG8_LDB(B1, 0, 1); PG8_STAGE(PG8_SB(0, 0), b2);
            PG8_BAR; PG8_WAIT_L(0); PG8_MMA(0, 1, At, B1); PG8_BAR;
            PG8_LDA(At, 0, 1); PG8_STAGE(PG8_SA(0, 0), a2);
            PG8_BAR; PG8_WAIT_L(0); PG8_MMA(1, 0, At, B0); PG8_BAR; PG8_SCHED;
            PG8_STAGE(PG8_SB(0, 1), b2 + hstep);
            PG8_WAIT_V(6); PG8_BAR; PG8_MMA(1, 1, At, B1); PG8_BAR;
            PG8_LDB(B0, 1, 0); PG8_SCHED; PG8_LDA(At, 1, 0); PG8_STAGE(PG8_SA(0, 1), a2 + hstep);
            PG8_WAIT_L(8); PG8_BAR; PG8_WAIT_L(0); PG8_MMA(0, 0, At, B0); PG8_BAR; PG8_SCHED;
            PG8_LDB(B1, 1, 1); PG8_STAGE(PG8_SB(1, 0), b3);
            PG8_BAR; PG8_WAIT_L(0); PG8_MMA(0, 1, At, B1); PG8_BAR;
            PG8_LDA(At, 1, 1); PG8_STAGE(PG8_SA(1, 0), a3);
            PG8_BAR; PG8_WAIT_L(0); PG8_MMA(1, 0, At, B0); PG8_BAR; PG8_SCHED;
            PG8_STAGE(PG8_SB(1, 1), b3 + hstep);
            PG8_WAIT_V(6); PG8_BAR; PG8_MMA(1, 1, At, B1); PG8_BAR;
        }
        E(acc, cur, wr, wc, fr, fq);
        if (!has_next) break;
#pragma unroll
        for (int a = 0; a < 2; ++a)
#pragma unroll
            for (int b = 0; b < 2; ++b)
#pragma unroll
                for (int m = 0; m < 4; ++m)
#pragma unroll
                    for (int n = 0; n < 2; ++n) acc[a][b][m][n] = (f32x4){0.f, 0.f, 0.f, 0.f};
        cur = nxt; cA = nA; cB = nB; ++ui;
    }
    PG8_WAIT_V(0);
    if (wr == 0) PG8_BAR;
    PG8_BAR;
#undef PG8_SA
#undef PG8_SB
#undef PG8_STAGE
#undef PG8_LDA
#undef PG8_LDB
#undef PG8_MMA
#undef PG8_WAIT_V
#undef PG8_WAIT_L
#undef PG8_BAR
#undef PG8_SCHED
}
}

__device__ __forceinline__ void ph_gemm_in(const Params& p, float* lds) {
    pg8::Gemm g{p.h, p.WinT, 1024}; pg8::SchedIn S{(int)gridDim.x, (int)blockIdx.x}; pg8::EpiIn E{&p};
    pg8::gemm_phase(( PG8_LAS unsigned char*)lds, g, S, E);
}
__device__ __forceinline__ void ph_gemm_out(const Params& p, float* lds) {
    pg8::Gemm g{p.mixed, p.WoutT, 1024}; pg8::SchedOut S{(int)gridDim.x, (int)blockIdx.x}; pg8::EpiOut E{&p};
    pg8::gemm_phase((PG8_LAS unsigned char*)lds, g, S, E);
}


#define LAS __attribute__((address_space(3)))
typedef LAS unsigned char* ldsp;
typedef short bf16x8_t __attribute__((ext_vector_type(8)));
typedef float f32x4_t __attribute__((ext_vector_type(4)));
typedef unsigned u32x4_t __attribute__((ext_vector_type(4)));
typedef unsigned u32x2_t __attribute__((ext_vector_type(2)));
#define MFMA16(a, b, c) __builtin_amdgcn_mfma_f32_16x16x32_bf16(a, b, c, 0, 0, 0)
__device__ __forceinline__ int toff(int r, int c) { return r * 256 + ((((c >> 3) ^ (r & 15)) << 4) | ((c & 7) << 1)); }
__device__ __forceinline__ bf16x8_t ldfrag(ldsp tile, int r, int kk, int fq) { return *(const LAS bf16x8_t*)(tile + toff(r, 32 * kk + 8 * fq)); }
__device__ __forceinline__ void stage_tile(ldsp dst, const bf16_t* src, int tid) {
#pragma unroll
    for (int i = 0; i < 4; ++i) { const int idx = tid + NT * i, r = idx >> 4, c = idx & 15; const u32x4_t v = *(const u32x4_t*)(src + (size_t)idx * 8); *(LAS u32x4_t*)(dst + r * 256 + ((c ^ (r & 15)) << 4)) = v; }
}
__device__ __forceinline__ void stage_tileT(ldsp dst, const bf16_t* src, int tid) {
    const int jj = tid & 63, c0 = tid >> 6;
#pragma unroll
    for (int ps = 0; ps < 2; ++ps) {
        const int c = c0 + 8 * ps;
        const u32x4_t aw = *(const u32x4_t*)(src + (2 * jj) * 128 + c * 8), bw = *(const u32x4_t*)(src + (2 * jj + 1) * 128 + c * 8);
#pragma unroll
        for (int i = 0; i < 8; ++i) {
            const int e = 8 * c + i;
            const unsigned lo = (i & 1) ? (aw[i >> 1] >> 16) : (aw[i >> 1] & 0xffffu), hi = (i & 1) ? (bw[i >> 1] & 0xffff0000u) : (bw[i >> 1] << 16);
            *(LAS unsigned*)(dst + e * 256 + ((((jj >> 2) ^ (e & 15)) << 4) | ((jj & 3) << 2))) = lo | hi;
        }
    }
}

__device__ void ph_states(const Params& p, ldsp lds) {
    const int tid = otid(), w = tid >> 6, lane = tid & 63, fr = lane & 15, fq = lane >> 4;
    ldsp bKf = lds, bKb = lds + 32768, bV = lds + 65536;
    for (int item = blockIdx.x; item < 32 * 34; item += gridDim.x) {
        const int bh = item / 34, c = item % 34, h = bh & 3;
        const float lgf = lgam(p, 0, h), lgb = lgam(p, 1, h);
        const bf16_t* K = p.rk + ((size_t)bh * KVROWS + c * 128) * 128;
        const bf16_t* V = p.rv + ((size_t)bh * KVROWS + c * 128) * 128;
        stage_tileT(bV, V, tid);
        {
            const int jj = tid & 63, c0 = tid >> 6;
            const float wf0 = __expf(lgf * (float)(127 - 2 * jj)), wf1 = __expf(lgf * (float)(126 - 2 * jj));
            const float wb0 = __expf(lgb * (float)(2 * jj)), wb1 = __expf(lgb * (float)(2 * jj + 1));
#pragma unroll
            for (int ps = 0; ps < 2; ++ps) {
                const int cc = c0 + 8 * ps;
                float a[8], b[8]; load8(K + (2 * jj) * 128 + cc * 8, a); load8(K + (2 * jj + 1) * 128 + cc * 8, b);
#pragma unroll
                for (int i = 0; i < 8; ++i) {
                    const int e = 8 * cc + i, off = e * 256 + ((((jj >> 2) ^ (e & 15)) << 4) | ((jj & 3) << 2));
                    *(LAS unsigned*)(bKf + off) = pack2(a[i] * wf0, b[i] * wf1);
                    *(LAS unsigned*)(bKb + off) = pack2(a[i] * wb0, b[i] * wb1);
                }
            }
        }
        __syncthreads();
        f32x4_t af[8], ab[8];
#pragma unroll
        for (int i = 0; i < 8; ++i) { af[i] = (f32x4_t){0.f, 0.f, 0.f, 0.f}; ab[i] = (f32x4_t){0.f, 0.f, 0.f, 0.f}; }
#pragma unroll 1
        for (int kk = 0; kk < 4; ++kk) {
            const bf16x8_t xf = ldfrag(bKf, 16 * w + fr, kk, fq), xb = ldfrag(bKb, 16 * w + fr, kk, fq);
#pragma unroll
            for (int nt = 0; nt < 8; ++nt) { const bf16x8_t bv = ldfrag(bV, 16 * nt + fr, kk, fq); af[nt] = MFMA16(xf, bv, af[nt]); ab[nt] = MFMA16(xb, bv, ab[nt]); }
        }
#pragma unroll
        for (int nt = 0; nt < 8; ++nt) {
            const size_t o = ((size_t)item * 128 + 16 * nt + fr) * 128 + 16 * w + 4 * fq;
            uint2 u; u.x = pack2(af[nt][0], af[nt][1]); u.y = pack2(af[nt][2], af[nt][3]); *(uint2*)(p.Kf + o) = u;
            u.x = pack2(ab[nt][0], ab[nt][1]); u.y = pack2(ab[nt][2], ab[nt][3]); *(uint2*)(p.Kb + o) = u;
        }
        __syncthreads();
    }
}

__device__ void ph_retout(const Params& p, ldsp lds) {
    const int tid = otid(), w = tid >> 6, lane = tid & 63, fr = lane & 15, fq = lane >> 4;
    ldsp bQ = lds, bK = lds + 32768, bV = lds + 65536, bR = lds + 98304;
    for (int item = blockIdx.x; item < 1024; item += gridDim.x) {
        const int bh = item >> 5, n = item & 31, b = bh >> 2, h = bh & 3;
        const float lgf = lgam(p, 0, h), lgb = lgam(p, 1, h);
        const bf16_t* Q = p.rq + ((size_t)bh * 4096 + n * 128) * 128;
        const bf16_t* K = p.rk + ((size_t)bh * KVROWS + n * 128) * 128;
        const bf16_t* V = p.rv + ((size_t)bh * KVROWS + n * 128) * 128;
        const bf16_t* RF = p.Rf + (size_t)(bh * 32 + n) * 16384;
        const bf16_t* RB = p.Rb + (size_t)(bh * 32 + n) * 16384;
        stage_tile(bQ, Q, tid); stage_tile(bK, K, tid); stage_tileT(bV, V, tid); stage_tile(bR, RF, tid);
        __syncthreads();
        f32x4_t s[8];
#pragma unroll
        for (int i = 0; i < 8; ++i) s[i] = (f32x4_t){0.f, 0.f, 0.f, 0.f};
#pragma unroll 1
        for (int kk = 0; kk < 4; ++kk) {
            const bf16x8_t a = ldfrag(bK, 16 * w + fr, kk, fq);
#pragma unroll
            for (int nt = 0; nt < 8; ++nt) { const bf16x8_t bq = ldfrag(bQ, 16 * nt + fr, kk, fq); s[nt] = MFMA16(a, bq, s[nt]); }
        }
        u32x4_t rbreg[4];
#pragma unroll
        for (int i = 0; i < 4; ++i) rbreg[i] = *(const u32x4_t*)(RB + (size_t)(tid + NT * i) * 8);
        __syncthreads();
#pragma unroll
        for (int nt = 0; nt < 8; ++nt) {
            const int i = 16 * nt + fr; float o[4];
#pragma unroll
            for (int r = 0; r < 4; ++r) { const int dlt = i - (16 * w + 4 * fq + r); const float dec = dlt >= 0 ? __expf(lgf * (float)dlt) : __expf(lgb * (float)(-dlt)); o[r] = s[nt][r] * dec; }
            u32x2_t u; u.x = pack2(o[0], o[1]); u.y = pack2(o[2], o[3]);
            *(LAS u32x2_t*)(bK + toff(i, 16 * w + 4 * fq)) = u;
        }
        __syncthreads();
        f32x4_t y[8], ca[8];
#pragma unroll
        for (int i = 0; i < 8; ++i) { y[i] = (f32x4_t){0.f, 0.f, 0.f, 0.f}; ca[i] = (f32x4_t){0.f, 0.f, 0.f, 0.f}; }
#pragma unroll 1
        for (int kk = 0; kk < 4; ++kk) {
            const bf16x8_t bs = ldfrag(bK, 16 * w + fr, kk, fq), bq = ldfrag(bQ, 16 * w + fr, kk, fq);
#pragma unroll
            for (int mt = 0; mt < 8; ++mt) {
                y[mt] = MFMA16(ldfrag(bV, 16 * mt + fr, kk, fq), bs, y[mt]);
                ca[mt] = MFMA16(ldfrag(bR, 16 * mt + fr, kk, fq), bq, ca[mt]);
            }
        }
        const int ip = 16 * w + fr;
        {
            const float cfs = __expf(lgf * (float)(ip + 1));
#pragma unroll
            for (int mt = 0; mt < 8; ++mt) { y[mt] += cfs * ca[mt]; ca[mt] = (f32x4_t){0.f, 0.f, 0.f, 0.f}; }
        }
        __syncthreads();
#pragma unroll
        for (int i = 0; i < 4; ++i) { const int idx = tid + NT * i, r = idx >> 4, c = idx & 15; *(LAS u32x4_t*)(bV + r * 256 + ((c ^ (r & 15)) << 4)) = rbreg[i]; }
        __syncthreads();
#pragma unroll 1
        for (int kk = 0; kk < 4; ++kk) {
            const bf16x8_t bq = ldfrag(bQ, 16 * w + fr, kk, fq);
#pragma unroll
            for (int mt = 0; mt < 8; ++mt) ca[mt] = MFMA16(ldfrag(bV, 16 * mt + fr, kk, fq), bq, ca[mt]);
        }
        const float cbs = __expf(lgb * (float)(128 - ip));
        float sum = 0.f;
#pragma unroll
        for (int mt = 0; mt < 8; ++mt) { y[mt] += cbs * ca[mt]; sum += y[mt][0] + y[mt][1] + y[mt][2] + y[mt][3]; }
        sum += __shfl_xor(sum, 16); sum += __shfl_xor(sum, 32);
        const float mu = sum * (1.f / 128.f);
        float vs = 0.f;
#pragma unroll
        for (int mt = 0; mt < 8; ++mt)
#pragma unroll
            for (int r = 0; r < 4; ++r) { const float dl = y[mt][r] - mu; vs += dl * dl; }
        vs += __shfl_xor(vs, 16); vs += __shfl_xor(vs, 32);
        const float rs = rsqrtf(vs * (1.f / 128.f) + 1e-6f);
        const size_t row = (size_t)b * 4096 + n * 128 + ip;
#pragma unroll
        for (int mt = 0; mt < 8; ++mt) {
            const int col = h * 128 + 16 * mt + 4 * fq;
            const uint2 g = *(const uint2*)(p.rg + row * 512 + col);
            const float4 gw = *(const float4*)(p.gn_w + col);
            const float o0 = (y[mt][0] - mu) * rs * gw.x * __uint_as_float(g.x << 16), o1 = (y[mt][1] - mu) * rs * gw.y * __uint_as_float(g.x & 0xffff0000u);
            const float o2 = (y[mt][2] - mu) * rs * gw.z * __uint_as_float(g.y << 16), o3 = (y[mt][3] - mu) * rs * gw.w * __uint_as_float(g.y & 0xffff0000u);
            uint2 u; u.x = pack2(o0, o1); u.y = pack2(o2, o3);
            *(uint2*)(p.mixed + row * 1024 + col) = u;
        }
        __syncthreads();
    }
}


__device__ __forceinline__ int koff(int r, int c) { return r * 128 + ((((c >> 3) ^ ((r >> 1) & 7)) << 4) | ((c & 7) << 1)); }
__device__ void ph_attn(const Params& p, ldsp lds) {
    const int tid = otid(), w = tid >> 6, lane = tid & 63, fr = lane & 15, fq = lane >> 4;
    const int g = w >> 1, sub = w & 1;
    int cnt = 0;
    for (int item = blockIdx.x; item < 1024; item += gridDim.x) {
        const int half = item & 1, nb = (item >> 1) & 31, bk = item >> 6, qoff = 64 * half + 32 * sub, b = bk >> 1, kvh = bk & 1, qh = kvh * 4 + g;
        const bf16_t* Kg = p.ak + (size_t)bk * KVROWS * 64;
        const bf16_t* Vg = p.av + (size_t)bk * KVROWS * 64;
        bf16x8_t qf[2][2];
#pragma unroll
        for (int st = 0; st < 2; ++st)
#pragma unroll
            for (int kk = 0; kk < 2; ++kk) qf[st][kk] = *(const bf16x8_t*)(p.aq + ((size_t)(b * 8 + qh) * 4096 + nb * 128 + qoff + 16 * st + fr) * 64 + 32 * kk + 8 * fq);
        f32x4_t oacc[2][4]; float mrun[2], lrun[2];
        const float sink = p.sink[qh];
#pragma unroll
        for (int st = 0; st < 2; ++st) {
            mrun[st] = sink; lrun[st] = fq == 0 ? 1.f : 0.f;
#pragma unroll
            for (int mt = 0; mt < 4; ++mt) oacc[st][mt] = (f32x4_t){0.f, 0.f, 0.f, 0.f};
        }
#pragma unroll 1
        for (int ti = 0; ti < 5; ++ti) {
            if ((ti == 2 && nb == 0) || (ti == 4 && nb == 31)) continue;
            const int rowbase = ti < 2 ? ti * 128 : 256 + (nb + ti - 3) * 128;
            const int mode = ti == 2 ? 1 : (ti == 4 ? 2 : 0);
            ldsp kb = lds + (cnt & 1) * 32768, vb = kb + 16384; ++cnt;
#pragma unroll
            for (int i = 0; i < 2; ++i) {
                const int idx = tid + NT * i, r = idx >> 3, c = idx & 7;
                const u32x4_t v = *(const u32x4_t*)(Kg + (size_t)rowbase * 64 + (size_t)idx * 8);
                *(LAS u32x4_t*)(kb + r * 128 + ((c ^ ((r >> 1) & 7)) << 4)) = v;
            }
            {
                const int jj = tid & 63, c = tid >> 6;
                const u32x4_t aw = *(const u32x4_t*)(Vg + (size_t)(rowbase + 2 * jj) * 64 + c * 8), bw = *(const u32x4_t*)(Vg + (size_t)(rowbase + 2 * jj + 1) * 64 + c * 8);
#pragma unroll
                for (int i = 0; i < 8; ++i) {
                    const int e = 8 * c + i;
                    const unsigned lo = (i & 1) ? (aw[i >> 1] >> 16) : (aw[i >> 1] & 0xffffu), hi = (i & 1) ? (bw[i >> 1] & 0xffff0000u) : (bw[i >> 1] << 16);
                    *(LAS unsigned*)(vb + e * 256 + ((((jj >> 2) ^ (e & 15)) << 4) | ((jj & 3) << 2))) = lo | hi;
                }
            }
            __syncthreads();
#pragma unroll
            for (int st = 0; st < 2; ++st) {
                f32x4_t s[8];
#pragma unroll
                for (int mt = 0; mt < 8; ++mt) s[mt] = (f32x4_t){0.f, 0.f, 0.f, 0.f};
#pragma unroll
                for (int kk = 0; kk < 2; ++kk)
#pragma unroll
                    for (int mt = 0; mt < 8; ++mt) s[mt] = MFMA16(*(const LAS bf16x8_t*)(kb + koff(16 * mt + fr, 32 * kk + 8 * fq)), qf[st][kk], s[mt]);
                if (mode) {
                    const int qi = qoff + 16 * st + fr;
#pragma unroll
                    for (int mt = 0; mt < 8; ++mt)
#pragma unroll
                        for (int r = 0; r < 4; ++r) { const int kj = 16 * mt + 4 * fq + r; const bool ok = mode == 1 ? kj >= qi : kj <= qi; s[mt][r] = ok ? s[mt][r] : -1e30f; }
                }
                float mx = s[0][0];
#pragma unroll
                for (int mt = 0; mt < 8; ++mt)
#pragma unroll
                    for (int r = 0; r < 4; ++r) mx = fmaxf(mx, s[mt][r]);
                mx = fmaxf(mx, __shfl_xor(mx, 16)); mx = fmaxf(mx, __shfl_xor(mx, 32));
                const float mn = fmaxf(mrun[st], mx), sc = __expf(mrun[st] - mn);
                mrun[st] = mn;
                float ps = 0.f;
#pragma unroll
                for (int mt = 0; mt < 8; ++mt)
#pragma unroll
                    for (int r = 0; r < 4; ++r) { const float pv = __expf(s[mt][r] - mn); s[mt][r] = pv; ps += pv; }
                lrun[st] = lrun[st] * sc + ps;
#pragma unroll
                for (int mt = 0; mt < 4; ++mt) oacc[st][mt] *= sc;
#pragma unroll
                for (int kk = 0; kk < 4; ++kk) {
                    u32x4_t pu; pu.x = pack2(s[2 * kk][0], s[2 * kk][1]); pu.y = pack2(s[2 * kk][2], s[2 * kk][3]); pu.z = pack2(s[2 * kk + 1][0], s[2 * kk + 1][1]); pu.w = pack2(s[2 * kk + 1][2], s[2 * kk + 1][3]);
                    const bf16x8_t pf = __builtin_bit_cast(bf16x8_t, pu);
#pragma unroll
                    for (int mt = 0; mt < 4; ++mt) {
                        const u32x2_t lo = *(const LAS u32x2_t*)(vb + toff(16 * mt + fr, 32 * kk + 4 * fq)), hi = *(const LAS u32x2_t*)(vb + toff(16 * mt + fr, 32 * kk + 16 + 4 * fq));
                        u32x4_t au; au.x = lo.x; au.y = lo.y; au.z = hi.x; au.w = hi.y;
                        oacc[st][mt] = MFMA16(__builtin_bit_cast(bf16x8_t, au), pf, oacc[st][mt]);
                    }
                }
                __builtin_amdgcn_sched_barrier(0);
            }
        }
#pragma unroll
        for (int st = 0; st < 2; ++st) {
            float lt = lrun[st]; lt += __shfl_xor(lt, 16); lt += __shfl_xor(lt, 32);
            const float inv = 1.f / lt;
            const size_t row = (size_t)b * 4096 + nb * 128 + qoff + 16 * st + fr;
#pragma unroll
            for (int mt = 0; mt < 4; ++mt) {
                const int col = qh * 64 + 16 * mt + 4 * fq;
                const uint2 gt = *(const uint2*)(p.ag + row * 512 + col);
                const float o0 = oacc[st][mt][0] * inv * __uint_as_float(gt.x << 16), o1 = oacc[st][mt][1] * inv * __uint_as_float(gt.x & 0xffff0000u);
                const float o2 = oacc[st][mt][2] * inv * __uint_as_float(gt.y << 16), o3 = oacc[st][mt][3] * inv * __uint_as_float(gt.y & 0xffff0000u);
                uint2 u; u.x = pack2(o0, o1); u.y = pack2(o2, o3);
                *(uint2*)(p.mixed + row * 1024 + 512 + col) = u;
            }
        }
    }
    __syncthreads();
}

__device__ void ph_states_naive(const Params& p) {
    for (int item = blockIdx.x; item < 32 * 34; item += gridDim.x) {
        const int bh = item / 34, c = item % 34, h = bh & 3;
        const float lgf = lgam(p, 0, h), lgb = lgam(p, 1, h);
        const bf16_t* K = p.rk + ((size_t)bh * KVROWS + c * 128) * 128;
        const bf16_t* V = p.rv + ((size_t)bh * KVROWS + c * 128) * 128;
        const int e = threadIdx.x & 127, dg = threadIdx.x >> 7;
        float af[32], ab[32];
#pragma unroll
        for (int i = 0; i < 32; ++i) { af[i] = 0.f; ab[i] = 0.f; }
        for (int j = 0; j < 128; ++j) {
            const float vv = bf2f(V[j * 128 + e]);
            const float wf = expf(lgf * (float)(127 - j)) * vv, wb = expf(lgb * (float)j) * vv;
#pragma unroll
            for (int d8 = 0; d8 < 4; ++d8) {
                float kk[8]; load8(K + j * 128 + dg * 32 + d8 * 8, kk);
#pragma unroll
                for (int i = 0; i < 8; ++i) { af[d8 * 8 + i] += wf * kk[i]; ab[d8 * 8 + i] += wb * kk[i]; }
            }
        }
        bf16_t* of = p.Kf + ((size_t)item * 128 + e) * 128 + dg * 32;
        bf16_t* ob = p.Kb + ((size_t)item * 128 + e) * 128 + dg * 32;
#pragma unroll
        for (int d8 = 0; d8 < 4; ++d8) { store8(of + d8 * 8, af + d8 * 8); store8(ob + d8 * 8, ab + d8 * 8); }
    }
}

__device__ void ph_scan(const Params& p) {
    const int tid = otid();
    for (int blk = blockIdx.x; blk < 512; blk += gridDim.x) {
        const int dir = blk >> 8, bh = (blk >> 3) & 31, h = bh & 3;
        const unsigned el = (unsigned)((blk & 7) * NT + tid) * 4u;
        const float gC = expf(lgam(p, dir, h) * 128.f);
        const bf16_t* __restrict__ ks = (dir ? p.Kb : p.Kf) + (size_t)bh * 34 * 16384;
        bf16_t* __restrict__ rs = (dir ? p.Rb : p.Rf) + (size_t)bh * 32 * 16384;
        uint2 kv[34];
#pragma unroll
        for (int n = 0; n < 34; ++n) kv[n] = *(const uint2*)(ks + (size_t)n * 16384 + el);
        float R[4];
        auto cv = [](const uint2 u, float* o) { o[0] = __uint_as_float(u.x << 16); o[1] = __uint_as_float(u.x & 0xffff0000u); o[2] = __uint_as_float(u.y << 16); o[3] = __uint_as_float(u.y & 0xffff0000u); };
        float t[4];
        cv(dir ? kv[33] : kv[32], R); cv(dir ? kv[32] : kv[33], t);
#pragma unroll
        for (int i = 0; i < 4; ++i) R[i] = gC * R[i] + t[i];
#pragma unroll
        for (int s = 0; s < 32; ++s) {
            const int n = dir ? 31 - s : s;
            uint2 u; u.x = pack2(R[0], R[1]); u.y = pack2(R[2], R[3]);
            *(uint2*)(rs + (size_t)n * 16384 + el) = u;
            cv(dir ? kv[31 - s] : kv[s], t);
#pragma unroll
            for (int i = 0; i < 4; ++i) R[i] = gC * R[i] + t[i];
        }
    }
}

__device__ void ph_retout_naive(const Params& p, float* S) {
    for (int item = blockIdx.x; item < 1024; item += gridDim.x) {
        const int bh = item >> 5, n = item & 31, b = bh >> 2, h = bh & 3;
        const float lgf = lgam(p, 0, h), lgb = lgam(p, 1, h);
        const bf16_t* Q = p.rq + ((size_t)bh * 4096 + n * 128) * 128;
        const bf16_t* K = p.rk + ((size_t)bh * KVROWS + n * 128) * 128;
        const bf16_t* V = p.rv + ((size_t)bh * KVROWS + n * 128) * 128;
        const bf16_t* RF = p.Rf + (size_t)(bh * 32 + n) * 16384;
        const bf16_t* RB = p.Rb + (size_t)(bh * 32 + n) * 16384;
        const int i = threadIdx.x >> 2, q4 = threadIdx.x & 3;
        for (int jj = 0; jj < 32; ++jj) {
            const int j = q4 * 32 + jj;
            float dot = 0.f;
#pragma unroll 4
            for (int d8 = 0; d8 < 16; ++d8) {
                float a[8], bb[8]; load8(Q + i * 128 + d8 * 8, a); load8(K + j * 128 + d8 * 8, bb);
#pragma unroll
                for (int t = 0; t < 8; ++t) dot += a[t] * bb[t];
            }
            const float dec = j <= i ? expf(lgf * (float)(i - j)) : expf(lgb * (float)(j - i));
            S[i * 128 + ((j + i) & 127)] = dot * dec;
        }
        __syncthreads();
        float y[32];
#pragma unroll
        for (int t = 0; t < 32; ++t) y[t] = 0.f;
        const int e0 = q4 * 32;
        for (int j = 0; j < 128; ++j) {
            const float s = S[i * 128 + ((j + i) & 127)];
#pragma unroll
            for (int e8 = 0; e8 < 4; ++e8) {
                float vv[8]; load8(V + j * 128 + e0 + e8 * 8, vv);
#pragma unroll
                for (int t = 0; t < 8; ++t) y[e8 * 8 + t] += s * vv[t];
            }
        }
        const float cf = expf(lgf * (float)(i + 1)), cb = expf(lgb * (float)(128 - i));
#pragma unroll 1
        for (int d8 = 0; d8 < 16; ++d8) {
            float a[8]; load8(Q + i * 128 + d8 * 8, a);
#pragma unroll
            for (int ee = 0; ee < 32; ++ee) {
                float rf[8], rb[8]; load8(RF + (e0 + ee) * 128 + d8 * 8, rf); load8(RB + (e0 + ee) * 128 + d8 * 8, rb);
                float sf = 0.f, sb = 0.f;
#pragma unroll
                for (int t = 0; t < 8; ++t) { sf += a[t] * rf[t]; sb += a[t] * rb[t]; }
                y[ee] += cf * sf + cb * sb;
            }
        }
        float sum = 0.f;
#pragma unroll
        for (int t = 0; t < 32; ++t) sum += y[t];
        sum += __shfl_xor(sum, 1); sum += __shfl_xor(sum, 2);
        const float mu = sum * (1.f / 128.f);
        float vs = 0.f;
#pragma unroll
        for (int t = 0; t < 32; ++t) { const float dlt = y[t] - mu; vs += dlt * dlt; }
        vs += __shfl_xor(vs, 1); vs += __shfl_xor(vs, 2);
        const float rs = rsqrtf(vs * (1.f / 128.f) + 1e-6f);
        const size_t row = (size_t)b * 4096 + n * 128 + i;
        const int col0 = h * 128 + e0;
#pragma unroll
        for (int e8 = 0; e8 < 4; ++e8) {
            float g[8], o[8]; load8(p.rg + row * 512 + col0 + e8 * 8, g);
#pragma unroll
            for (int t = 0; t < 8; ++t) o[t] = (y[e8 * 8 + t] - mu) * rs * p.gn_w[col0 + e8 * 8 + t] * g[t];
            store8(p.mixed + row * 1024 + col0 + e8 * 8, o);
        }
        __syncthreads();
    }
}

__device__ void ph_attn_naive(const Params& p) {
    for (int idx = blockIdx.x * NT + otid(); idx < 8 * 8 * 4096; idx += gridDim.x * NT) {
        const int t = idx & 4095, bq = idx >> 12, qh = bq & 7, b = bq >> 3, kvh = qh >> 2;
        float q[64], acc[64];
#pragma unroll
        for (int d8 = 0; d8 < 8; ++d8) load8(p.aq + ((size_t)bq * 4096 + t) * 64 + d8 * 8, q + d8 * 8);
#pragma unroll
        for (int e = 0; e < 64; ++e) acc[e] = 0.f;
        const bf16_t* Kb = p.ak + (size_t)(b * 2 + kvh) * KVROWS * 64;
        const bf16_t* Vb = p.av + (size_t)(b * 2 + kvh) * KVROWS * 64;
        float m = p.sink[qh], l = 1.f;
        const int lo = t - 128 < 0 ? 0 : t - 128, hi = t + 128 > 4095 ? 4095 : t + 128;
        const int nkeys = 256 + (hi - lo + 1);
        for (int kk = 0; kk < nkeys; ++kk) {
            const int krow = kk < 256 ? kk : lo + kk;
            float s = 0.f;
#pragma unroll
            for (int d8 = 0; d8 < 8; ++d8) {
                float kv[8]; load8(Kb + (size_t)krow * 64 + d8 * 8, kv);
#pragma unroll
                for (int i = 0; i < 8; ++i) s += q[d8 * 8 + i] * kv[i];
            }
            if (s > m) {
                const float sc = __expf(m - s); l *= sc;
#pragma unroll
                for (int e = 0; e < 64; ++e) acc[e] *= sc;
                m = s;
            }
            const float pe = __expf(s - m); l += pe;
#pragma unroll
            for (int d8 = 0; d8 < 8; ++d8) {
                float vv[8]; load8(Vb + (size_t)krow * 64 + d8 * 8, vv);
#pragma unroll
                for (int i = 0; i < 8; ++i) acc[d8 * 8 + i] += pe * vv[i];
            }
        }
        const float inv = 1.f / l;
        const size_t row = (size_t)b * 4096 + t;
#pragma unroll
        for (int d8 = 0; d8 < 8; ++d8) {
            float g[8], o[8]; load8(p.ag + row * 512 + qh * 64 + d8 * 8, g);
#pragma unroll
            for (int i = 0; i < 8; ++i) o[i] = acc[d8 * 8 + i] * inv * g[i];
            store8(p.mixed + row * 1024 + 512 + qh * 64 + d8 * 8, o);
        }
    }
}

__device__ void ph_final(const Params& p) {
    const int tid = otid(), wave = tid >> 6, lane = tid & 63;
    for (int row = blockIdx.x * 8 + wave; row < 32768; row += gridDim.x * 8) {
        float* src = p.out + (size_t)row * 1024;
        float4 xv[4]; float ss = 0.f;
#pragma unroll
        for (int i = 0; i < 4; ++i) { xv[i] = *(const float4*)(src + i * 256 + lane * 4); ss += xv[i].x * xv[i].x + xv[i].y * xv[i].y + xv[i].z * xv[i].z + xv[i].w * xv[i].w; }
        ss = wave_sum(ss);
        const float rstd = rsqrtf(ss * (1.f / 1024.f) + 1e-6f);
#pragma unroll
        for (int i = 0; i < 4; ++i) {
            const int col = i * 256 + lane * 4;
            const float4 w4 = *(const float4*)(p.fnw + col);
            float4 o; o.x = xv[i].x * rstd * w4.x; o.y = xv[i].y * rstd * w4.y; o.z = xv[i].z * rstd * w4.z; o.w = xv[i].w * rstd * w4.w;
            *(float4*)(src + col) = o;
        }
    }
}

#define NPHASE 9
template <int PH> __device__ __forceinline__ void run_phase(const Params& p, float* lds) {
    if (PH == 0) { ph_mod(p, lds); __syncthreads(); ph_wconv(p, lds); }
    else if (PH == 1) ph_h(p);
    else if (PH == 2) ph_gemm_in(p, lds);
    else if (PH == 3) { ph_states(p, (ldsp)lds); ph_attn(p, (ldsp)lds); }
    else if (PH == 4) ph_scan(p);
    else if (PH == 5) ph_retout(p, (ldsp)lds);
    else if (PH == 6) ph_gemm_out(p, lds);
    else if (PH == 7) ph_final(p);
}

template <int PH> __global__ __launch_bounds__(NT) void k_ph(Params p) {
    extern __shared__ __attribute__((aligned(16))) float lds[];
    run_phase<PH>(p, lds);
}


#define XB_TMO      128
#define XB_XCNT(j)  (256  + 64 * (j))
#define XB_XSUB(j)  (1280 + 64 * (j))
#define XB_XGEN(j)  (2304 + 64 * (j))
#define XB_TOP      3328
#define XB_TOPGEN   3392
#define XCD_BAR_WORDS 3456
#define XB_SPIN_CAP (1u << 18)
__device__ __forceinline__ unsigned xb_ld(unsigned* p)              { return __hip_atomic_load(p, __ATOMIC_RELAXED, __HIP_MEMORY_SCOPE_AGENT); }
__device__ __forceinline__ unsigned xb_add(unsigned* p, unsigned v) { return __hip_atomic_fetch_add(p, v, __ATOMIC_RELAXED, __HIP_MEMORY_SCOPE_AGENT); }
__device__ __forceinline__ unsigned xb_xcc_id() { return (unsigned)__builtin_amdgcn_s_getreg((3 << 11) | 20) & 0xFu; }
#define XB_SPIN(cond, bar) do { unsigned _sp = 0; while (cond) { __builtin_amdgcn_s_sleep(1); \
    if ((++_sp & 255u) == 0u) { if (xb_ld(&(bar)[XB_TMO])) break; if (_sp > XB_SPIN_CAP) { atomicAdd(&(bar)[XB_TMO], 1u); break; } } } } while (0)
struct XcdBarrier { unsigned* bar; unsigned x; volatile LAS unsigned* st; };
__device__ __forceinline__ XcdBarrier xcd_barrier_post(unsigned* bar, volatile LAS unsigned* st) {
    XcdBarrier b; b.bar = bar; b.x = xb_xcc_id(); b.st = st;
    if (threadIdx.x == 0) (void)xb_add(&bar[XB_XCNT(b.x)], 1u);
    return b;
}
__device__ __forceinline__ void xcd_barrier_complete(unsigned* bar, unsigned x, unsigned& nloc, unsigned& nx) {
    const unsigned G = gridDim.x * gridDim.y * gridDim.z;
    unsigned sum, cnt, mine, sp = 0u;
    for (;;) {
        sum = 0u; cnt = 0u; mine = 0u;
#pragma unroll
        for (unsigned j = 0; j < 16; ++j) { const unsigned c = xb_ld(&bar[XB_XCNT(j)]); sum += c; cnt += (c > 0u) ? 1u : 0u; mine = (j == x) ? c : mine; }
        if (sum == G) break;
        __builtin_amdgcn_s_sleep(1);
        if ((++sp & 255u) == 0u) { if (xb_ld(&bar[XB_TMO])) break; if (sp > XB_SPIN_CAP) { atomicAdd(&bar[XB_TMO], 1u); break; } }
    }
    nloc = mine > 0u ? mine : 1u; nx = cnt > 0u ? cnt : 1u;
}
__device__ __forceinline__ void xcd_barrier(const XcdBarrier& b) {
    asm volatile("s_waitcnt vmcnt(0)" ::: "memory");
    __syncthreads();
    if (threadIdx.x == 0) {
        unsigned* bar = b.bar;
        __builtin_amdgcn_s_waitcnt(0);
        unsigned nloc = b.st[0], nx = b.st[1];
        if (nloc == 0u) { xcd_barrier_complete(bar, b.x, nloc, nx); b.st[0] = nloc; b.st[1] = nx; }
        const unsigned old = xb_add(&bar[XB_XSUB(b.x)], 1u);
        const unsigned gen = old / nloc;
        if (old + 1u == (gen + 1u) * nloc) {
            __builtin_amdgcn_fence(__ATOMIC_RELEASE, "agent");
            asm volatile("s_waitcnt vmcnt(0)" ::: "memory");
            const unsigned og = xb_add(&bar[XB_TOP], 1u);
            const unsigned tg = og / nx;
            if (og + 1u == (tg + 1u) * nx) xb_add(&bar[XB_TOPGEN], 1u);
            else XB_SPIN(xb_ld(&bar[XB_TOPGEN]) == tg, bar);
            __builtin_amdgcn_fence(__ATOMIC_ACQUIRE, "agent");
            xb_add(&bar[XB_XGEN(b.x)], 1u);
            asm volatile("s_waitcnt vmcnt(0)" ::: "memory");
        } else {
            XB_SPIN(xb_ld(&bar[XB_XGEN(b.x)]) == gen, bar);
            __builtin_amdgcn_fence(__ATOMIC_ACQUIRE, "agent");
            asm volatile("s_waitcnt vmcnt(0)" ::: "memory");
        }
    }
    __syncthreads();
}

#ifndef REPMASK
#define REPMASK 0
#endif
#define RUNPH(i) do { run_phase<i>(p, lds); if ((REPMASK >> i) & 1) { __syncthreads(); run_phase<i>(p, lds); } } while (0)
#define GSYNC() do { xcd_barrier(xb); if ((REPMASK >> 8) & 1) xcd_barrier(xb); } while (0)
__global__ __launch_bounds__(NT) void k_mega(Params p) {
    extern __shared__ __attribute__((aligned(16))) float lds[];
    cg::grid_group grid = cg::this_grid();
    if (p.out == nullptr) grid.sync();
    volatile LAS unsigned* xst = (volatile LAS unsigned*)((ldsp)lds + LDS_GEMM);
    if (threadIdx.x < 4) xst[threadIdx.x] = 0u;
    __syncthreads();
    const XcdBarrier xb = xcd_barrier_post(p.bar, xst);
    RUNPH(0); GSYNC();
    RUNPH(1); GSYNC();
    RUNPH(2); GSYNC();
    RUNPH(3); GSYNC();
    RUNPH(4); GSYNC();
    RUNPH(5); GSYNC();
    RUNPH(6); GSYNC();
    run_phase<7>(p, lds);
}

template <int PH> static void launch_ph(const Params& p, int grid, hipStream_t stream) {
    static bool attr = false;
    if (!attr) { (void)hipFuncSetAttribute((const void*)k_ph<PH>, hipFuncAttributeMaxDynamicSharedMemorySize, LDS_BYTES); attr = true; }
    hipLaunchKernelGGL(k_ph<PH>, dim3(grid), dim3(NT), LDS_BYTES, stream, p);
}

extern "C" void kernel_launch(void* const* d_in, const int* in_sizes, int n_in, void* d_out, int out_size, void* d_ws, size_t ws_size, hipStream_t stream) {
    Params p{};
    p.x = (const float*)d_in[0]; p.c = (const float*)d_in[1]; p.ctx = (const float*)d_in[2]; p.c_ctx = (const float*)d_in[3];
    p.w_ada = (const float*)d_in[4]; p.b_ada = (const float*)d_in[5]; p.w_in = (const float*)d_in[6]; p.decay = (const float*)d_in[7];
    p.gn_w = (const float*)d_in[8]; p.sink = (const float*)d_in[9]; p.w_out = (const float*)d_in[10]; p.fnw = (const float*)d_in[11];
    p.out = (float*)d_out;
    unsigned char* w = (unsigned char*)d_ws; size_t off = 0;
    auto take = [&](size_t bytes) { unsigned char* r = w + off; off += (bytes + 255) & ~(size_t)255; return r; };
    p.mod = (float*)take(9 * 3072 * 4);
    p.tab128 = (float2*)take(64 * 32 * 8);
    p.tab64 = (float2*)take(64 * 16 * 8);
    p.h = (bf16_t*)take((size_t)MROWS * 1024 * 2);
    p.mixed = p.h;
    p.rq = (bf16_t*)take((size_t)32 * 4096 * 128 * 2);
    p.rk = (bf16_t*)take((size_t)32 * KVROWS * 128 * 2);
    p.rv = (bf16_t*)take((size_t)32 * KVROWS * 128 * 2);
    p.rg = (bf16_t*)take((size_t)32768 * 512 * 2);
    p.aq = (bf16_t*)take((size_t)64 * 4096 * 64 * 2);
    p.ak = (bf16_t*)take((size_t)16 * KVROWS * 64 * 2);
    p.av = (bf16_t*)take((size_t)16 * KVROWS * 64 * 2);
    p.ag = (bf16_t*)take((size_t)32768 * 512 * 2);
    p.Kf = (bf16_t*)take((size_t)32 * 34 * 16384 * 2);
    p.Kb = (bf16_t*)take((size_t)32 * 34 * 16384 * 2);
    p.Rf = (bf16_t*)take((size_t)32 * 32 * 16384 * 2);
    p.Rb = (bf16_t*)take((size_t)32 * 32 * 16384 * 2);
    p.WinT = (bf16_t*)take((size_t)3328 * 1024 * 2);
    p.WoutT = (bf16_t*)take((size_t)1024 * 1024 * 2);
    p.bar = (unsigned*)take(XCD_BAR_WORDS * 4);
    if (off > ws_size) { fprintf(stderr, "kernel_launch: workspace too small (%zu > %zu)\n", off, ws_size); return; }
#if MK_ONE_LAUNCH
    static int grid_blocks = 0;
    if (!grid_blocks) {
        int dev = 0, cus = 0, per_cu = 0;
        (void)hipGetDevice(&dev);
        (void)hipDeviceGetAttribute(&cus, hipDeviceAttributeMultiprocessorCount, dev);
        (void)hipFuncSetAttribute((const void*)k_mega, hipFuncAttributeMaxDynamicSharedMemorySize, LDS_BYTES);
        (void)hipOccupancyMaxActiveBlocksPerMultiprocessor(&per_cu, (const void*)k_mega, NT, LDS_BYTES);
        if (per_cu < 1) per_cu = 1;
        grid_blocks = cus * per_cu;
    }
    (void)hipMemsetAsync(p.bar, 0, XCD_BAR_WORDS * 4, stream);
    void* args[] = {&p};
    hipError_t e = hipLaunchCooperativeKernel((const void*)k_mega, dim3(grid_blocks), dim3(NT), args, LDS_BYTES, stream);
    if (e != hipSuccess) fprintf(stderr, "cooperative launch failed: %s (grid %d)\n", hipGetErrorString(e), grid_blocks);
#else
    const int G = 1024;
    launch_ph<0>(p, G, stream); launch_ph<1>(p, G, stream); launch_ph<2>(p, G, stream); launch_ph<3>(p, G, stream);
    launch_ph<4>(p, G, stream); launch_ph<5>(p, G, stream); launch_ph<6>(p, G, stream); launch_ph<7>(p, G, stream);
#endif
}
```

```cpp
#include <hip/hip_runtime.h>
#include <hip/hip_cooperative_groups.h>
#include <cstdio>
namespace cg = cooperative_groups;

#ifndef MK_ONE_LAUNCH
#define MK_ONE_LAUNCH 1
#endif

typedef unsigned short bf16_t;
#define NT 512
#define MROWS 34816
#define KVROWS 4352
#define LDS_GEMM 131072
#define LDS_TAB (LDS_GEMM + 64)
#define LDS_BYTES (LDS_TAB + 24576)

struct Params {
    const float *x, *c, *ctx, *c_ctx, *w_ada, *b_ada, *w_in, *decay, *gn_w, *sink, *w_out, *fnw;
    float* out;
    float* mod;
    float2* tab128;
    float2* tab64;
    bf16_t *h, *rq, *rk, *rv, *rg, *aq, *ak, *av, *ag, *Kf, *Kb, *Rf, *Rb, *mixed, *WinT, *WoutT;
    unsigned* bar;
};

__device__ __forceinline__ int otid() { int t = threadIdx.x; asm volatile("" : "+v"(t)); return t; }
__device__ __forceinline__ float bf2f(bf16_t b) { return __uint_as_float(((unsigned)b) << 16); }
__device__ __forceinline__ bf16_t f2bf(float f) { unsigned u = __float_as_uint(f); u += 0x7FFFu + ((u >> 16) & 1u); return (bf16_t)(u >> 16); }
typedef __bf16 bf2_t __attribute__((ext_vector_type(2)));
typedef float fl2_t __attribute__((ext_vector_type(2)));
__device__ __forceinline__ unsigned pack2(float lo, float hi) { fl2_t v = {lo, hi}; bf2_t b = __builtin_convertvector(v, bf2_t); return *(unsigned*)&b; }
__device__ __forceinline__ void store8(bf16_t* dst, const float* o) {
    uint4 u; u.x = pack2(o[0], o[1]); u.y = pack2(o[2], o[3]); u.z = pack2(o[4], o[5]); u.w = pack2(o[6], o[7]);
    *(uint4*)dst = u;
}
__device__ __forceinline__ void load8(const bf16_t* src, float* o) {
    const uint4 u = *(const uint4*)src;
    o[0] = __uint_as_float(u.x << 16); o[1] = __uint_as_float(u.x & 0xffff0000u);
    o[2] = __uint_as_float(u.y << 16); o[3] = __uint_as_float(u.y & 0xffff0000u);
    o[4] = __uint_as_float(u.z << 16); o[5] = __uint_as_float(u.z & 0xffff0000u);
    o[6] = __uint_as_float(u.w << 16); o[7] = __uint_as_float(u.w & 0xffff0000u);
}
__device__ __forceinline__ float silu_f(float v) { return v / (1.f + __expf(-v)); }
__device__ __forceinline__ float wave_sum(float v) {
#pragma unroll
    for (int o = 32; o >= 1; o >>= 1) v += __shfl_xor(v, o);
    return v;
}
__device__ __forceinline__ float lgam(const Params& p, int dir, int h) { return -log1pf(expf(-p.decay[dir * 4 + h])); }

__device__ __forceinline__ int ocol_in(int sg) {
    if (sg < 1024) { const int s = sg & 127; return (sg & ~127) + ((s >> 5) << 4) + (((s >> 3) & 3) << 2) + (s & 3) + (((s >> 2) & 1) << 6); }
    if (sg >= 2048 && sg < 2688) { const int s = sg & 63; return (sg & ~63) + ((s >> 5) << 4) + (((s >> 3) & 3) << 2) + (s & 3) + (((s >> 2) & 1) << 5); }
    return sg;
}

typedef __attribute__((address_space(3))) const fl2_t* ldstab_t;
enum { K_RQ = 0, K_RK, K_RV, K_RG, K_AQ, K_AK, K_AV, K_AG };
template <int KIND> __device__ __forceinline__ void epi_in8(const Params& p, ldstab_t t128, ldstab_t t64, int row, int s0, const float* v) {
    const bool isc = row >= 32768;
    int b, t;
    if (isc) { const int r = row - 32768; b = r >> 8; t = r & 255; } else { b = row >> 12; t = row & 4095; }
    const int gr = (t >> 6) & 63, gc = t & 63;
    float o[8];
    if (KIND == K_RQ || KIND == K_RK) {
        const bool isk = KIND == K_RK;
        if (!isk && isc) return;
        const int head = (s0 >> 7) & 3, s = s0 & 127, wc = s >> 5, fq = (s >> 3) & 3;
        const float scl = isk ? 0.08838834764831845f : 1.f;
        if (isc) {
#pragma unroll
            for (int i = 0; i < 8; ++i) o[i] = v[i] * scl;
        } else {
            const int pos = wc < 2 ? gr : gc;
            ldstab_t tb = t128 + pos * 32 + (wc & 1) * 16 + fq * 4;
#pragma unroll
            for (int j = 0; j < 4; ++j) { const fl2_t cs = tb[j]; const float x1 = v[j] * scl, x2 = v[4 + j] * scl; o[j] = x1 * cs.x - x2 * cs.y; o[4 + j] = x1 * cs.y + x2 * cs.x; }
        }
        bf16_t* dst = isk ? p.rk + ((size_t)(b * 4 + head) * KVROWS + (isc ? 4096 + t : t)) * 128 + s
                          : p.rq + ((size_t)(b * 4 + head) * 4096 + t) * 128 + s;
        store8(dst, o);
    } else if (KIND == K_RV) {
        const int head = (s0 - 1024) >> 7, s = s0 & 127;
        store8(p.rv + ((size_t)(b * 4 + head) * KVROWS + (isc ? 4096 + t : t)) * 128 + s, v);
    } else if (KIND == K_RG) {
        if (isc) return;
#pragma unroll
        for (int i = 0; i < 8; ++i) o[i] = silu_f(v[i]);
        store8(p.rg + (size_t)row * 512 + (s0 - 1536), o);
    } else if (KIND == K_AQ || KIND == K_AK) {
        const bool isk = KIND == K_AK;
        if (!isk && isc) return;
        const int head = isk ? (s0 - 2560) >> 6 : (s0 - 2048) >> 6, s = s0 & 63, w = s >> 5, fq = (s >> 3) & 3;
        const float scl = isk ? 1.f : 0.125f;
        if (isc) {
#pragma unroll
            for (int i = 0; i < 8; ++i) o[i] = v[i];
        } else {
            const int pos = w == 0 ? gr : gc;
            ldstab_t tb = t64 + pos * 16 + fq * 4;
#pragma unroll
            for (int j = 0; j < 4; ++j) { const fl2_t cs = tb[j]; const float x1 = v[j] * scl, x2 = v[4 + j] * scl; o[j] = x1 * cs.x - x2 * cs.y; o[4 + j] = x1 * cs.y + x2 * cs.x; }
        }
        bf16_t* dst = isk ? p.ak + ((size_t)(b * 2 + head) * KVROWS + (isc ? t : 256 + t)) * 64 + s
                          : p.aq + ((size_t)(b * 8 + head) * 4096 + t) * 64 + s;
        store8(dst, o);
    } else if (KIND == K_AV) {
        const int head = (s0 - 2688) >> 6, s = s0 & 63;
        store8(p.av + ((size_t)(b * 2 + head) * KVROWS + (isc ? t : 256 + t)) * 64 + s, v);
    } else {
        if (isc) return;
#pragma unroll
        for (int i = 0; i < 8; ++i) o[i] = silu_f(v[i]);
        store8(p.ag + (size_t)row * 512 + (s0 - 2816), o);
    }
}

__device__ void ph_mod(const Params& p, float* lds) {
    const int tid = otid();
    float* sc = lds;
    float* red = lds + 9216;
    if (blockIdx.x < 192) {
        for (int i = tid; i < 9 * 1024; i += NT) {
            const int v = i >> 10, k = i & 1023;
            const float cv = v < 8 ? p.c[v * 1024 + k] : p.c_ctx[k];
            sc[i] = cv / (1.f + expf(-cv));
        }
        __syncthreads();
        for (int item = blockIdx.x; item < 192; item += gridDim.x) {
            const int cl = tid & 15, kg = tid >> 4, col = item * 16 + cl;
            float acc[9];
#pragma unroll
            for (int v = 0; v < 9; ++v) acc[v] = 0.f;
#pragma unroll 4
            for (int kk = 0; kk < 32; ++kk) {
                const int k = kg * 32 + kk;
                const float w = p.w_ada[(size_t)k * 3072 + col];
#pragma unroll
                for (int v = 0; v < 9; ++v) acc[v] += sc[v * 1024 + k] * w;
            }
#pragma unroll
            for (int v = 0; v < 9; ++v) red[(kg * 9 + v) * 16 + cl] = acc[v];
            __syncthreads();
            if (tid < 144) {
                const int v = tid >> 4;
                float s = 0.f;
                for (int g2 = 0; g2 < 32; ++g2) s += red[(g2 * 9 + v) * 16 + cl];
                p.mod[v * 3072 + col] = s + p.b_ada[col];
            }
            __syncthreads();
        }
    }
    const int gt = blockIdx.x * NT + tid;
    if (gt < 2048) { const int pos = gt >> 5, f = gt & 31; const float a = (float)pos * powf(10000.f, -(float)f / 32.f); p.tab128[gt] = make_float2(cosf(a), sinf(a)); }
    else if (gt < 3072) { const int g2 = gt - 2048, pos = g2 >> 4, f = g2 & 15; const float a = (float)pos * powf(10000.f, -(float)f / 16.f); p.tab64[g2] = make_float2(cosf(a), sinf(a)); }
}

__device__ void ph_h(const Params& p) {
    const int tid = otid(), wave = tid >> 6, lane = tid & 63;
    const int stride = gridDim.x * 8;
    for (int row0 = blockIdx.x * 8 + wave; row0 < MROWS; row0 += 2 * stride) {
        float4 xv[2][4]; int vv[2]; bool ok[2];
#pragma unroll
        for (int u = 0; u < 2; ++u) {
            const int row = row0 + u * stride; ok[u] = row < MROWS;
            const int rr = ok[u] ? row : row0;
            const float* src; if (rr < 32768) { src = p.x + (size_t)rr * 1024; vv[u] = rr >> 12; } else { src = p.ctx + (size_t)(rr - 32768) * 1024; vv[u] = 8; }
#pragma unroll
            for (int i = 0; i < 4; ++i) xv[u][i] = *(const float4*)(src + i * 256 + lane * 4);
        }
#pragma unroll
        for (int u = 0; u < 2; ++u) {
            if (!ok[u]) continue;
            const int row = row0 + u * stride;
            float ss = 0.f;
#pragma unroll
            for (int i = 0; i < 4; ++i) ss += xv[u][i].x * xv[u][i].x + xv[u][i].y * xv[u][i].y + xv[u][i].z * xv[u][i].z + xv[u][i].w * xv[u][i].w;
            ss = wave_sum(ss);
            const float rstd = rsqrtf(ss * (1.f / 1024.f) + 1e-6f);
            const float* sh = p.mod + vv[u] * 3072; const float* sc = sh + 1024;
#pragma unroll
            for (int i = 0; i < 4; ++i) {
                const int col = i * 256 + lane * 4;
                const float4 s4 = *(const float4*)(sc + col), h4 = *(const float4*)(sh + col);
                uint2 o;
                o.x = pack2(xv[u][i].x * rstd * (1.f + s4.x) + h4.x, xv[u][i].y * rstd * (1.f + s4.y) + h4.y);
                o.y = pack2(xv[u][i].z * rstd * (1.f + s4.z) + h4.z, xv[u][i].w * rstd * (1.f + s4.w) + h4.w);
                *(uint2*)(p.h + (size_t)row * 1024 + col) = o;
            }
        }
    }
}

template <int MODE> __device__ void ph_gemm_naive(const Params& p, float* lds) {
    const bf16_t* A = MODE == 0 ? p.h : p.mixed;
    const float* Bm = MODE == 0 ? p.w_in : p.w_out;
    constexpr int ldb = MODE == 0 ? 3328 : 1024;
    constexpr int nrt = (MODE == 0 ? MROWS : 32768) / 64, nct = ldb / 128;
    float* As = lds;
    float* Bs = lds + 32 * 65;
    const int tid = threadIdx.x, ty = tid >> 4, tx = tid & 15;
    for (int tile = blockIdx.x; tile < nrt * nct; tile += gridDim.x) {
        const int rt = tile / nct, ct = tile % nct;
        float acc[2][8];
#pragma unroll
        for (int r = 0; r < 2; ++r)
#pragma unroll
            for (int t = 0; t < 8; ++t) acc[r][t] = 0.f;
        int bc[8];
#pragma unroll
        for (int i = 0; i < 8; ++i) { const int cc = (tid + NT * i) & 127; const int sg = ct * 128 + cc; bc[i] = MODE == 0 ? ocol_in(sg) : sg; }
        for (int k0 = 0; k0 < 1024; k0 += 32) {
#pragma unroll
            for (int i = 0; i < 4; ++i) { const int e = tid + NT * i, r = e >> 5, kk = e & 31; As[kk * 65 + r] = bf2f(A[(size_t)(rt * 64 + r) * 1024 + k0 + kk]); }
#pragma unroll
            for (int i = 0; i < 8; ++i) { const int e = tid + NT * i, kk = e >> 7, cc = e & 127; Bs[kk * 129 + cc] = Bm[(size_t)(k0 + kk) * ldb + bc[i]]; }
            __syncthreads();
#pragma unroll 4
            for (int kk = 0; kk < 32; ++kk) {
                const float a0 = As[kk * 65 + ty * 2], a1 = As[kk * 65 + ty * 2 + 1];
#pragma unroll
                for (int t = 0; t < 8; ++t) { const float bv = Bs[kk * 129 + tx * 8 + t]; acc[0][t] += a0 * bv; acc[1][t] += a1 * bv; }
            }
            __syncthreads();
        }
#pragma unroll
        for (int r = 0; r < 2; ++r) {
            const int row = rt * 64 + ty * 2 + r, s0 = ct * 128 + tx * 8;
            if (MODE == 0) { }
            else {
                const int b = row >> 12;
                const float* gate = p.mod + b * 3072 + 2048 + s0;
                const float* xr = p.x + (size_t)row * 1024 + s0;
                float* orow = p.out + (size_t)row * 1024 + s0;
#pragma unroll
                for (int t = 0; t < 8; ++t) orow[t] = xr[t] + gate[t] * acc[r][t];
            }
        }
    }
}


__device__ void ph_wconv(const Params& p, float* lds) {
    const int tid = otid();
    for (int item = blockIdx.x; item < 544; item += gridDim.x) {
        const bool isin = item < 416; const int it = isin ? item : item - 416;
        const int win = it >> 4, kb = it & 15; const int ld = isin ? 3328 : 1024;
        const float* W = (isin ? p.w_in : p.w_out) + (size_t)(kb * 64) * ld + win * 128;
#pragma unroll
        for (int i = 0; i < 16; ++i) { const int e = tid + NT * i, k = e >> 7, c = e & 127; lds[k * 129 + c] = W[(size_t)k * ld + c]; }
        __syncthreads();
#pragma unroll
        for (int i = 0; i < 2; ++i) {
            const int e = tid + NT * i, pp = e >> 3, k8 = e & 7;
            const int pglob = win * 128 + pp;
            int col = pp;
            if (isin) {
                const int pos = pglob & 255;
                const int slot = (pos & ~31) | (((pos >> 2) & 3) << 3) | (((pos >> 4) & 1) << 2) | (pos & 3);
                col = ocol_in((pglob & ~255) + slot) - win * 128;
            }
            float o[8];
#pragma unroll
            for (int t = 0; t < 8; ++t) o[t] = lds[(k8 * 8 + t) * 129 + col];
            store8((isin ? p.WinT : p.WoutT) + (size_t)pglob * 1024 + kb * 64 + k8 * 8, o);
        }
        __syncthreads();
    }
}

namespace pg8 {
#define PG8_LAS __attribute__((address_space(3)))
typedef short bf16x8 __attribute__((ext_vector_type(8)));
typedef float f32x4 __attribute__((ext_vector_type(4)));
constexpr int BM = 256, BK = 64, HALF = 128, HTB = HALF * BK * 2, STAGE_BYTES = 8 * HTB, NXCD = 8, WGM = 8;
__device__ __forceinline__ int lds_byte(int r, int c) { const int st = (r >> 4) * 2 + (c >> 5), rr = r & 15, cc = c & 31, ob = rr * 64 + cc * 2; return st * 1024 + (ob ^ (((ob >> 9) & 1) << 5)); }
__device__ __forceinline__ void stage_rc(int b, int& R, int& C) { const int st = b / 1024, sb = b % 1024, swz = sb ^ (((sb >> 9) & 1) << 5); R = (st >> 1) * 16 + swz / 64; C = (st & 1) * 32 + (swz % 64) / 2; }
struct Unit { int pm, pn; };
struct Gemm { const bf16_t* A; const bf16_t* Bt; int K; };
__device__ __forceinline__ void static_unit(int wgid, int nM, int nN, Unit& u) {
    const int nwg = nM * nN;
    { const int q = nwg / NXCD, r = nwg % NXCD, xcd = wgid % NXCD, off = wgid / NXCD; wgid = (xcd < r ? xcd * (q + 1) : r * (q + 1) + (xcd - r) * q) + off; }
    const int nig = WGM * nN, gid = wgid / nig, fm = gid * WGM, gsz = (nM - fm) < WGM ? (nM - fm) : WGM;
    u.pm = fm + ((wgid % nig) % gsz); u.pn = (wgid % nig) / gsz;
}
struct SchedIn {
    int G, c;
    __device__ __forceinline__ bool next(int i, Unit& u) const {
        const int L = i * G + c;
        if (L < 1664) { static_unit(L, 128, 13, u); return true; }
        if (L < 1704) { const int q = L - 1664, r = q % 5; u.pm = 128 + q / 5; u.pn = r < 4 ? 2 + r : 10; return true; }
        return false;
    }
};
struct SchedOut {
    int G, c;
    __device__ __forceinline__ bool next(int i, Unit& u) const {
        const int L = i * G + c;
        if (L < 512) { static_unit(L, 128, 4, u); return true; }
        return false;
    }
};
struct EpiIn {
    const Params* p; ldstab_t t128, t64;
    template <int KIND, int BJ> __device__ __forceinline__ void half(const f32x4 (&acc)[2][2][4][2], const Unit& u, int wr, int wc, int fr, int fq) const {
        const int s0 = u.pn * BM + BJ * HALF + wc * 32 + fq * 8;
#pragma unroll
        for (int ai = 0; ai < 2; ++ai)
#pragma unroll
            for (int m = 0; m < 4; ++m) {
                const int row = u.pm * BM + ai * HALF + wr * 64 + m * 16 + fr;
                float v[8];
#pragma unroll
                for (int j = 0; j < 4; ++j) { v[j] = acc[ai][BJ][m][0][j]; v[4 + j] = acc[ai][BJ][m][1][j]; }
                epi_in8<KIND>(*p, t128, t64, row, s0, v);
            }
    }
    template <int K0, int K1> __device__ __forceinline__ void both(const f32x4 (&acc)[2][2][4][2], const Unit& u, int wr, int wc, int fr, int fq) const {
        half<K0, 0>(acc, u, wr, wc, fr, fq); half<K1, 1>(acc, u, wr, wc, fr, fq);
    }
    __device__ __forceinline__ void operator()(const f32x4 (&acc)[2][2][4][2], const Unit& u, int wr, int wc, int fr, int fq) const {
        switch (u.pn) {
            case 0: case 1: both<K_RQ, K_RQ>(acc, u, wr, wc, fr, fq); break;
            case 2: case 3: both<K_RK, K_RK>(acc, u, wr, wc, fr, fq); break;
            case 4: case 5: both<K_RV, K_RV>(acc, u, wr, wc, fr, fq); break;
            case 6: case 7: both<K_RG, K_RG>(acc, u, wr, wc, fr, fq); break;
            case 8: case 9: both<K_AQ, K_AQ>(acc, u, wr, wc, fr, fq); break;
            case 10: both<K_AK, K_AV>(acc, u, wr, wc, fr, fq); break;
            default: both<K_AG, K_AG>(acc, u, wr, wc, fr, fq); break;
        }
    }
};
struct EpiOut {
    const Params* p;
    __device__ __forceinline__ void operator()(const f32x4 (&acc)[2][2][4][2], const Unit& u, int wr, int wc, int fr, int fq) const {
        const int b = (u.pm * BM) >> 12;
        f32x4 gv[2][2];
#pragma unroll
        for (int bj = 0; bj < 2; ++bj)
#pragma unroll
            for (int n = 0; n < 2; ++n) gv[bj][n] = *(const f32x4*)(p->mod + b * 3072 + 2048 + u.pn * BM + bj * HALF + wc * 32 + n * 16 + fq * 4);
#pragma unroll
        for (int ai = 0; ai < 2; ++ai) {
            f32x4 xv[4][2][2];
#pragma unroll
            for (int m = 0; m < 4; ++m) {
                const size_t rowoff = (size_t)(u.pm * BM + ai * HALF + wr * 64 + m * 16 + fr) * 1024 + u.pn * BM + wc * 32 + fq * 4;
#pragma unroll
                for (int bj = 0; bj < 2; ++bj)
#pragma unroll
                    for (int n = 0; n < 2; ++n) xv[m][bj][n] = *(const f32x4*)(p->x + rowoff + bj * HALF + n * 16);
            }
#pragma unroll
            for (int m = 0; m < 4; ++m) {
                const size_t rowoff = (size_t)(u.pm * BM + ai * HALF + wr * 64 + m * 16 + fr) * 1024 + u.pn * BM + wc * 32 + fq * 4;
#pragma unroll
                for (int bj = 0; bj < 2; ++bj)
#pragma unroll
                    for (int n = 0; n < 2; ++n) *(f32x4*)(p->out + rowoff + bj * HALF + n * 16) = xv[m][bj][n] + gv[bj][n] * acc[ai][bj][m][n];
            }
        }
    }
};

template <class Epi, class Sched>
__device__ __forceinline__ void gemm_phase(PG8_LAS unsigned char* lds, const Gemm g, const Sched& S, const Epi& E) {
    const int tid = otid(), wid = __builtin_amdgcn_readfirstlane(tid >> 6), lane = tid & 63, wr = wid >> 2, wc = wid & 3, fr = lane & 15, fq = lane >> 4;
    const int K = g.K, nt = K / BK;
    unsigned voffA[2];
#pragma unroll
    for (int i = 0; i < 2; ++i) { int R, C; stage_rc(tid * 16 + i * 8192, R, C); voffA[i] = (unsigned)(R * K + C) * 2u; }
    const size_t kstep = (size_t)(BK * 2);
    const size_t hstep = (size_t)HALF * K * 2;
    const size_t tstep = 2 * hstep;
    const unsigned ldsw = (unsigned)wid * 1024u;
    const int aoff = lds_byte(wr * 64 + fr, fq * 8), boff = lds_byte(wc * 32 + fr, fq * 8);
#define PG8_SA(b, h) (((b) * 2 + (h)) * HTB)
#define PG8_SB(b, h) ((4 + (b) * 2 + (h)) * HTB)
#define PG8_STAGE(bufoff, gbase) do { _Pragma("unroll") for (int _i = 0; _i < 2; ++_i) \
        __builtin_amdgcn_global_load_lds((const unsigned*)((const char*)(gbase) + voffA[_i]), (PG8_LAS unsigned*)(lds + (bufoff) + ldsw + _i * 8192), 16, 0, 0); } while (0)
#define PG8_LDA(dst, b, h) do { _Pragma("unroll") for (int m = 0; m < 4; ++m) _Pragma("unroll") for (int k = 0; k < 2; ++k) dst[m][k] = *(const PG8_LAS bf16x8*)(lds + PG8_SA(b, h) + aoff + m * 2048 + k * 1024); } while (0)
#define PG8_LDB(dst, b, h) do { _Pragma("unroll") for (int n = 0; n < 2; ++n) _Pragma("unroll") for (int k = 0; k < 2; ++k) dst[n][k] = *(const PG8_LAS bf16x8*)(lds + PG8_SB(b, h) + boff + n * 2048 + k * 1024); } while (0)
#define PG8_MMA(ai, bj, At, Bt) do { __builtin_amdgcn_s_setprio(1); _Pragma("unroll") for (int m = 0; m < 4; ++m) _Pragma("unroll") for (int n = 0; n < 2; ++n) _Pragma("unroll") for (int k = 0; k < 2; ++k) \
        acc[ai][bj][m][n] = __builtin_amdgcn_mfma_f32_16x16x32_bf16(Bt[n][k], At[m][k], acc[ai][bj][m][n], 0, 0, 0); __builtin_amdgcn_s_setprio(0); } while (0)
#define PG8_WAIT_V(n) asm volatile("s_waitcnt vmcnt(" #n ")" ::: "memory")
#define PG8_WAIT_L(n) asm volatile("s_waitcnt lgkmcnt(" #n ")" ::: "memory")
#define PG8_BAR __builtin_amdgcn_s_barrier()
#define PG8_SCHED __builtin_amdgcn_sched_barrier(0)
    Unit cur, nxt; int ui = 0;
    if (!S.next(0, cur)) return;
    f32x4 acc[2][2][4][2];
#pragma unroll
    for (int a = 0; a < 2; ++a)
#pragma unroll
        for (int b = 0; b < 2; ++b)
#pragma unroll
            for (int m = 0; m < 4; ++m)
#pragma unroll
                for (int n = 0; n < 2; ++n) acc[a][b][m][n] = (f32x4){0.f, 0.f, 0.f, 0.f};
    bf16x8 At[4][2], B0[2][2], B1[2][2];
    const char* cA = (const char*)g.A + (size_t)cur.pm * tstep; const char* cB = (const char*)g.Bt + (size_t)cur.pn * tstep;
    PG8_STAGE(PG8_SB(0, 0), cB); PG8_STAGE(PG8_SA(0, 0), cA); PG8_STAGE(PG8_SB(0, 1), cB + hstep); PG8_STAGE(PG8_SA(0, 1), cA + hstep);
    if (wr == 1) PG8_BAR;
    PG8_WAIT_V(4); PG8_BAR;
    PG8_STAGE(PG8_SB(1, 0), cB + kstep); PG8_STAGE(PG8_SA(1, 0), cA + kstep); PG8_STAGE(PG8_SB(1, 1), cB + hstep + kstep);
    PG8_WAIT_V(6); PG8_BAR;
    for (;;) {
        const bool has_next = S.next(ui + 1, nxt);
        const char* nA = has_next ? (const char*)g.A + (size_t)nxt.pm * tstep : cA; const char* nB = has_next ? (const char*)g.Bt + (size_t)nxt.pn * tstep : cB;
        for (int t = 0; t < nt; t += 2) {
            const bool last = (t == nt - 2);
            const char* a1 = cA + (size_t)(t + 1) * kstep;
            const char* a2 = last ? nA : cA + (size_t)(t + 2) * kstep; const char* b2 = last ? nB : cB + (size_t)(t + 2) * kstep;
            const char* a3 = a2 + kstep; const char* b3 = b2 + kstep;
            PG8_LDB(B0, 0, 0); PG8_SCHED; PG8_LDA(At, 0, 0); PG8_STAGE(PG8_SA(1, 1), a1 + hstep);
            PG8_WAIT_L(8); PG8_BAR; PG8_WAIT_L(0); PG8_MMA(0, 0, At, B0); PG8_BAR; PG8_SCHED;
            PG8_LDB(B1, 0, 1); PG8_STAGE(PG8_SB(0, 0), b2);
            PG8_BAR; PG8_WAIT_L(0); PG8_MMA(0, 1, At, B1); PG8_BAR;
            PG8_LDA(At, 0, 1); PG8_STAGE(PG8_SA(0, 0), a2);
            PG8_BAR; PG8_WAIT_L(0); PG8_MMA(1, 0, At, B0); PG8_BAR; PG8_SCHED;
            PG8_STAGE(PG8_SB(0, 1), b2 + hstep);
            PG8_WAIT_V(6); PG8_BAR; PG8_MMA(1, 1, At, B1); PG8_BAR;
            PG8_LDB(B0, 1, 0); PG8_SCHED; PG8_LDA(At, 1, 0); PG8_STAGE(PG8_SA(0, 1), a2 + hstep);
            PG8_WAIT_L(8); PG8_BAR; PG8_WAIT_L(0); PG8_MMA(0, 0, At, B0); PG8_BAR; PG8_SCHED;
            PG8_LDB(B1, 1, 1); PG8_STAGE(PG8_SB(1, 0), b3);
            PG8_BAR; PG8_WAIT_L(0); PG8_MMA(0, 1, At, B1); PG8_BAR;
            PG8_LDA(At, 1, 1); PG8_STAGE(PG8_SA(1, 0), a3);
            PG8_BAR; PG8_WAIT_L(0); PG8_MMA(1, 0, At, B0); PG8_BAR; PG8_SCHED;
            PG8_STAGE(PG8_SB(1, 1), b3 + hstep);
            PG8_WAIT_V(6); PG8_BAR; PG8_MMA(1, 1, At, B1); PG8_BAR;
        }
        E(acc, cur, wr, wc, fr, fq);
        if (!has_next) break;
#pragma unroll
        for (int a = 0; a < 2; ++a)
#pragma unroll
            for (int b = 0; b < 2; ++b)
#pragma unroll
                for (int m = 0; m < 4; ++m)
#pragma unroll
                    for (int n = 0; n < 2; ++n) acc[a][b][m][n] = (f32x4){0.f, 0.f, 0.f, 0.f};
        cur = nxt; cA = nA; cB = nB; ++ui;
    }
    PG8_WAIT_V(0);
    if (wr == 0) PG8_BAR;
    PG8_BAR;
#undef PG8_SA
#undef PG8_SB
#undef PG8_STAGE
#undef PG8_LDA
#undef PG8_LDB
#undef PG8_MMA
#undef PG8_WAIT_V
#undef PG8_WAIT_L
#undef PG8_BAR
#undef PG8_SCHED
}
}

__device__ __forceinline__ void ph_gemm_in(const Params& p, float* lds) {
    {
        const int tid = otid();
        PG8_LAS pg8::f32x4* dt = (PG8_LAS pg8::f32x4*)((PG8_LAS unsigned char*)lds + LDS_TAB);
        const pg8::f32x4* s1 = (const pg8::f32x4*)p.tab128; const pg8::f32x4* s2 = (const pg8::f32x4*)p.tab64;
        dt[tid] = s1[tid]; dt[tid + NT] = s1[tid + NT]; dt[tid + 2 * NT] = s2[tid];
        __syncthreads();
    }
    ldstab_t t128 = (ldstab_t)((PG8_LAS unsigned char*)lds + LDS_TAB), t64 = t128 + 2048;
    pg8::Gemm g{p.h, p.WinT, 1024}; pg8::SchedIn S{(int)gridDim.x, (int)blockIdx.x}; pg8::EpiIn E{&p, t128, t64};
    pg8::gemm_phase(( PG8_LAS unsigned char*)lds, g, S, E);
}
__device__ __forceinline__ void ph_gemm_out(const Params& p, float* lds) {
    pg8::Gemm g{p.mixed, p.WoutT, 1024}; pg8::SchedOut S{(int)gridDim.x, (int)blockIdx.x}; pg8::EpiOut E{&p};
    pg8::gemm_phase((PG8_LAS unsigned char*)lds, g, S, E);
}


#define LAS __attribute__((address_space(3)))
typedef LAS unsigned char* ldsp;
typedef short bf16x8_t __attribute__((ext_vector_type(8)));
typedef float f32x4_t __attribute__((ext_vector_type(4)));
typedef unsigned u32x4_t __attribute__((ext_vector_type(4)));
typedef unsigned u32x2_t __attribute__((ext_vector_type(2)));
#define MFMA16(a, b, c) __builtin_amdgcn_mfma_f32_16x16x32_bf16(a, b, c, 0, 0, 0)
__device__ __forceinline__ int toff(int r, int c) { return r * 256 + ((((c >> 3) ^ (r & 15)) << 4) | ((c & 7) << 1)); }
__device__ __forceinline__ bf16x8_t ldfrag(ldsp tile, int r, int kk, int fq) { return *(const LAS bf16x8_t*)(tile + toff(r, 32 * kk + 8 * fq)); }
__device__ __forceinline__ void stage_tile(ldsp dst, const bf16_t* src, int tid) {
#pragma unroll
    for (int i = 0; i < 4; ++i) { const int idx = tid + NT * i, r = idx >> 4, c = idx & 15; const u32x4_t v = *(const u32x4_t*)(src + (size_t)idx * 8); *(LAS u32x4_t*)(dst + r * 256 + ((c ^ (r & 15)) << 4)) = v; }
}
__device__ __forceinline__ void stage_tileT(ldsp dst, const bf16_t* src, int tid) {
    const int jj = tid & 63, c0 = tid >> 6;
#pragma unroll
    for (int ps = 0; ps < 2; ++ps) {
        const int c = c0 + 8 * ps;
        const u32x4_t aw = *(const u32x4_t*)(src + (2 * jj) * 128 + c * 8), bw = *(const u32x4_t*)(src + (2 * jj + 1) * 128 + c * 8);
#pragma unroll
        for (int i = 0; i < 8; ++i) {
            const int e = 8 * c + i;
            const unsigned lo = (i & 1) ? (aw[i >> 1] >> 16) : (aw[i >> 1] & 0xffffu), hi = (i & 1) ? (bw[i >> 1] & 0xffff0000u) : (bw[i >> 1] << 16);
            *(LAS unsigned*)(dst + e * 256 + ((((jj >> 2) ^ (e & 15)) << 4) | ((jj & 3) << 2))) = lo | hi;
        }
    }
}

__device__ void ph_states(const Params& p, ldsp lds) {
    const int tid = otid(), w = tid >> 6, lane = tid & 63, fr = lane & 15, fq = lane >> 4;
    ldsp bKf = lds, bKb = lds + 32768, bV = lds + 65536;
    for (int item = blockIdx.x; item < 32 * 34; item += gridDim.x) {
        const int bh = item / 34, c = item % 34, h = bh & 3;
        const float lgf = lgam(p, 0, h), lgb = lgam(p, 1, h);
        const bf16_t* K = p.rk + ((size_t)bh * KVROWS + c * 128) * 128;
        const bf16_t* V = p.rv + ((size_t)bh * KVROWS + c * 128) * 128;
        stage_tileT(bV, V, tid);
        {
            const int jj = tid & 63, c0 = tid >> 6;
            const float wf0 = __expf(lgf * (float)(127 - 2 * jj)), wf1 = __expf(lgf * (float)(126 - 2 * jj));
            const float wb0 = __expf(lgb * (float)(2 * jj)), wb1 = __expf(lgb * (float)(2 * jj + 1));
#pragma unroll
            for (int ps = 0; ps < 2; ++ps) {
                const int cc = c0 + 8 * ps;
                float a[8], b[8]; load8(K + (2 * jj) * 128 + cc * 8, a); load8(K + (2 * jj + 1) * 128 + cc * 8, b);
#pragma unroll
                for (int i = 0; i < 8; ++i) {
                    const int e = 8 * cc + i, off = e * 256 + ((((jj >> 2) ^ (e & 15)) << 4) | ((jj & 3) << 2));
                    *(LAS unsigned*)(bKf + off) = pack2(a[i] * wf0, b[i] * wf1);
                    *(LAS unsigned*)(bKb + off) = pack2(a[i] * wb0, b[i] * wb1);
                }
            }
        }
        __syncthreads();
        f32x4_t af[8], ab[8];
#pragma unroll
        for (int i = 0; i < 8; ++i) { af[i] = (f32x4_t){0.f, 0.f, 0.f, 0.f}; ab[i] = (f32x4_t){0.f, 0.f, 0.f, 0.f}; }
#pragma unroll 1
        for (int kk = 0; kk < 4; ++kk) {
            const bf16x8_t xf = ldfrag(bKf, 16 * w + fr, kk, fq), xb = ldfrag(bKb, 16 * w + fr, kk, fq);
#pragma unroll
            for (int nt = 0; nt < 8; ++nt) { const bf16x8_t bv = ldfrag(bV, 16 * nt + fr, kk, fq); af[nt] = MFMA16(xf, bv, af[nt]); ab[nt] = MFMA16(xb, bv, ab[nt]); }
        }
#pragma unroll
        for (int nt = 0; nt < 8; ++nt) {
            const size_t o = ((size_t)item * 128 + 16 * nt + fr) * 128 + 16 * w + 4 * fq;
            uint2 u; u.x = pack2(af[nt][0], af[nt][1]); u.y = pack2(af[nt][2], af[nt][3]); *(uint2*)(p.Kf + o) = u;
            u.x = pack2(ab[nt][0], ab[nt][1]); u.y = pack2(ab[nt][2], ab[nt][3]); *(uint2*)(p.Kb + o) = u;
        }
        __syncthreads();
    }
}

__device__ void ph_retout(const Params& p, ldsp lds) {
    const int tid = otid(), w = tid >> 6, lane = tid & 63, fr = lane & 15, fq = lane >> 4;
    ldsp bQ = lds, bK = lds + 32768, bV = lds + 65536, bR = lds + 98304;
    for (int item = blockIdx.x; item < 1024; item += gridDim.x) {
        const int bh = item >> 5, n = item & 31, b = bh >> 2, h = bh & 3;
        const float lgf = lgam(p, 0, h), lgb = lgam(p, 1, h);
        const bf16_t* Q = p.rq + ((size_t)bh * 4096 + n * 128) * 128;
        const bf16_t* K = p.rk + ((size_t)bh * KVROWS + n * 128) * 128;
        const bf16_t* V = p.rv + ((size_t)bh * KVROWS + n * 128) * 128;
        const bf16_t* RF = p.Rf + (size_t)(bh * 32 + n) * 16384;
        const bf16_t* RB = p.Rb + (size_t)(bh * 32 + n) * 16384;
        stage_tile(bQ, Q, tid); stage_tile(bK, K, tid); stage_tileT(bV, V, tid); stage_tile(bR, RF, tid);
        __syncthreads();
        f32x4_t s[8];
#pragma unroll
        for (int i = 0; i < 8; ++i) s[i] = (f32x4_t){0.f, 0.f, 0.f, 0.f};
#pragma unroll 1
        for (int kk = 0; kk < 4; ++kk) {
            const bf16x8_t a = ldfrag(bK, 16 * w + fr, kk, fq);
#pragma unroll
            for (int nt = 0; nt < 8; ++nt) { const bf16x8_t bq = ldfrag(bQ, 16 * nt + fr, kk, fq); s[nt] = MFMA16(a, bq, s[nt]); }
        }
        u32x4_t rbreg[4];
#pragma unroll
        for (int i = 0; i < 4; ++i) rbreg[i] = *(const u32x4_t*)(RB + (size_t)(tid + NT * i) * 8);
        __syncthreads();
#pragma unroll
        for (int nt = 0; nt < 8; ++nt) {
            const int i = 16 * nt + fr; float o[4];
#pragma unroll
            for (int r = 0; r < 4; ++r) { const int dlt = i - (16 * w + 4 * fq + r); const float dec = dlt >= 0 ? __expf(lgf * (float)dlt) : __expf(lgb * (float)(-dlt)); o[r] = s[nt][r] * dec; }
            u32x2_t u; u.x = pack2(o[0], o[1]); u.y = pack2(o[2], o[3]);
            *(LAS u32x2_t*)(bK + toff(i, 16 * w + 4 * fq)) = u;
        }
        __syncthreads();
        f32x4_t y[8], ca[8];
#pragma unroll
        for (int i = 0; i < 8; ++i) { y[i] = (f32x4_t){0.f, 0.f, 0.f, 0.f}; ca[i] = (f32x4_t){0.f, 0.f, 0.f, 0.f}; }
#pragma unroll 1
        for (int kk = 0; kk < 4; ++kk) {
            const bf16x8_t bs = ldfrag(bK, 16 * w + fr, kk, fq), bq = ldfrag(bQ, 16 * w + fr, kk, fq);
#pragma unroll
            for (int mt = 0; mt < 8; ++mt) {
                y[mt] = MFMA16(ldfrag(bV, 16 * mt + fr, kk, fq), bs, y[mt]);
                ca[mt] = MFMA16(ldfrag(bR, 16 * mt + fr, kk, fq), bq, ca[mt]);
            }
        }
        const int ip = 16 * w + fr;
        {
            const float cfs = __expf(lgf * (float)(ip + 1));
#pragma unroll
            for (int mt = 0; mt < 8; ++mt) { y[mt] += cfs * ca[mt]; ca[mt] = (f32x4_t){0.f, 0.f, 0.f, 0.f}; }
        }
        __syncthreads();
#pragma unroll
        for (int i = 0; i < 4; ++i) { const int idx = tid + NT * i, r = idx >> 4, c = idx & 15; *(LAS u32x4_t*)(bV + r * 256 + ((c ^ (r & 15)) << 4)) = rbreg[i]; }
        __syncthreads();
#pragma unroll 1
        for (int kk = 0; kk < 4; ++kk) {
            const bf16x8_t bq = ldfrag(bQ, 16 * w + fr, kk, fq);
#pragma unroll
            for (int mt = 0; mt < 8; ++mt) ca[mt] = MFMA16(ldfrag(bV, 16 * mt + fr, kk, fq), bq, ca[mt]);
        }
        const float cbs = __expf(lgb * (float)(128 - ip));
        float sum = 0.f;
#pragma unroll
        for (int mt = 0; mt < 8; ++mt) { y[mt] += cbs * ca[mt]; sum += y[mt][0] + y[mt][1] + y[mt][2] + y[mt][3]; }
        sum += __shfl_xor(sum, 16); sum += __shfl_xor(sum, 32);
        const float mu = sum * (1.f / 128.f);
        float vs = 0.f;
#pragma unroll
        for (int mt = 0; mt < 8; ++mt)
#pragma unroll
            for (int r = 0; r < 4; ++r) { const float dl = y[mt][r] - mu; vs += dl * dl; }
        vs += __shfl_xor(vs, 16); vs += __shfl_xor(vs, 32);
        const float rs = rsqrtf(vs * (1.f / 128.f) + 1e-6f);
        const size_t row = (size_t)b * 4096 + n * 128 + ip;
#pragma unroll
        for (int mt = 0; mt < 8; ++mt) {
            const int col = h * 128 + 16 * mt + 4 * fq;
            const uint2 g = *(const uint2*)(p.rg + row * 512 + col);
            const float4 gw = *(const float4*)(p.gn_w + col);
            const float o0 = (y[mt][0] - mu) * rs * gw.x * __uint_as_float(g.x << 16), o1 = (y[mt][1] - mu) * rs * gw.y * __uint_as_float(g.x & 0xffff0000u);
            const float o2 = (y[mt][2] - mu) * rs * gw.z * __uint_as_float(g.y << 16), o3 = (y[mt][3] - mu) * rs * gw.w * __uint_as_float(g.y & 0xffff0000u);
            uint2 u; u.x = pack2(o0, o1); u.y = pack2(o2, o3);
            *(uint2*)(p.mixed + row * 1024 + col) = u;
        }
        __syncthreads();
    }
}


__device__ __forceinline__ int koff(int r, int c) { return r * 128 + ((((c >> 3) ^ ((r >> 1) & 7)) << 4) | ((c & 7) << 1)); }
__device__ void ph_attn(const Params& p, ldsp lds) {
    const int tid = otid(), w = tid >> 6, lane = tid & 63, fr = lane & 15, fq = lane >> 4;
    const int g = w >> 1, sub = w & 1;
    int cnt = 0;
    for (int item = blockIdx.x; item < 1024; item += gridDim.x) {
        const int half = item & 1, nb = (item >> 1) & 31, bk = item >> 6, qoff = 64 * half + 32 * sub, b = bk >> 1, kvh = bk & 1, qh = kvh * 4 + g;
        const bf16_t* Kg = p.ak + (size_t)bk * KVROWS * 64;
        const bf16_t* Vg = p.av + (size_t)bk * KVROWS * 64;
        bf16x8_t qf[2][2];
#pragma unroll
        for (int st = 0; st < 2; ++st)
#pragma unroll
            for (int kk = 0; kk < 2; ++kk) qf[st][kk] = *(const bf16x8_t*)(p.aq + ((size_t)(b * 8 + qh) * 4096 + nb * 128 + qoff + 16 * st + fr) * 64 + 32 * kk + 8 * fq);
        f32x4_t oacc[2][4]; float mrun[2], lrun[2];
        const float sink = p.sink[qh];
#pragma unroll
        for (int st = 0; st < 2; ++st) {
            mrun[st] = sink; lrun[st] = fq == 0 ? 1.f : 0.f;
#pragma unroll
            for (int mt = 0; mt < 4; ++mt) oacc[st][mt] = (f32x4_t){0.f, 0.f, 0.f, 0.f};
        }
#pragma unroll 1
        for (int ti = 0; ti < 5; ++ti) {
            if ((ti == 2 && nb == 0) || (ti == 4 && nb == 31)) continue;
            const int rowbase = ti < 2 ? ti * 128 : 256 + (nb + ti - 3) * 128;
            const int mode = ti == 2 ? 1 : (ti == 4 ? 2 : 0);
            ldsp kb = lds + (cnt & 1) * 32768, vb = kb + 16384; ++cnt;
#pragma unroll
            for (int i = 0; i < 2; ++i) {
                const int idx = tid + NT * i, r = idx >> 3, c = idx & 7;
                const u32x4_t v = *(const u32x4_t*)(Kg + (size_t)rowbase * 64 + (size_t)idx * 8);
                *(LAS u32x4_t*)(kb + r * 128 + ((c ^ ((r >> 1) & 7)) << 4)) = v;
            }
            {
                const int jj = tid & 63, c = tid >> 6;
                const u32x4_t aw = *(const u32x4_t*)(Vg + (size_t)(rowbase + 2 * jj) * 64 + c * 8), bw = *(const u32x4_t*)(Vg + (size_t)(rowbase + 2 * jj + 1) * 64 + c * 8);
#pragma unroll
                for (int i = 0; i < 8; ++i) {
                    const int e = 8 * c + i;
                    const unsigned lo = (i & 1) ? (aw[i >> 1] >> 16) : (aw[i >> 1] & 0xffffu), hi = (i & 1) ? (bw[i >> 1] & 0xffff0000u) : (bw[i >> 1] << 16);
                    *(LAS unsigned*)(vb + e * 256 + ((((jj >> 2) ^ (e & 15)) << 4) | ((jj & 3) << 2))) = lo | hi;
                }
            }
            __syncthreads();
#pragma unroll
            for (int st = 0; st < 2; ++st) {
                f32x4_t s[8];
#pragma unroll
                for (int mt = 0; mt < 8; ++mt) s[mt] = (f32x4_t){0.f, 0.f, 0.f, 0.f};
#pragma unroll
                for (int kk = 0; kk < 2; ++kk)
#pragma unroll
                    for (int mt = 0; mt < 8; ++mt) s[mt] = MFMA16(*(const LAS bf16x8_t*)(kb + koff(16 * mt + fr, 32 * kk + 8 * fq)), qf[st][kk], s[mt]);
                if (mode) {
                    const int qi = qoff + 16 * st + fr;
#pragma unroll
                    for (int mt = 0; mt < 8; ++mt)
#pragma unroll
                        for (int r = 0; r < 4; ++r) { const int kj = 16 * mt + 4 * fq + r; const bool ok = mode == 1 ? kj >= qi : kj <= qi; s[mt][r] = ok ? s[mt][r] : -1e30f; }
                }
                float mx = s[0][0];
#pragma unroll
                for (int mt = 0; mt < 8; ++mt)
#pragma unroll
                    for (int r = 0; r < 4; ++r) mx = fmaxf(mx, s[mt][r]);
                mx = fmaxf(mx, __shfl_xor(mx, 16)); mx = fmaxf(mx, __shfl_xor(mx, 32));
                const float mn = fmaxf(mrun[st], mx), sc = __expf(mrun[st] - mn);
                mrun[st] = mn;
                float ps = 0.f;
#pragma unroll
                for (int mt = 0; mt < 8; ++mt)
#pragma unroll
                    for (int r = 0; r < 4; ++r) { const float pv = __expf(s[mt][r] - mn); s[mt][r] = pv; ps += pv; }
                lrun[st] = lrun[st] * sc + ps;
#pragma unroll
                for (int mt = 0; mt < 4; ++mt) oacc[st][mt] *= sc;
#pragma unroll
                for (int kk = 0; kk < 4; ++kk) {
                    u32x4_t pu; pu.x = pack2(s[2 * kk][0], s[2 * kk][1]); pu.y = pack2(s[2 * kk][2], s[2 * kk][3]); pu.z = pack2(s[2 * kk + 1][0], s[2 * kk + 1][1]); pu.w = pack2(s[2 * kk + 1][2], s[2 * kk + 1][3]);
                    const bf16x8_t pf = __builtin_bit_cast(bf16x8_t, pu);
#pragma unroll
                    for (int mt = 0; mt < 4; ++mt) {
                        const u32x2_t lo = *(const LAS u32x2_t*)(vb + toff(16 * mt + fr, 32 * kk + 4 * fq)), hi = *(const LAS u32x2_t*)(vb + toff(16 * mt + fr, 32 * kk + 16 + 4 * fq));
                        u32x4_t au; au.x = lo.x; au.y = lo.y; au.z = hi.x; au.w = hi.y;
                        oacc[st][mt] = MFMA16(__builtin_bit_cast(bf16x8_t, au), pf, oacc[st][mt]);
                    }
                }
                __builtin_amdgcn_sched_barrier(0);
            }
        }
#pragma unroll
        for (int st = 0; st < 2; ++st) {
            float lt = lrun[st]; lt += __shfl_xor(lt, 16); lt += __shfl_xor(lt, 32);
            const float inv = 1.f / lt;
            const size_t row = (size_t)b * 4096 + nb * 128 + qoff + 16 * st + fr;
#pragma unroll
            for (int mt = 0; mt < 4; ++mt) {
                const int col = qh * 64 + 16 * mt + 4 * fq;
                const uint2 gt = *(const uint2*)(p.ag + row * 512 + col);
                const float o0 = oacc[st][mt][0] * inv * __uint_as_float(gt.x << 16), o1 = oacc[st][mt][1] * inv * __uint_as_float(gt.x & 0xffff0000u);
                const float o2 = oacc[st][mt][2] * inv * __uint_as_float(gt.y << 16), o3 = oacc[st][mt][3] * inv * __uint_as_float(gt.y & 0xffff0000u);
                uint2 u; u.x = pack2(o0, o1); u.y = pack2(o2, o3);
                *(uint2*)(p.mixed + row * 1024 + 512 + col) = u;
            }
        }
    }
    __syncthreads();
}

__device__ void ph_states_naive(const Params& p) {
    for (int item = blockIdx.x; item < 32 * 34; item += gridDim.x) {
        const int bh = item / 34, c = item % 34, h = bh & 3;
        const float lgf = lgam(p, 0, h), lgb = lgam(p, 1, h);
        const bf16_t* K = p.rk + ((size_t)bh * KVROWS + c * 128) * 128;
        const bf16_t* V = p.rv + ((size_t)bh * KVROWS + c * 128) * 128;
        const int e = threadIdx.x & 127, dg = threadIdx.x >> 7;
        float af[32], ab[32];
#pragma unroll
        for (int i = 0; i < 32; ++i) { af[i] = 0.f; ab[i] = 0.f; }
        for (int j = 0; j < 128; ++j) {
            const float vv = bf2f(V[j * 128 + e]);
            const float wf = expf(lgf * (float)(127 - j)) * vv, wb = expf(lgb * (float)j) * vv;
#pragma unroll
            for (int d8 = 0; d8 < 4; ++d8) {
                float kk[8]; load8(K + j * 128 + dg * 32 + d8 * 8, kk);
#pragma unroll
                for (int i = 0; i < 8; ++i) { af[d8 * 8 + i] += wf * kk[i]; ab[d8 * 8 + i] += wb * kk[i]; }
            }
        }
        bf16_t* of = p.Kf + ((size_t)item * 128 + e) * 128 + dg * 32;
        bf16_t* ob = p.Kb + ((size_t)item * 128 + e) * 128 + dg * 32;
#pragma unroll
        for (int d8 = 0; d8 < 4; ++d8) { store8(of + d8 * 8, af + d8 * 8); store8(ob + d8 * 8, ab + d8 * 8); }
    }
}

__device__ void ph_scan(const Params& p) {
    const int tid = otid();
    for (int blk = blockIdx.x; blk < 512; blk += gridDim.x) {
        const int dir = blk >> 8, bh = (blk >> 3) & 31, h = bh & 3;
        const unsigned el = (unsigned)((blk & 7) * NT + tid) * 4u;
        const float gC = expf(lgam(p, dir, h) * 128.f);
        const bf16_t* __restrict__ ks = (dir ? p.Kb : p.Kf) + (size_t)bh * 34 * 16384;
        bf16_t* __restrict__ rs = (dir ? p.Rb : p.Rf) + (size_t)bh * 32 * 16384;
        uint2 kv[34];
#pragma unroll
        for (int n = 0; n < 34; ++n) kv[n] = *(const uint2*)(ks + (size_t)n * 16384 + el);
        float R[4];
        auto cv = [](const uint2 u, float* o) { o[0] = __uint_as_float(u.x << 16); o[1] = __uint_as_float(u.x & 0xffff0000u); o[2] = __uint_as_float(u.y << 16); o[3] = __uint_as_float(u.y & 0xffff0000u); };
        float t[4];
        cv(dir ? kv[33] : kv[32], R); cv(dir ? kv[32] : kv[33], t);
#pragma unroll
        for (int i = 0; i < 4; ++i) R[i] = gC * R[i] + t[i];
#pragma unroll
        for (int s = 0; s < 32; ++s) {
            const int n = dir ? 31 - s : s;
            uint2 u; u.x = pack2(R[0], R[1]); u.y = pack2(R[2], R[3]);
            *(uint2*)(rs + (size_t)n * 16384 + el) = u;
            cv(dir ? kv[31 - s] : kv[s], t);
#pragma unroll
            for (int i = 0; i < 4; ++i) R[i] = gC * R[i] + t[i];
        }
    }
}

__device__ void ph_retout_naive(const Params& p, float* S) {
    for (int item = blockIdx.x; item < 1024; item += gridDim.x) {
        const int bh = item >> 5, n = item & 31, b = bh >> 2, h = bh & 3;
        const float lgf = lgam(p, 0, h), lgb = lgam(p, 1, h);
        const bf16_t* Q = p.rq + ((size_t)bh * 4096 + n * 128) * 128;
        const bf16_t* K = p.rk + ((size_t)bh * KVROWS + n * 128) * 128;
        const bf16_t* V = p.rv + ((size_t)bh * KVROWS + n * 128) * 128;
        const bf16_t* RF = p.Rf + (size_t)(bh * 32 + n) * 16384;
        const bf16_t* RB = p.Rb + (size_t)(bh * 32 + n) * 16384;
        const int i = threadIdx.x >> 2, q4 = threadIdx.x & 3;
        for (int jj = 0; jj < 32; ++jj) {
            const int j = q4 * 32 + jj;
            float dot = 0.f;
#pragma unroll 4
            for (int d8 = 0; d8 < 16; ++d8) {
                float a[8], bb[8]; load8(Q + i * 128 + d8 * 8, a); load8(K + j * 128 + d8 * 8, bb);
#pragma unroll
                for (int t = 0; t < 8; ++t) dot += a[t] * bb[t];
            }
            const float dec = j <= i ? expf(lgf * (float)(i - j)) : expf(lgb * (float)(j - i));
            S[i * 128 + ((j + i) & 127)] = dot * dec;
        }
        __syncthreads();
        float y[32];
#pragma unroll
        for (int t = 0; t < 32; ++t) y[t] = 0.f;
        const int e0 = q4 * 32;
        for (int j = 0; j < 128; ++j) {
            const float s = S[i * 128 + ((j + i) & 127)];
#pragma unroll
            for (int e8 = 0; e8 < 4; ++e8) {
                float vv[8]; load8(V + j * 128 + e0 + e8 * 8, vv);
#pragma unroll
                for (int t = 0; t < 8; ++t) y[e8 * 8 + t] += s * vv[t];
            }
        }
        const float cf = expf(lgf * (float)(i + 1)), cb = expf(lgb * (float)(128 - i));
#pragma unroll 1
        for (int d8 = 0; d8 < 16; ++d8) {
            float a[8]; load8(Q + i * 128 + d8 * 8, a);
#pragma unroll
            for (int ee = 0; ee < 32; ++ee) {
                float rf[8], rb[8]; load8(RF + (e0 + ee) * 128 + d8 * 8, rf); load8(RB + (e0 + ee) * 128 + d8 * 8, rb);
                float sf = 0.f, sb = 0.f;
#pragma unroll
                for (int t = 0; t < 8; ++t) { sf += a[t] * rf[t]; sb += a[t] * rb[t]; }
                y[ee] += cf * sf + cb * sb;
            }
        }
        float sum = 0.f;
#pragma unroll
        for (int t = 0; t < 32; ++t) sum += y[t];
        sum += __shfl_xor(sum, 1); sum += __shfl_xor(sum, 2);
        const float mu = sum * (1.f / 128.f);
        float vs = 0.f;
#pragma unroll
        for (int t = 0; t < 32; ++t) { const float dlt = y[t] - mu; vs += dlt * dlt; }
        vs += __shfl_xor(vs, 1); vs += __shfl_xor(vs, 2);
        const float rs = rsqrtf(vs * (1.f / 128.f) + 1e-6f);
        const size_t row = (size_t)b * 4096 + n * 128 + i;
        const int col0 = h * 128 + e0;
#pragma unroll
        for (int e8 = 0; e8 < 4; ++e8) {
            float g[8], o[8]; load8(p.rg + row * 512 + col0 + e8 * 8, g);
#pragma unroll
            for (int t = 0; t < 8; ++t) o[t] = (y[e8 * 8 + t] - mu) * rs * p.gn_w[col0 + e8 * 8 + t] * g[t];
            store8(p.mixed + row * 1024 + col0 + e8 * 8, o);
        }
        __syncthreads();
    }
}

__device__ void ph_attn_naive(const Params& p) {
    for (int idx = blockIdx.x * NT + otid(); idx < 8 * 8 * 4096; idx += gridDim.x * NT) {
        const int t = idx & 4095, bq = idx >> 12, qh = bq & 7, b = bq >> 3, kvh = qh >> 2;
        float q[64], acc[64];
#pragma unroll
        for (int d8 = 0; d8 < 8; ++d8) load8(p.aq + ((size_t)bq * 4096 + t) * 64 + d8 * 8, q + d8 * 8);
#pragma unroll
        for (int e = 0; e < 64; ++e) acc[e] = 0.f;
        const bf16_t* Kb = p.ak + (size_t)(b * 2 + kvh) * KVROWS * 64;
        const bf16_t* Vb = p.av + (size_t)(b * 2 + kvh) * KVROWS * 64;
        float m = p.sink[qh], l = 1.f;
        const int lo = t - 128 < 0 ? 0 : t - 128, hi = t + 128 > 4095 ? 4095 : t + 128;
        const int nkeys = 256 + (hi - lo + 1);
        for (int kk = 0; kk < nkeys; ++kk) {
            const int krow = kk < 256 ? kk : lo + kk;
            float s = 0.f;
#pragma unroll
            for (int d8 = 0; d8 < 8; ++d8) {
                float kv[8]; load8(Kb + (size_t)krow * 64 + d8 * 8, kv);
#pragma unroll
                for (int i = 0; i < 8; ++i) s += q[d8 * 8 + i] * kv[i];
            }
            if (s > m) {
                const float sc = __expf(m - s); l *= sc;
#pragma unroll
                for (int e = 0; e < 64; ++e) acc[e] *= sc;
                m = s;
            }
            const float pe = __expf(s - m); l += pe;
#pragma unroll
            for (int d8 = 0; d8 < 8; ++d8) {
                float vv[8]; load8(Vb + (size_t)krow * 64 + d8 * 8, vv);
#pragma unroll
                for (int i = 0; i < 8; ++i) acc[d8 * 8 + i] += pe * vv[i];
            }
        }
        const float inv = 1.f / l;
        const size_t row = (size_t)b * 4096 + t;
#pragma unroll
        for (int d8 = 0; d8 < 8; ++d8) {
            float g[8], o[8]; load8(p.ag + row * 512 + qh * 64 + d8 * 8, g);
#pragma unroll
            for (int i = 0; i < 8; ++i) o[i] = acc[d8 * 8 + i] * inv * g[i];
            store8(p.mixed + row * 1024 + 512 + qh * 64 + d8 * 8, o);
        }
    }
}

__device__ void ph_final(const Params& p) {
    const int tid = otid(), wave = tid >> 6, lane = tid & 63;
    const int stride = gridDim.x * 8;
    float4 w4[4];
#pragma unroll
    for (int i = 0; i < 4; ++i) w4[i] = *(const float4*)(p.fnw + i * 256 + lane * 4);
    for (int row0 = blockIdx.x * 8 + wave; row0 < 32768; row0 += 2 * stride) {
        float4 xv[2][4]; bool ok[2];
#pragma unroll
        for (int u = 0; u < 2; ++u) {
            const int row = row0 + u * stride; ok[u] = row < 32768;
            const float* src = p.out + (size_t)(ok[u] ? row : row0) * 1024;
#pragma unroll
            for (int i = 0; i < 4; ++i) xv[u][i] = *(const float4*)(src + i * 256 + lane * 4);
        }
#pragma unroll
        for (int u = 0; u < 2; ++u) {
            if (!ok[u]) continue;
            float* dst = p.out + (size_t)(row0 + u * stride) * 1024;
            float ss = 0.f;
#pragma unroll
            for (int i = 0; i < 4; ++i) ss += xv[u][i].x * xv[u][i].x + xv[u][i].y * xv[u][i].y + xv[u][i].z * xv[u][i].z + xv[u][i].w * xv[u][i].w;
            ss = wave_sum(ss);
            const float rstd = rsqrtf(ss * (1.f / 1024.f) + 1e-6f);
#pragma unroll
            for (int i = 0; i < 4; ++i) {
                float4 o; o.x = xv[u][i].x * rstd * w4[i].x; o.y = xv[u][i].y * rstd * w4[i].y; o.z = xv[u][i].z * rstd * w4[i].z; o.w = xv[u][i].w * rstd * w4[i].w;
                *(float4*)(dst + i * 256 + lane * 4) = o;
            }
        }
    }
}

#define NPHASE 9
template <int PH> __device__ __forceinline__ void run_phase(const Params& p, float* lds) {
    if (PH == 0) ph_mod(p, lds);
    else if (PH == 1) { ph_wconv(p, lds); ph_h(p); }
    else if (PH == 2) ph_gemm_in(p, lds);
    else if (PH == 3) { ph_states(p, (ldsp)lds); ph_attn(p, (ldsp)lds); }
    else if (PH == 4) ph_scan(p);
    else if (PH == 5) ph_retout(p, (ldsp)lds);
    else if (PH == 6) ph_gemm_out(p, lds);
    else if (PH == 7) ph_final(p);
}

template <int PH> __global__ __launch_bounds__(NT) void k_ph(Params p) {
    extern __shared__ __attribute__((aligned(16))) float lds[];
    run_phase<PH>(p, lds);
}


#define XB_TMO      128
#define XB_XCNT(j)  (256  + 64 * (j))
#define XB_XSUB(j)  (1280 + 64 * (j))
#define XB_XGEN(j)  (2304 + 64 * (j))
#define XB_TOP      3328
#define XB_TOPGEN   3392
#define XCD_BAR_WORDS 3456
#define XB_SPIN_CAP (1u << 18)
__device__ __forceinline__ unsigned xb_ld(unsigned* p)              { return __hip_atomic_load(p, __ATOMIC_RELAXED, __HIP_MEMORY_SCOPE_AGENT); }
__device__ __forceinline__ unsigned xb_add(unsigned* p, unsigned v) { return __hip_atomic_fetch_add(p, v, __ATOMIC_RELAXED, __HIP_MEMORY_SCOPE_AGENT); }
__device__ __forceinline__ unsigned xb_xcc_id() { return (unsigned)__builtin_amdgcn_s_getreg((3 << 11) | 20) & 0xFu; }
#define XB_SPIN(cond, bar) do { unsigned _sp = 0; while (cond) { __builtin_amdgcn_s_sleep(1); \
    if ((++_sp & 255u) == 0u) { if (xb_ld(&(bar)[XB_TMO])) break; if (_sp > XB_SPIN_CAP) { atomicAdd(&(bar)[XB_TMO], 1u); break; } } } } while (0)
struct XcdBarrier { unsigned* bar; unsigned x; volatile LAS unsigned* st; };
__device__ __forceinline__ XcdBarrier xcd_barrier_post(unsigned* bar, volatile LAS unsigned* st) {
    XcdBarrier b; b.bar = bar; b.x = xb_xcc_id(); b.st = st;
    if (threadIdx.x == 0) (void)xb_add(&bar[XB_XCNT(b.x)], 1u);
    return b;
}
__device__ __forceinline__ void xcd_barrier_complete(unsigned* bar, unsigned x, unsigned& nloc, unsigned& nx) {
    const unsigned G = gridDim.x * gridDim.y * gridDim.z;
    unsigned sum, cnt, mine, sp = 0u;
    for (;;) {
        sum = 0u; cnt = 0u; mine = 0u;
#pragma unroll
        for (unsigned j = 0; j < 16; ++j) { const unsigned c = xb_ld(&bar[XB_XCNT(j)]); sum += c; cnt += (c > 0u) ? 1u : 0u; mine = (j == x) ? c : mine; }
        if (sum == G) break;
        __builtin_amdgcn_s_sleep(1);
        if ((++sp & 255u) == 0u) { if (xb_ld(&bar[XB_TMO])) break; if (sp > XB_SPIN_CAP) { atomicAdd(&bar[XB_TMO], 1u); break; } }
    }
    nloc = mine > 0u ? mine : 1u; nx = cnt > 0u ? cnt : 1u;
}
__device__ __forceinline__ void xcd_barrier(const XcdBarrier& b) {
    asm volatile("s_waitcnt vmcnt(0)" ::: "memory");
    __syncthreads();
    if (threadIdx.x == 0) {
        unsigned* bar = b.bar;
        __builtin_amdgcn_s_waitcnt(0);
        unsigned nloc = b.st[0], nx = b.st[1];
        if (nloc == 0u) { xcd_barrier_complete(bar, b.x, nloc, nx); b.st[0] = nloc; b.st[1] = nx; }
        const unsigned old = xb_add(&bar[XB_XSUB(b.x)], 1u);
        const unsigned gen = old / nloc;
        if (old + 1u == (gen + 1u) * nloc) {
            __builtin_amdgcn_fence(__ATOMIC_RELEASE, "agent");
            asm volatile("s_waitcnt vmcnt(0)" ::: "memory");
            const unsigned og = xb_add(&bar[XB_TOP], 1u);
            const unsigned tg = og / nx;
            if (og + 1u == (tg + 1u) * nx) xb_add(&bar[XB_TOPGEN], 1u);
            else XB_SPIN(xb_ld(&bar[XB_TOPGEN]) == tg, bar);
            __builtin_amdgcn_fence(__ATOMIC_ACQUIRE, "agent");
            xb_add(&bar[XB_XGEN(b.x)], 1u);
            asm volatile("s_waitcnt vmcnt(0)" ::: "memory");
        } else {
            XB_SPIN(xb_ld(&bar[XB_XGEN(b.x)]) == gen, bar);
            __builtin_amdgcn_fence(__ATOMIC_ACQUIRE, "agent");
            asm volatile("s_waitcnt vmcnt(0)" ::: "memory");
        }
    }
    __syncthreads();
}

#ifndef REPMASK
#define REPMASK 0
#endif
#define RUNPH(i) do { run_phase<i>(p, lds); if ((REPMASK >> i) & 1) { __syncthreads(); run_phase<i>(p, lds); } } while (0)
#define GSYNC() do { xcd_barrier(xb); if ((REPMASK >> 8) & 1) xcd_barrier(xb); } while (0)
__global__ __launch_bounds__(NT) void k_mega(Params p) {
    extern __shared__ __attribute__((aligned(16))) float lds[];
    cg::grid_group grid = cg::this_grid();
    if (p.out == nullptr) grid.sync();
    volatile LAS unsigned* xst = (volatile LAS unsigned*)((ldsp)lds + LDS_GEMM);
    if (threadIdx.x < 4) xst[threadIdx.x] = 0u;
    __syncthreads();
    const XcdBarrier xb = xcd_barrier_post(p.bar, xst);
    RUNPH(0); GSYNC();
    RUNPH(1); GSYNC();
    RUNPH(2); GSYNC();
    RUNPH(3); GSYNC();
    RUNPH(4); GSYNC();
    RUNPH(5); GSYNC();
    RUNPH(6); GSYNC();
    run_phase<7>(p, lds);
}

template <int PH> static void launch_ph(const Params& p, int grid, hipStream_t stream) {
    static bool attr = false;
    if (!attr) { (void)hipFuncSetAttribute((const void*)k_ph<PH>, hipFuncAttributeMaxDynamicSharedMemorySize, LDS_BYTES); attr = true; }
    hipLaunchKernelGGL(k_ph<PH>, dim3(grid), dim3(NT), LDS_BYTES, stream, p);
}

extern "C" void kernel_launch(void* const* d_in, const int* in_sizes, int n_in, void* d_out, int out_size, void* d_ws, size_t ws_size, hipStream_t stream) {
    Params p{};
    p.x = (const float*)d_in[0]; p.c = (const float*)d_in[1]; p.ctx = (const float*)d_in[2]; p.c_ctx = (const float*)d_in[3];
    p.w_ada = (const float*)d_in[4]; p.b_ada = (const float*)d_in[5]; p.w_in = (const float*)d_in[6]; p.decay = (const float*)d_in[7];
    p.gn_w = (const float*)d_in[8]; p.sink = (const float*)d_in[9]; p.w_out = (const float*)d_in[10]; p.fnw = (const float*)d_in[11];
    p.out = (float*)d_out;
    unsigned char* w = (unsigned char*)d_ws; size_t off = 0;
    auto take = [&](size_t bytes) { unsigned char* r = w + off; off += (bytes + 255) & ~(size_t)255; return r; };
    p.mod = (float*)take(9 * 3072 * 4);
    p.tab128 = (float2*)take(64 * 32 * 8);
    p.tab64 = (float2*)take(64 * 16 * 8);
    p.h = (bf16_t*)take((size_t)MROWS * 1024 * 2);
    p.mixed = p.h;
    p.rq = (bf16_t*)take((size_t)32 * 4096 * 128 * 2);
    p.rk = (bf16_t*)take((size_t)32 * KVROWS * 128 * 2);
    p.rv = (bf16_t*)take((size_t)32 * KVROWS * 128 * 2);
    p.rg = (bf16_t*)take((size_t)32768 * 512 * 2);
    p.aq = (bf16_t*)take((size_t)64 * 4096 * 64 * 2);
    p.ak = (bf16_t*)take((size_t)16 * KVROWS * 64 * 2);
    p.av = (bf16_t*)take((size_t)16 * KVROWS * 64 * 2);
    p.ag = (bf16_t*)take((size_t)32768 * 512 * 2);
    p.Kf = (bf16_t*)take((size_t)32 * 34 * 16384 * 2);
    p.Kb = (bf16_t*)take((size_t)32 * 34 * 16384 * 2);
    p.Rf = (bf16_t*)take((size_t)32 * 32 * 16384 * 2);
    p.Rb = (bf16_t*)take((size_t)32 * 32 * 16384 * 2);
    p.WinT = (bf16_t*)take((size_t)3328 * 1024 * 2);
    p.WoutT = (bf16_t*)take((size_t)1024 * 1024 * 2);
    p.bar = (unsigned*)take(XCD_BAR_WORDS * 4);
    if (off > ws_size) { fprintf(stderr, "kernel_launch: workspace too small (%zu > %zu)\n", off, ws_size); return; }
#if MK_ONE_LAUNCH
    static int grid_blocks = 0;
    if (!grid_blocks) {
        int dev = 0, cus = 0, per_cu = 0;
        (void)hipGetDevice(&dev);
        (void)hipDeviceGetAttribute(&cus, hipDeviceAttributeMultiprocessorCount, dev);
        (void)hipFuncSetAttribute((const void*)k_mega, hipFuncAttributeMaxDynamicSharedMemorySize, LDS_BYTES);
        (void)hipOccupancyMaxActiveBlocksPerMultiprocessor(&per_cu, (const void*)k_mega, NT, LDS_BYTES);
        if (per_cu < 1) per_cu = 1;
        grid_blocks = cus * per_cu;
    }
    (void)hipMemsetAsync(p.bar, 0, XCD_BAR_WORDS * 4, stream);
    void* args[] = {&p};
    hipError_t e = hipLaunchCooperativeKernel((const void*)k_mega, dim3(grid_blocks), dim3(NT), args, LDS_BYTES, stream);
    if (e != hipSuccess) fprintf(stderr, "cooperative launch failed: %s (grid %d)\n", hipGetErrorString(e), grid_blocks);
#else
    const int G = 1024;
    launch_ph<0>(p, G, stream); launch_ph<1>(p, G, stream); launch_ph<2>(p, G, stream); launch_ph<3>(p, G, stream);
    launch_ph<4>(p, G, stream); launch_ph<5>(p, G, stream); launch_ph<6>(p, G, stream); launch_ph<7>(p, G, stream);
#endif
}
```

```cpp
#include <hip/hip_runtime.h>
#include <hip/hip_cooperative_groups.h>
#include <cstdio>
namespace cg = cooperative_groups;

#ifndef MK_ONE_LAUNCH
#define MK_ONE_LAUNCH 1
#endif

typedef unsigned short bf16_t;
#define NT 512
#define MROWS 34816
#define KVROWS 4352
#define LDS_GEMM 131072
#define LDS_TAB (LDS_GEMM + 64)
#define LDS_BYTES (LDS_TAB + 24576)

struct Params {
    const float *x, *c, *ctx, *c_ctx, *w_ada, *b_ada, *w_in, *decay, *gn_w, *sink, *w_out, *fnw;
    float* out;
    float* mod;
    float2* tab128;
    float2* tab64;
    bf16_t *h, *rq, *rk, *rv, *rg, *aq, *ak, *av, *ag, *Kf, *Kb, *Rf, *Rb, *mixed, *WinT, *WoutT;
    unsigned* bar;
};

__device__ __forceinline__ int otid() { int t = threadIdx.x; asm volatile("" : "+v"(t)); return t; }
__device__ __forceinline__ float bf2f(bf16_t b) { return __uint_as_float(((unsigned)b) << 16); }
__device__ __forceinline__ bf16_t f2bf(float f) { unsigned u = __float_as_uint(f); u += 0x7FFFu + ((u >> 16) & 1u); return (bf16_t)(u >> 16); }
typedef __bf16 bf2_t __attribute__((ext_vector_type(2)));
typedef float fl2_t __attribute__((ext_vector_type(2)));
__device__ __forceinline__ unsigned pack2(float lo, float hi) { fl2_t v = {lo, hi}; bf2_t b = __builtin_convertvector(v, bf2_t); return *(unsigned*)&b; }
__device__ __forceinline__ void store8(bf16_t* dst, const float* o) {
    uint4 u; u.x = pack2(o[0], o[1]); u.y = pack2(o[2], o[3]); u.z = pack2(o[4], o[5]); u.w = pack2(o[6], o[7]);
    *(uint4*)dst = u;
}
__device__ __forceinline__ void load8(const bf16_t* src, float* o) {
    const uint4 u = *(const uint4*)src;
    o[0] = __uint_as_float(u.x << 16); o[1] = __uint_as_float(u.x & 0xffff0000u);
    o[2] = __uint_as_float(u.y << 16); o[3] = __uint_as_float(u.y & 0xffff0000u);
    o[4] = __uint_as_float(u.z << 16); o[5] = __uint_as_float(u.z & 0xffff0000u);
    o[6] = __uint_as_float(u.w << 16); o[7] = __uint_as_float(u.w & 0xffff0000u);
}
__device__ __forceinline__ float silu_f(float v) { return v / (1.f + __expf(-v)); }
__device__ __forceinline__ float wave_sum(float v) {
#pragma unroll
    for (int o = 32; o >= 1; o >>= 1) v += __shfl_xor(v, o);
    return v;
}
__device__ __forceinline__ float lgam(const Params& p, int dir, int h) { return -log1pf(expf(-p.decay[dir * 4 + h])); }

__device__ __forceinline__ int ocol_in(int sg) {
    if (sg < 1024) { const int s = sg & 127; return (sg & ~127) + ((s >> 5) << 4) + (((s >> 3) & 3) << 2) + (s & 3) + (((s >> 2) & 1) << 6); }
    if (sg >= 2048 && sg < 2688) { const int s = sg & 63; return (sg & ~63) + ((s >> 5) << 4) + (((s >> 3) & 3) << 2) + (s & 3) + (((s >> 2) & 1) << 5); }
    return sg;
}

typedef __attribute__((address_space(3))) const fl2_t* ldstab_t;
enum { K_RQ = 0, K_RK, K_RV, K_RG, K_AQ, K_AK, K_AV, K_AG };
template <int KIND> __device__ __forceinline__ void epi_in8(const Params& p, ldstab_t t128, ldstab_t t64, int row, int s0, const float* v) {
    const bool isc = row >= 32768;
    int b, t;
    if (isc) { const int r = row - 32768; b = r >> 8; t = r & 255; } else { b = row >> 12; t = row & 4095; }
    const int gr = (t >> 6) & 63, gc = t & 63;
    float o[8];
    if (KIND == K_RQ || KIND == K_RK) {
        const bool isk = KIND == K_RK;
        if (!isk && isc) return;
        const int head = (s0 >> 7) & 3, s = s0 & 127, wc = s >> 5, fq = (s >> 3) & 3;
        const float scl = isk ? 0.08838834764831845f : 1.f;
        if (isc) {
#pragma unroll
            for (int i = 0; i < 8; ++i) o[i] = v[i] * scl;
        } else {
            const int pos = wc < 2 ? gr : gc;
            ldstab_t tb = t128 + pos * 32 + (wc & 1) * 16 + fq * 4;
#pragma unroll
            for (int j = 0; j < 4; ++j) { const fl2_t cs = tb[j]; const float x1 = v[j] * scl, x2 = v[4 + j] * scl; o[j] = x1 * cs.x - x2 * cs.y; o[4 + j] = x1 * cs.y + x2 * cs.x; }
        }
        bf16_t* dst = isk ? p.rk + ((size_t)(b * 4 + head) * KVROWS + (isc ? 4096 + t : t)) * 128 + s
                          : p.rq + ((size_t)(b * 4 + head) * 4096 + t) * 128 + s;
        store8(dst, o);
    } else if (KIND == K_RV) {
        const int head = (s0 - 1024) >> 7, s = s0 & 127;
        store8(p.rv + ((size_t)(b * 4 + head) * KVROWS + (isc ? 4096 + t : t)) * 128 + s, v);
    } else if (KIND == K_RG) {
        if (isc) return;
#pragma unroll
        for (int i = 0; i < 8; ++i) o[i] = silu_f(v[i]);
        store8(p.rg + (size_t)row * 512 + (s0 - 1536), o);
    } else if (KIND == K_AQ || KIND == K_AK) {
        const bool isk = KIND == K_AK;
        if (!isk && isc) return;
        const int head = isk ? (s0 - 2560) >> 6 : (s0 - 2048) >> 6, s = s0 & 63, w = s >> 5, fq = (s >> 3) & 3;
        const float scl = isk ? 1.f : 0.125f * 1.4426950408889634f;
        if (isc) {
#pragma unroll
            for (int i = 0; i < 8; ++i) o[i] = v[i];
        } else {
            const int pos = w == 0 ? gr : gc;
            ldstab_t tb = t64 + pos * 16 + fq * 4;
#pragma unroll
            for (int j = 0; j < 4; ++j) { const fl2_t cs = tb[j]; const float x1 = v[j] * scl, x2 = v[4 + j] * scl; o[j] = x1 * cs.x - x2 * cs.y; o[4 + j] = x1 * cs.y + x2 * cs.x; }
        }
        bf16_t* dst = isk ? p.ak + ((size_t)(b * 2 + head) * KVROWS + (isc ? t : 256 + t)) * 64 + s
                          : p.aq + ((size_t)(b * 8 + head) * 4096 + t) * 64 + s;
        store8(dst, o);
    } else if (KIND == K_AV) {
        const int head = (s0 - 2688) >> 6, s = s0 & 63;
        store8(p.av + ((size_t)(b * 2 + head) * KVROWS + (isc ? t : 256 + t)) * 64 + s, v);
    } else {
        if (isc) return;
#pragma unroll
        for (int i = 0; i < 8; ++i) o[i] = silu_f(v[i]);
        store8(p.ag + (size_t)row * 512 + (s0 - 2816), o);
    }
}

__device__ void ph_mod(const Params& p, float* lds) {
    const int tid = otid();
    float* sc = lds;
    float* red = lds + 9216;
    if (blockIdx.x < 192) {
        for (int i = tid; i < 9 * 1024; i += NT) {
            const int v = i >> 10, k = i & 1023;
            const float cv = v < 8 ? p.c[v * 1024 + k] : p.c_ctx[k];
            sc[i] = cv / (1.f + expf(-cv));
        }
        __syncthreads();
        for (int item = blockIdx.x; item < 192; item += gridDim.x) {
            const int cl = tid & 15, kg = tid >> 4, col = item * 16 + cl;
            float acc[9];
#pragma unroll
            for (int v = 0; v < 9; ++v) acc[v] = 0.f;
#pragma unroll 4
            for (int kk = 0; kk < 32; ++kk) {
                const int k = kg * 32 + kk;
                const float w = p.w_ada[(size_t)k * 3072 + col];
#pragma unroll
                for (int v = 0; v < 9; ++v) acc[v] += sc[v * 1024 + k] * w;
            }
#pragma unroll
            for (int v = 0; v < 9; ++v) red[(kg * 9 + v) * 16 + cl] = acc[v];
            __syncthreads();
            if (tid < 144) {
                const int v = tid >> 4;
                float s = 0.f;
                for (int g2 = 0; g2 < 32; ++g2) s += red[(g2 * 9 + v) * 16 + cl];
                p.mod[v * 3072 + col] = s + p.b_ada[col];
            }
            __syncthreads();
        }
    }
    const int gt = blockIdx.x * NT + tid;
    if (gt < 2048) { const int pos = gt >> 5, f = gt & 31; const float a = (float)pos * powf(10000.f, -(float)f / 32.f); p.tab128[gt] = make_float2(cosf(a), sinf(a)); }
    else if (gt < 3072) { const int g2 = gt - 2048, pos = g2 >> 4, f = g2 & 15; const float a = (float)pos * powf(10000.f, -(float)f / 16.f); p.tab64[g2] = make_float2(cosf(a), sinf(a)); }
}

__device__ void ph_h(const Params& p) {
    const int tid = otid(), wave = tid >> 6, lane = tid & 63;
    const int stride = gridDim.x * 8;
    for (int row0 = blockIdx.x * 8 + wave; row0 < MROWS; row0 += 2 * stride) {
        float4 xv[2][4]; int vv[2]; bool ok[2];
#pragma unroll
        for (int u = 0; u < 2; ++u) {
            const int row = row0 + u * stride; ok[u] = row < MROWS;
            const int rr = ok[u] ? row : row0;
            const float* src; if (rr < 32768) { src = p.x + (size_t)rr * 1024; vv[u] = rr >> 12; } else { src = p.ctx + (size_t)(rr - 32768) * 1024; vv[u] = 8; }
#pragma unroll
            for (int i = 0; i < 4; ++i) xv[u][i] = *(const float4*)(src + i * 256 + lane * 4);
        }
#pragma unroll
        for (int u = 0; u < 2; ++u) {
            if (!ok[u]) continue;
            const int row = row0 + u * stride;
            float ss = 0.f;
#pragma unroll
            for (int i = 0; i < 4; ++i) ss += xv[u][i].x * xv[u][i].x + xv[u][i].y * xv[u][i].y + xv[u][i].z * xv[u][i].z + xv[u][i].w * xv[u][i].w;
            ss = wave_sum(ss);
            const float rstd = rsqrtf(ss * (1.f / 1024.f) + 1e-6f);
            const float* sh = p.mod + vv[u] * 3072; const float* sc = sh + 1024;
#pragma unroll
            for (int i = 0; i < 4; ++i) {
                const int col = i * 256 + lane * 4;
                const float4 s4 = *(const float4*)(sc + col), h4 = *(const float4*)(sh + col);
                uint2 o;
                o.x = pack2(xv[u][i].x * rstd * (1.f + s4.x) + h4.x, xv[u][i].y * rstd * (1.f + s4.y) + h4.y);
                o.y = pack2(xv[u][i].z * rstd * (1.f + s4.z) + h4.z, xv[u][i].w * rstd * (1.f + s4.w) + h4.w);
                *(uint2*)(p.h + (size_t)row * 1024 + col) = o;
            }
        }
    }
}

template <int MODE> __device__ void ph_gemm_naive(const Params& p, float* lds) {
    const bf16_t* A = MODE == 0 ? p.h : p.mixed;
    const float* Bm = MODE == 0 ? p.w_in : p.w_out;
    constexpr int ldb = MODE == 0 ? 3328 : 1024;
    constexpr int nrt = (MODE == 0 ? MROWS : 32768) / 64, nct = ldb / 128;
    float* As = lds;
    float* Bs = lds + 32 * 65;
    const int tid = threadIdx.x, ty = tid >> 4, tx = tid & 15;
    for (int tile = blockIdx.x; tile < nrt * nct; tile += gridDim.x) {
        const int rt = tile / nct, ct = tile % nct;
        float acc[2][8];
#pragma unroll
        for (int r = 0; r < 2; ++r)
#pragma unroll
            for (int t = 0; t < 8; ++t) acc[r][t] = 0.f;
        int bc[8];
#pragma unroll
        for (int i = 0; i < 8; ++i) { const int cc = (tid + NT * i) & 127; const int sg = ct * 128 + cc; bc[i] = MODE == 0 ? ocol_in(sg) : sg; }
        for (int k0 = 0; k0 < 1024; k0 += 32) {
#pragma unroll
            for (int i = 0; i < 4; ++i) { const int e = tid + NT * i, r = e >> 5, kk = e & 31; As[kk * 65 + r] = bf2f(A[(size_t)(rt * 64 + r) * 1024 + k0 + kk]); }
#pragma unroll
            for (int i = 0; i < 8; ++i) { const int e = tid + NT * i, kk = e >> 7, cc = e & 127; Bs[kk * 129 + cc] = Bm[(size_t)(k0 + kk) * ldb + bc[i]]; }
            __syncthreads();
#pragma unroll 4
            for (int kk = 0; kk < 32; ++kk) {
                const float a0 = As[kk * 65 + ty * 2], a1 = As[kk * 65 + ty * 2 + 1];
#pragma unroll
                for (int t = 0; t < 8; ++t) { const float bv = Bs[kk * 129 + tx * 8 + t]; acc[0][t] += a0 * bv; acc[1][t] += a1 * bv; }
            }
            __syncthreads();
        }
#pragma unroll
        for (int r = 0; r < 2; ++r) {
            const int row = rt * 64 + ty * 2 + r, s0 = ct * 128 + tx * 8;
            if (MODE == 0) { }
            else {
                const int b = row >> 12;
                const float* gate = p.mod + b * 3072 + 2048 + s0;
                const float* xr = p.x + (size_t)row * 1024 + s0;
                float* orow = p.out + (size_t)row * 1024 + s0;
#pragma unroll
                for (int t = 0; t < 8; ++t) orow[t] = xr[t] + gate[t] * acc[r][t];
            }
        }
    }
}


__device__ void ph_wconv(const Params& p, float* lds) {
    const int tid = otid();
    for (int item = blockIdx.x; item < 544; item += gridDim.x) {
        const bool isin = item < 416; const int it = isin ? item : item - 416;
        const int win = it >> 4, kb = it & 15; const int ld = isin ? 3328 : 1024;
        const float* W = (isin ? p.w_in : p.w_out) + (size_t)(kb * 64) * ld + win * 128;
#pragma unroll
        for (int i = 0; i < 16; ++i) { const int e = tid + NT * i, k = e >> 7, c = e & 127; lds[k * 129 + c] = W[(size_t)k * ld + c]; }
        __syncthreads();
#pragma unroll
        for (int i = 0; i < 2; ++i) {
            const int e = tid + NT * i, pp = e >> 3, k8 = e & 7;
            const int pglob = win * 128 + pp;
            int col = pp;
            if (isin) {
                const int pos = pglob & 255;
                const int slot = (pos & ~31) | (((pos >> 2) & 3) << 3) | (((pos >> 4) & 1) << 2) | (pos & 3);
                col = ocol_in((pglob & ~255) + slot) - win * 128;
            }
            float o[8];
#pragma unroll
            for (int t = 0; t < 8; ++t) o[t] = lds[(k8 * 8 + t) * 129 + col];
            store8((isin ? p.WinT : p.WoutT) + (size_t)pglob * 1024 + kb * 64 + k8 * 8, o);
        }
        __syncthreads();
    }
}

namespace pg8 {
#define PG8_LAS __attribute__((address_space(3)))
typedef short bf16x8 __attribute__((ext_vector_type(8)));
typedef float f32x4 __attribute__((ext_vector_type(4)));
constexpr int BM = 256, BK = 64, HALF = 128, HTB = HALF * BK * 2, STAGE_BYTES = 8 * HTB, NXCD = 8, WGM = 8;
__device__ __forceinline__ int lds_byte(int r, int c) { const int st = (r >> 4) * 2 + (c >> 5), rr = r & 15, cc = c & 31, ob = rr * 64 + cc * 2; return st * 1024 + (ob ^ (((ob >> 9) & 1) << 5)); }
__device__ __forceinline__ void stage_rc(int b, int& R, int& C) { const int st = b / 1024, sb = b % 1024, swz = sb ^ (((sb >> 9) & 1) << 5); R = (st >> 1) * 16 + swz / 64; C = (st & 1) * 32 + (swz % 64) / 2; }
struct Unit { int pm, pn; };
struct Gemm { const bf16_t* A; const bf16_t* Bt; int K; };
__device__ __forceinline__ void static_unit(int wgid, int nM, int nN, Unit& u) {
    const int nwg = nM * nN;
    { const int q = nwg / NXCD, r = nwg % NXCD, xcd = wgid % NXCD, off = wgid / NXCD; wgid = (xcd < r ? xcd * (q + 1) : r * (q + 1) + (xcd - r) * q) + off; }
    const int nig = WGM * nN, gid = wgid / nig, fm = gid * WGM, gsz = (nM - fm) < WGM ? (nM - fm) : WGM;
    u.pm = fm + ((wgid % nig) % gsz); u.pn = (wgid % nig) / gsz;
}
struct SchedIn {
    int G, c;
    __device__ __forceinline__ bool next(int i, Unit& u) const {
        const int L = i * G + c;
        if (L < 1664) { static_unit(L, 128, 13, u); return true; }
        if (L < 1704) { const int q = L - 1664, r = q % 5; u.pm = 128 + q / 5; u.pn = r < 4 ? 2 + r : 10; return true; }
        return false;
    }
};
struct SchedOut {
    int G, c;
    __device__ __forceinline__ bool next(int i, Unit& u) const {
        const int L = i * G + c;
        if (L < 512) { static_unit(L, 128, 4, u); return true; }
        return false;
    }
};
struct EpiIn {
    const Params* p; ldstab_t t128, t64;
    template <int KIND, int BJ> __device__ __forceinline__ void half(const f32x4 (&acc)[2][2][4][2], const Unit& u, int wr, int wc, int fr, int fq) const {
        const int s0 = u.pn * BM + BJ * HALF + wc * 32 + fq * 8;
#pragma unroll
        for (int ai = 0; ai < 2; ++ai)
#pragma unroll
            for (int m = 0; m < 4; ++m) {
                const int row = u.pm * BM + ai * HALF + wr * 64 + m * 16 + fr;
                float v[8];
#pragma unroll
                for (int j = 0; j < 4; ++j) { v[j] = acc[ai][BJ][m][0][j]; v[4 + j] = acc[ai][BJ][m][1][j]; }
                epi_in8<KIND>(*p, t128, t64, row, s0, v);
            }
    }
    template <int K0, int K1> __device__ __forceinline__ void both(const f32x4 (&acc)[2][2][4][2], const Unit& u, int wr, int wc, int fr, int fq) const {
        half<K0, 0>(acc, u, wr, wc, fr, fq); half<K1, 1>(acc, u, wr, wc, fr, fq);
    }
    __device__ __forceinline__ void operator()(const f32x4 (&acc)[2][2][4][2], const Unit& u, int wr, int wc, int fr, int fq) const {
        switch (u.pn) {
            case 0: case 1: both<K_RQ, K_RQ>(acc, u, wr, wc, fr, fq); break;
            case 2: case 3: both<K_RK, K_RK>(acc, u, wr, wc, fr, fq); break;
            case 4: case 5: both<K_RV, K_RV>(acc, u, wr, wc, fr, fq); break;
            case 6: case 7: both<K_RG, K_RG>(acc, u, wr, wc, fr, fq); break;
            case 8: case 9: both<K_AQ, K_AQ>(acc, u, wr, wc, fr, fq); break;
            case 10: both<K_AK, K_AV>(acc, u, wr, wc, fr, fq); break;
            default: both<K_AG, K_AG>(acc, u, wr, wc, fr, fq); break;
        }
    }
};
struct EpiOut {
    const Params* p;
    __device__ __forceinline__ void operator()(const f32x4 (&acc)[2][2][4][2], const Unit& u, int wr, int wc, int fr, int fq) const {
        const int b = (u.pm * BM) >> 12;
        f32x4 gv[2][2];
#pragma unroll
        for (int bj = 0; bj < 2; ++bj)
#pragma unroll
            for (int n = 0; n < 2; ++n) gv[bj][n] = *(const f32x4*)(p->mod + b * 3072 + 2048 + u.pn * BM + bj * HALF + wc * 32 + n * 16 + fq * 4);
#pragma unroll
        for (int ai = 0; ai < 2; ++ai) {
            f32x4 xv[4][2][2];
#pragma unroll
            for (int m = 0; m < 4; ++m) {
                const size_t rowoff = (size_t)(u.pm * BM + ai * HALF + wr * 64 + m * 16 + fr) * 1024 + u.pn * BM + wc * 32 + fq * 4;
#pragma unroll
                for (int bj = 0; bj < 2; ++bj)
#pragma unroll
                    for (int n = 0; n < 2; ++n) xv[m][bj][n] = *(const f32x4*)(p->x + rowoff + bj * HALF + n * 16);
            }
#pragma unroll
            for (int m = 0; m < 4; ++m) {
                const size_t rowoff = (size_t)(u.pm * BM + ai * HALF + wr * 64 + m * 16 + fr) * 1024 + u.pn * BM + wc * 32 + fq * 4;
#pragma unroll
                for (int bj = 0; bj < 2; ++bj)
#pragma unroll
                    for (int n = 0; n < 2; ++n) *(f32x4*)(p->out + rowoff + bj * HALF + n * 16) = xv[m][bj][n] + gv[bj][n] * acc[ai][bj][m][n];
            }
        }
    }
};

template <class Epi, class Sched>
__device__ __forceinline__ void gemm_phase(PG8_LAS unsigned char* lds, const Gemm g, const Sched& S, const Epi& E) {
    const int tid = otid(), wid = __builtin_amdgcn_readfirstlane(tid >> 6), lane = tid & 63, wr = wid >> 2, wc = wid & 3, fr = lane & 15, fq = lane >> 4;
    const int K = g.K, nt = K / BK;
    unsigned voffA[2];
#pragma unroll
    for (int i = 0; i < 2; ++i) { int R, C; stage_rc(tid * 16 + i * 8192, R, C); voffA[i] = (unsigned)(R * K + C) * 2u; }
    const size_t kstep = (size_t)(BK * 2);
    const size_t hstep = (size_t)HALF * K * 2;
    const size_t tstep = 2 * hstep;
    const unsigned ldsw = (unsigned)wid * 1024u;
    const int aoff = lds_byte(wr * 64 + fr, fq * 8), boff = lds_byte(wc * 32 + fr, fq * 8);
#define PG8_SA(b, h) (((b) * 2 + (h)) * HTB)
#define PG8_SB(b, h) ((4 + (b) * 2 + (h)) * HTB)
#define PG8_STAGE(bufoff, gbase) do { _Pragma("unroll") for (int _i = 0; _i < 2; ++_i) \
        __builtin_amdgcn_global_load_lds((const unsigned*)((const char*)(gbase) + voffA[_i]), (PG8_LAS unsigned*)(lds + (bufoff) + ldsw + _i * 8192), 16, 0, 0); } while (0)
#define PG8_LDA(dst, b, h) do { _Pragma("unroll") for (int m = 0; m < 4; ++m) _Pragma("unroll") for (int k = 0; k < 2; ++k) dst[m][k] = *(const PG8_LAS bf16x8*)(lds + PG8_SA(b, h) + aoff + m * 2048 + k * 1024); } while (0)
#define PG8_LDB(dst, b, h) do { _Pragma("unroll") for (int n = 0; n < 2; ++n) _Pragma("unroll") for (int k = 0; k < 2; ++k) dst[n][k] = *(const PG8_LAS bf16x8*)(lds + PG8_SB(b, h) + boff + n * 2048 + k * 1024); } while (0)
#define PG8_MMA(ai, bj, At, Bt) do { __builtin_amdgcn_s_setprio(1); _Pragma("unroll") for (int m = 0; m < 4; ++m) _Pragma("unroll") for (int n = 0; n < 2; ++n) _Pragma("unroll") for (int k = 0; k < 2; ++k) \
        acc[ai][bj][m][n] = __builtin_amdgcn_mfma_f32_16x16x32_bf16(Bt[n][k], At[m][k], acc[ai][bj][m][n], 0, 0, 0); __builtin_amdgcn_s_setprio(0); } while (0)
#define PG8_WAIT_V(n) asm volatile("s_waitcnt vmcnt(" #n ")" ::: "memory")
#define PG8_WAIT_L(n) asm volatile("s_waitcnt lgkmcnt(" #n ")" ::: "memory")
#define PG8_BAR __builtin_amdgcn_s_barrier()
#define PG8_SCHED __builtin_amdgcn_sched_barrier(0)
    Unit cur, nxt; int ui = 0;
    if (!S.next(0, cur)) return;
    f32x4 acc[2][2][4][2];
#pragma unroll
    for (int a = 0; a < 2; ++a)
#pragma unroll
        for (int b = 0; b < 2; ++b)
#pragma unroll
            for (int m = 0; m < 4; ++m)
#pragma unroll
                for (int n = 0; n < 2; ++n) acc[a][b][m][n] = (f32x4){0.f, 0.f, 0.f, 0.f};
    bf16x8 At[4][2], B0[2][2], B1[2][2];
    const char* cA = (const char*)g.A + (size_t)cur.pm * tstep; const char* cB = (const char*)g.Bt + (size_t)cur.pn * tstep;
    PG8_STAGE(PG8_SB(0, 0), cB); PG8_STAGE(PG8_SA(0, 0), cA); PG8_STAGE(PG8_SB(0, 1), cB + hstep); PG8_STAGE(PG8_SA(0, 1), cA + hstep);
    if (wr == 1) PG8_BAR;
    PG8_WAIT_V(4); PG8_BAR;
    PG8_STAGE(PG8_SB(1, 0), cB + kstep); PG8_STAGE(PG8_SA(1, 0), cA + kstep); PG8_STAGE(PG8_SB(1, 1), cB + hstep + kstep);
    PG8_WAIT_V(6); PG8_BAR;
    for (;;) {
        const bool has_next = S.next(ui + 1, nxt);
        const char* nA = has_next ? (const char*)g.A + (size_t)nxt.pm * tstep : cA; const char* nB = has_next ? (const char*)g.Bt + (size_t)nxt.pn * tstep : cB;
        for (int t = 0; t < nt; t += 2) {
            const bool last = (t == nt - 2);
            const char* a1 = cA + (size_t)(t + 1) * kstep;
            const char* a2 = last ? nA : cA + (size_t)(t + 2) * kstep; const char* b2 = last ? nB : cB + (size_t)(t + 2) * kstep;
            const char* a3 = a2 + kstep; const char* b3 = b2 + kstep;
            PG8_LDB(B0, 0, 0); PG8_SCHED; PG8_LDA(At, 0, 0); PG8_STAGE(PG8_SA(1, 1), a1 + hstep);
            PG8_WAIT_L(8); PG8_BAR; PG8_WAIT_L(0); PG8_MMA(0, 0, At, B0); PG8_BAR; PG8_SCHED;
            PG8_LDB(B1, 0, 1); PG8_STAGE(PG8_SB(0, 0), b2);
            PG8_BAR; PG8_WAIT_L(0); PG8_MMA(0, 1, At, B1); PG8_BAR;
            PG8_LDA(At, 0, 1); PG8_STAGE(PG8_SA(0, 0), a2);
            PG8_BAR; PG8_WAIT_L(0); PG8_MMA(1, 0, At, B0); PG8_BAR; PG8_SCHED;
            PG8_STAGE(PG8_SB(0, 1), b2 + hstep);
            PG8_WAIT_V(6); PG8_BAR; PG8_MMA(1, 1, At, B1); PG8_BAR;
            PG8_LDB(B0, 1, 0); PG8_SCHED; PG8_LDA(At, 1, 0); PG8_STAGE(PG8_SA(0, 1), a2 + hstep);
            PG8_WAIT_L(8); PG8_BAR; PG8_WAIT_L(0); PG8_MMA(0, 0, At, B0); PG8_BAR; PG8_SCHED;
            PG8_LDB(B1, 1, 1); PG8_STAGE(PG8_SB(1, 0), b3);
            PG8_BAR; PG8_WAIT_L(0); PG8_MMA(0, 1, At, B1); PG8_BAR;
            PG8_LDA(At, 1, 1); PG8_STAGE(PG8_SA(1, 0), a3);
            PG8_BAR; PG8_WAIT_L(0); PG8_MMA(1, 0, At, B0); PG8_BAR; PG8_SCHED;
            PG8_STAGE(PG8_SB(1, 1), b3 + hstep);
            PG8_WAIT_V(6); PG8_BAR; PG8_MMA(1, 1, At, B1); PG8_BAR;
        }
        E(acc, cur, wr, wc, fr, fq);
        if (!has_next) break;
#pragma unroll
        for (int a = 0; a < 2; ++a)
#pragma unroll
            for (int b = 0; b < 2; ++b)
#pragma unroll
                for (int m = 0; m < 4; ++m)
#pragma unroll
                    for (int n = 0; n < 2; ++n) acc[a][b][m][n] = (f32x4){0.f, 0.f, 0.f, 0.f};
        cur = nxt; cA = nA; cB = nB; ++ui;
    }
    PG8_WAIT_V(0);
    if (wr == 0) PG8_BAR;
    PG8_BAR;
#undef PG8_SA
#undef PG8_SB
#undef PG8_STAGE
#undef PG8_LDA
#undef PG8_LDB
#undef PG8_MMA
#undef PG8_WAIT_V
#undef PG8_WAIT_L
#undef PG8_BAR
#undef PG8_SCHED
}
}

__device__ __forceinline__ void ph_gemm_in(const Params& p, float* lds) {
    {
        const int tid = otid();
        PG8_LAS pg8::f32x4* dt = (PG8_LAS pg8::f32x4*)((PG8_LAS unsigned char*)lds + LDS_TAB);
        const pg8::f32x4* s1 = (const pg8::f32x4*)p.tab128; const pg8::f32x4* s2 = (const pg8::f32x4*)p.tab64;
        dt[tid] = s1[tid]; dt[tid + NT] = s1[tid + NT]; dt[tid + 2 * NT] = s2[tid];
        __syncthreads();
    }
    ldstab_t t128 = (ldstab_t)((PG8_LAS unsigned char*)lds + LDS_TAB), t64 = t128 + 2048;
    pg8::Gemm g{p.h, p.WinT, 1024}; pg8::SchedIn S{(int)gridDim.x, (int)blockIdx.x}; pg8::EpiIn E{&p, t128, t64};
    pg8::gemm_phase(( PG8_LAS unsigned char*)lds, g, S, E);
}
__device__ __forceinline__ void ph_gemm_out(const Params& p, float* lds) {
    pg8::Gemm g{p.mixed, p.WoutT, 1024}; pg8::SchedOut S{(int)gridDim.x, (int)blockIdx.x}; pg8::EpiOut E{&p};
    pg8::gemm_phase((PG8_LAS unsigned char*)lds, g, S, E);
}


#define LAS __attribute__((address_space(3)))
typedef LAS unsigned char* ldsp;
typedef short bf16x8_t __attribute__((ext_vector_type(8)));
typedef float f32x4_t __attribute__((ext_vector_type(4)));
typedef unsigned u32x4_t __attribute__((ext_vector_type(4)));
typedef unsigned u32x2_t __attribute__((ext_vector_type(2)));
#define MFMA16(a, b, c) __builtin_amdgcn_mfma_f32_16x16x32_bf16(a, b, c, 0, 0, 0)
__device__ __forceinline__ int toff(int r, int c) { return r * 256 + ((((c >> 3) ^ (r & 15)) << 4) | ((c & 7) << 1)); }
__device__ __forceinline__ bf16x8_t ldfrag(ldsp tile, int r, int kk, int fq) { return *(const LAS bf16x8_t*)(tile + toff(r, 32 * kk + 8 * fq)); }
__device__ __forceinline__ void stage_tile(ldsp dst, const bf16_t* src, int tid) {
#pragma unroll
    for (int i = 0; i < 4; ++i) { const int idx = tid + NT * i, r = idx >> 4, c = idx & 15; const u32x4_t v = *(const u32x4_t*)(src + (size_t)idx * 8); *(LAS u32x4_t*)(dst + r * 256 + ((c ^ (r & 15)) << 4)) = v; }
}
__device__ __forceinline__ void stage_tileT(ldsp dst, const bf16_t* src, int tid) {
    const int jj = tid & 63, c0 = tid >> 6;
#pragma unroll
    for (int ps = 0; ps < 2; ++ps) {
        const int c = c0 + 8 * ps;
        const u32x4_t aw = *(const u32x4_t*)(src + (2 * jj) * 128 + c * 8), bw = *(const u32x4_t*)(src + (2 * jj + 1) * 128 + c * 8);
#pragma unroll
        for (int i = 0; i < 8; ++i) {
            const int e = 8 * c + i;
            const unsigned lo = (i & 1) ? (aw[i >> 1] >> 16) : (aw[i >> 1] & 0xffffu), hi = (i & 1) ? (bw[i >> 1] & 0xffff0000u) : (bw[i >> 1] << 16);
            *(LAS unsigned*)(dst + e * 256 + ((((jj >> 2) ^ (e & 15)) << 4) | ((jj & 3) << 2))) = lo | hi;
        }
    }
}

__device__ void ph_states(const Params& p, ldsp lds) {
    const int tid = otid(), w = tid >> 6, lane = tid & 63, fr = lane & 15, fq = lane >> 4;
    ldsp bKf = lds, bKb = lds + 32768, bV = lds + 65536;
    const int jj = tid & 63, c0 = tid >> 6;
    u32x4_t rk[2][2], rv[2][2];
    auto issue = [&](int item) {
        const int bh = item / 34, c = item % 34;
        const bf16_t* K = p.rk + ((size_t)bh * KVROWS + c * 128) * 128;
        const bf16_t* V = p.rv + ((size_t)bh * KVROWS + c * 128) * 128;
#pragma unroll
        for (int ps = 0; ps < 2; ++ps) {
            const int cc = c0 + 8 * ps;
            rk[ps][0] = *(const u32x4_t*)(K + (2 * jj) * 128 + cc * 8); rk[ps][1] = *(const u32x4_t*)(K + (2 * jj + 1) * 128 + cc * 8);
            rv[ps][0] = *(const u32x4_t*)(V + (2 * jj) * 128 + cc * 8); rv[ps][1] = *(const u32x4_t*)(V + (2 * jj + 1) * 128 + cc * 8);
        }
    };
    if ((int)blockIdx.x < 32 * 34) issue(blockIdx.x);
    for (int item = blockIdx.x; item < 32 * 34; item += gridDim.x) {
        const int bh = item / 34, h = bh & 3;
        const float lgf = lgam(p, 0, h), lgb = lgam(p, 1, h);
        {
            const float wf0 = __expf(lgf * (float)(127 - 2 * jj)), wf1 = __expf(lgf * (float)(126 - 2 * jj));
            const float wb0 = __expf(lgb * (float)(2 * jj)), wb1 = __expf(lgb * (float)(2 * jj + 1));
#pragma unroll
            for (int ps = 0; ps < 2; ++ps) {
                const int cc = c0 + 8 * ps;
#pragma unroll
                for (int i = 0; i < 8; ++i) {
                    const int e = 8 * cc + i, off = e * 256 + ((((jj >> 2) ^ (e & 15)) << 4) | ((jj & 3) << 2));
                    const unsigned ka = rk[ps][0][i >> 1], kb2 = rk[ps][1][i >> 1], va = rv[ps][0][i >> 1], vb2 = rv[ps][1][i >> 1];
                    const float a = (i & 1) ? __uint_as_float(ka & 0xffff0000u) : __uint_as_float(ka << 16);
                    const float b = (i & 1) ? __uint_as_float(kb2 & 0xffff0000u) : __uint_as_float(kb2 << 16);
                    *(LAS unsigned*)(bKf + off) = pack2(a * wf0, b * wf1);
                    *(LAS unsigned*)(bKb + off) = pack2(a * wb0, b * wb1);
                    *(LAS unsigned*)(bV + off) = (i & 1) ? ((va >> 16) | (vb2 & 0xffff0000u)) : ((va & 0xffffu) | (vb2 << 16));
                }
            }
        }
        if (item + (int)gridDim.x < 32 * 34) issue(item + gridDim.x);
        __syncthreads();
        f32x4_t af[8], ab[8];
#pragma unroll
        for (int i = 0; i < 8; ++i) { af[i] = (f32x4_t){0.f, 0.f, 0.f, 0.f}; ab[i] = (f32x4_t){0.f, 0.f, 0.f, 0.f}; }
#pragma unroll 1
        for (int kk = 0; kk < 4; ++kk) {
            const bf16x8_t xf = ldfrag(bKf, 16 * w + fr, kk, fq), xb = ldfrag(bKb, 16 * w + fr, kk, fq);
#pragma unroll
            for (int nt = 0; nt < 8; ++nt) { const bf16x8_t bv = ldfrag(bV, 16 * nt + fr, kk, fq); af[nt] = MFMA16(xf, bv, af[nt]); ab[nt] = MFMA16(xb, bv, ab[nt]); }
        }
#pragma unroll
        for (int nt = 0; nt < 8; ++nt) {
            const size_t o = ((size_t)item * 128 + 16 * nt + fr) * 128 + 16 * w + 4 * fq;
            uint2 u; u.x = pack2(af[nt][0], af[nt][1]); u.y = pack2(af[nt][2], af[nt][3]); *(uint2*)(p.Kf + o) = u;
            u.x = pack2(ab[nt][0], ab[nt][1]); u.y = pack2(ab[nt][2], ab[nt][3]); *(uint2*)(p.Kb + o) = u;
        }
        __syncthreads();
    }
}

__device__ void ph_retout(const Params& p, ldsp lds) {
    const int tid = otid(), w = tid >> 6, lane = tid & 63, fr = lane & 15, fq = lane >> 4;
    ldsp bQ = lds, bK = lds + 32768, bV = lds + 65536, bR = lds + 98304;
    for (int item = blockIdx.x; item < 1024; item += gridDim.x) {
        const int bh = item >> 5, n = item & 31, b = bh >> 2, h = bh & 3;
        const float lgf = lgam(p, 0, h), lgb = lgam(p, 1, h);
        const bf16_t* Q = p.rq + ((size_t)bh * 4096 + n * 128) * 128;
        const bf16_t* K = p.rk + ((size_t)bh * KVROWS + n * 128) * 128;
        const bf16_t* V = p.rv + ((size_t)bh * KVROWS + n * 128) * 128;
        const bf16_t* RF = p.Rf + (size_t)(bh * 32 + n) * 16384;
        const bf16_t* RB = p.Rb + (size_t)(bh * 32 + n) * 16384;
        stage_tile(bQ, Q, tid); stage_tile(bK, K, tid); stage_tileT(bV, V, tid); stage_tile(bR, RF, tid);
        __syncthreads();
        f32x4_t s[8];
#pragma unroll
        for (int i = 0; i < 8; ++i) s[i] = (f32x4_t){0.f, 0.f, 0.f, 0.f};
#pragma unroll 1
        for (int kk = 0; kk < 4; ++kk) {
            const bf16x8_t a = ldfrag(bK, 16 * w + fr, kk, fq);
#pragma unroll
            for (int nt = 0; nt < 8; ++nt) { const bf16x8_t bq = ldfrag(bQ, 16 * nt + fr, kk, fq); s[nt] = MFMA16(a, bq, s[nt]); }
        }
        u32x4_t rbreg[4];
#pragma unroll
        for (int i = 0; i < 4; ++i) rbreg[i] = *(const u32x4_t*)(RB + (size_t)(tid + NT * i) * 8);
        __syncthreads();
#pragma unroll
        for (int nt = 0; nt < 8; ++nt) {
            const int i = 16 * nt + fr; float o[4];
#pragma unroll
            for (int r = 0; r < 4; ++r) { const int dlt = i - (16 * w + 4 * fq + r); const float dec = dlt >= 0 ? __expf(lgf * (float)dlt) : __expf(lgb * (float)(-dlt)); o[r] = s[nt][r] * dec; }
            u32x2_t u; u.x = pack2(o[0], o[1]); u.y = pack2(o[2], o[3]);
            *(LAS u32x2_t*)(bK + toff(i, 16 * w + 4 * fq)) = u;
        }
        __syncthreads();
        f32x4_t y[8], ca[8];
#pragma unroll
        for (int i = 0; i < 8; ++i) { y[i] = (f32x4_t){0.f, 0.f, 0.f, 0.f}; ca[i] = (f32x4_t){0.f, 0.f, 0.f, 0.f}; }
#pragma unroll 1
        for (int kk = 0; kk < 4; ++kk) {
            const bf16x8_t bs = ldfrag(bK, 16 * w + fr, kk, fq), bq = ldfrag(bQ, 16 * w + fr, kk, fq);
#pragma unroll
            for (int mt = 0; mt < 8; ++mt) {
                y[mt] = MFMA16(ldfrag(bV, 16 * mt + fr, kk, fq), bs, y[mt]);
                ca[mt] = MFMA16(ldfrag(bR, 16 * mt + fr, kk, fq), bq, ca[mt]);
            }
        }
        const int ip = 16 * w + fr;
        {
            const float cfs = __expf(lgf * (float)(ip + 1));
#pragma unroll
            for (int mt = 0; mt < 8; ++mt) { y[mt] += cfs * ca[mt]; ca[mt] = (f32x4_t){0.f, 0.f, 0.f, 0.f}; }
        }
        __syncthreads();
#pragma unroll
        for (int i = 0; i < 4; ++i) { const int idx = tid + NT * i, r = idx >> 4, c = idx & 15; *(LAS u32x4_t*)(bV + r * 256 + ((c ^ (r & 15)) << 4)) = rbreg[i]; }
        __syncthreads();
#pragma unroll 1
        for (int kk = 0; kk < 4; ++kk) {
            const bf16x8_t bq = ldfrag(bQ, 16 * w + fr, kk, fq);
#pragma unroll
            for (int mt = 0; mt < 8; ++mt) ca[mt] = MFMA16(ldfrag(bV, 16 * mt + fr, kk, fq), bq, ca[mt]);
        }
        const float cbs = __expf(lgb * (float)(128 - ip));
        float sum = 0.f;
#pragma unroll
        for (int mt = 0; mt < 8; ++mt) { y[mt] += cbs * ca[mt]; sum += y[mt][0] + y[mt][1] + y[mt][2] + y[mt][3]; }
        sum += __shfl_xor(sum, 16); sum += __shfl_xor(sum, 32);
        const float mu = sum * (1.f / 128.f);
        float vs = 0.f;
#pragma unroll
        for (int mt = 0; mt < 8; ++mt)
#pragma unroll
            for (int r = 0; r < 4; ++r) { const float dl = y[mt][r] - mu; vs += dl * dl; }
        vs += __shfl_xor(vs, 16); vs += __shfl_xor(vs, 32);
        const float rs = rsqrtf(vs * (1.f / 128.f) + 1e-6f);
        const size_t row = (size_t)b * 4096 + n * 128 + ip;
#pragma unroll
        for (int mt = 0; mt < 8; ++mt) {
            const int col = h * 128 + 16 * mt + 4 * fq;
            const uint2 g = *(const uint2*)(p.rg + row * 512 + col);
            const float4 gw = *(const float4*)(p.gn_w + col);
            const float o0 = (y[mt][0] - mu) * rs * gw.x * __uint_as_float(g.x << 16), o1 = (y[mt][1] - mu) * rs * gw.y * __uint_as_float(g.x & 0xffff0000u);
            const float o2 = (y[mt][2] - mu) * rs * gw.z * __uint_as_float(g.y << 16), o3 = (y[mt][3] - mu) * rs * gw.w * __uint_as_float(g.y & 0xffff0000u);
            uint2 u; u.x = pack2(o0, o1); u.y = pack2(o2, o3);
            *(uint2*)(p.mixed + row * 1024 + col) = u;
        }
        __syncthreads();
    }
}


__device__ __forceinline__ int koff(int r, int c) { return r * 128 + ((((c >> 3) ^ ((r >> 1) & 7)) << 4) | ((c & 7) << 1)); }
__device__ void ph_attn(const Params& p, ldsp lds) {
    const int tid = otid(), w = tid >> 6, lane = tid & 63, fr = lane & 15, fq = lane >> 4;
    const int g = w >> 1, sub = w & 1;
    int cnt = 0;
    for (int item = blockIdx.x; item < 1024; item += gridDim.x) {
        const int half = item & 1, nb = (item >> 1) & 31, bk = item >> 6, qoff = 64 * half + 32 * sub, b = bk >> 1, kvh = bk & 1, qh = kvh * 4 + g;
        const bf16_t* Kg = p.ak + (size_t)bk * KVROWS * 64;
        const bf16_t* Vg = p.av + (size_t)bk * KVROWS * 64;
        bf16x8_t qf[2][2];
#pragma unroll
        for (int st = 0; st < 2; ++st)
#pragma unroll
            for (int kk = 0; kk < 2; ++kk) qf[st][kk] = *(const bf16x8_t*)(p.aq + ((size_t)(b * 8 + qh) * 4096 + nb * 128 + qoff + 16 * st + fr) * 64 + 32 * kk + 8 * fq);
        f32x4_t oacc[2][4], lacc[2]; float mrun[2];
        const float sink = p.sink[qh] * 1.4426950408889634f;
        const bf16x8_t ones = (bf16x8_t){0x3F80, 0x3F80, 0x3F80, 0x3F80, 0x3F80, 0x3F80, 0x3F80, 0x3F80};
#pragma unroll
        for (int st = 0; st < 2; ++st) {
            mrun[st] = sink; lacc[st] = (f32x4_t){1.f, 1.f, 1.f, 1.f};
#pragma unroll
            for (int mt = 0; mt < 4; ++mt) oacc[st][mt] = (f32x4_t){0.f, 0.f, 0.f, 0.f};
        }
        const int ntl = 5 - (nb == 0 ? 1 : 0) - (nb == 31 ? 1 : 0);
        const int jj = tid & 63, vc = tid >> 6;
        u32x4_t pk0, pk1, pv0, pv1;
        {
            const int rb0 = 0;
            pk0 = *(const u32x4_t*)(Kg + (size_t)rb0 * 64 + (size_t)tid * 8); pk1 = *(const u32x4_t*)(Kg + (size_t)rb0 * 64 + (size_t)(tid + NT) * 8);
            pv0 = *(const u32x4_t*)(Vg + (size_t)(rb0 + 2 * jj) * 64 + vc * 8); pv1 = *(const u32x4_t*)(Vg + (size_t)(rb0 + 2 * jj + 1) * 64 + vc * 8);
        }
#pragma unroll 1
        for (int k = 0; k < ntl; ++k) {
            const int ti = k + ((nb == 0 && k >= 2) ? 1 : 0);
            const int mode = ti == 2 ? 1 : (ti == 4 ? 2 : 0);
            ldsp kb = lds + (cnt & 1) * 32768, vb = kb + 16384; ++cnt;
            {
                const int r0 = tid >> 3, c0 = tid & 7, r1 = (tid + NT) >> 3;
                *(LAS u32x4_t*)(kb + r0 * 128 + ((c0 ^ ((r0 >> 1) & 7)) << 4)) = pk0;
                *(LAS u32x4_t*)(kb + r1 * 128 + ((c0 ^ ((r1 >> 1) & 7)) << 4)) = pk1;
#pragma unroll
                for (int i = 0; i < 8; ++i) {
                    const int e = 8 * vc + i;
                    const unsigned lo = (i & 1) ? (pv0[i >> 1] >> 16) : (pv0[i >> 1] & 0xffffu), hi = (i & 1) ? (pv1[i >> 1] & 0xffff0000u) : (pv1[i >> 1] << 16);
                    *(LAS unsigned*)(vb + e * 256 + ((((jj >> 2) ^ (e & 15)) << 4) | ((jj & 3) << 2))) = lo | hi;
                }
            }
            if (k + 1 < ntl) {
                const int tn = k + 1 + ((nb == 0 && k + 1 >= 2) ? 1 : 0);
                const int rbn = tn < 2 ? tn * 128 : 256 + (nb + tn - 3) * 128;
                pk0 = *(const u32x4_t*)(Kg + (size_t)rbn * 64 + (size_t)tid * 8); pk1 = *(const u32x4_t*)(Kg + (size_t)rbn * 64 + (size_t)(tid + NT) * 8);
                pv0 = *(const u32x4_t*)(Vg + (size_t)(rbn + 2 * jj) * 64 + vc * 8); pv1 = *(const u32x4_t*)(Vg + (size_t)(rbn + 2 * jj + 1) * 64 + vc * 8);
            }
            __syncthreads();
#pragma unroll
            for (int st = 0; st < 2; ++st) {
                const int q0s = qoff + 16 * st;
                constexpr int mlo = 0, mhi = 7;
                f32x4_t s[8];
#pragma unroll
                for (int mt = 0; mt < 8; ++mt) {
                    if (mt >= mlo && mt <= mhi) {
                        s[mt] = (f32x4_t){0.f, 0.f, 0.f, 0.f};
#pragma unroll
                        for (int kk = 0; kk < 2; ++kk) s[mt] = MFMA16(*(const LAS bf16x8_t*)(kb + koff(16 * mt + fr, 32 * kk + 8 * fq)), qf[st][kk], s[mt]);
                    } else s[mt] = (f32x4_t){-1e30f, -1e30f, -1e30f, -1e30f};
                }
                if (mode) {
                    const int qi = q0s + fr;
#pragma unroll
                    for (int mt = 0; mt < 8; ++mt)
#pragma unroll
                        for (int r = 0; r < 4; ++r) { const int kj = 16 * mt + 4 * fq + r; const bool ok = mode == 1 ? kj >= qi : kj <= qi; s[mt][r] = ok ? s[mt][r] : -1e30f; }
                }
                float mx = s[0][0];
#pragma unroll
                for (int mt = 0; mt < 8; ++mt)
#pragma unroll
                    for (int r = 0; r < 4; ++r) mx = fmaxf(mx, s[mt][r]);
                mx = fmaxf(mx, __shfl_xor(mx, 16)); mx = fmaxf(mx, __shfl_xor(mx, 32));
                const float mn = fmaxf(mrun[st], mx), sc = __builtin_amdgcn_exp2f(mrun[st] - mn);
                mrun[st] = mn;
#pragma unroll
                for (int mt = 0; mt < 8; ++mt) {
                    if (mt >= mlo && mt <= mhi) {
#pragma unroll
                        for (int r = 0; r < 4; ++r) s[mt][r] = __builtin_amdgcn_exp2f(s[mt][r] - mn);
                    } else s[mt] = (f32x4_t){0.f, 0.f, 0.f, 0.f};
                }
                lacc[st] *= sc;
#pragma unroll
                for (int mt = 0; mt < 4; ++mt) oacc[st][mt] *= sc;
#pragma unroll
                for (int kk = 0; kk < 4; ++kk) {
                    if (2 * kk + 1 >= mlo && 2 * kk <= mhi) {
                        u32x4_t pu; pu.x = pack2(s[2 * kk][0], s[2 * kk][1]); pu.y = pack2(s[2 * kk][2], s[2 * kk][3]); pu.z = pack2(s[2 * kk + 1][0], s[2 * kk + 1][1]); pu.w = pack2(s[2 * kk + 1][2], s[2 * kk + 1][3]);
                        const bf16x8_t pf = __builtin_bit_cast(bf16x8_t, pu);
                        lacc[st] = MFMA16(ones, pf, lacc[st]);
#pragma unroll
                        for (int mt = 0; mt < 4; ++mt) {
                            const u32x2_t lo = *(const LAS u32x2_t*)(vb + toff(16 * mt + fr, 32 * kk + 4 * fq)), hi = *(const LAS u32x2_t*)(vb + toff(16 * mt + fr, 32 * kk + 16 + 4 * fq));
                            u32x4_t au; au.x = lo.x; au.y = lo.y; au.z = hi.x; au.w = hi.y;
                            oacc[st][mt] = MFMA16(__builtin_bit_cast(bf16x8_t, au), pf, oacc[st][mt]);
                        }
                    }
                }
                __builtin_amdgcn_sched_barrier(0);
            }
        }
#pragma unroll
        for (int st = 0; st < 2; ++st) {
            const float inv = 1.f / lacc[st][0];
            const size_t row = (size_t)b * 4096 + nb * 128 + qoff + 16 * st + fr;
#pragma unroll
            for (int mt = 0; mt < 4; ++mt) {
                const int col = qh * 64 + 16 * mt + 4 * fq;
                const uint2 gt = *(const uint2*)(p.ag + row * 512 + col);
                const float o0 = oacc[st][mt][0] * inv * __uint_as_float(gt.x << 16), o1 = oacc[st][mt][1] * inv * __uint_as_float(gt.x & 0xffff0000u);
                const float o2 = oacc[st][mt][2] * inv * __uint_as_float(gt.y << 16), o3 = oacc[st][mt][3] * inv * __uint_as_float(gt.y & 0xffff0000u);
                uint2 u; u.x = pack2(o0, o1); u.y = pack2(o2, o3);
                *(uint2*)(p.mixed + row * 1024 + 512 + col) = u;
            }
        }
    }
    __syncthreads();
}

__device__ void ph_states_naive(const Params& p) {
    for (int item = blockIdx.x; item < 32 * 34; item += gridDim.x) {
        const int bh = item / 34, c = item % 34, h = bh & 3;
        const float lgf = lgam(p, 0, h), lgb = lgam(p, 1, h);
        const bf16_t* K = p.rk + ((size_t)bh * KVROWS + c * 128) * 128;
        const bf16_t* V = p.rv + ((size_t)bh * KVROWS + c * 128) * 128;
        const int e = threadIdx.x & 127, dg = threadIdx.x >> 7;
        float af[32], ab[32];
#pragma unroll
        for (int i = 0; i < 32; ++i) { af[i] = 0.f; ab[i] = 0.f; }
        for (int j = 0; j < 128; ++j) {
            const float vv = bf2f(V[j * 128 + e]);
            const float wf = expf(lgf * (float)(127 - j)) * vv, wb = expf(lgb * (float)j) * vv;
#pragma unroll
            for (int d8 = 0; d8 < 4; ++d8) {
                float kk[8]; load8(K + j * 128 + dg * 32 + d8 * 8, kk);
#pragma unroll
                for (int i = 0; i < 8; ++i) { af[d8 * 8 + i] += wf * kk[i]; ab[d8 * 8 + i] += wb * kk[i]; }
            }
        }
        bf16_t* of = p.Kf + ((size_t)item * 128 + e) * 128 + dg * 32;
        bf16_t* ob = p.Kb + ((size_t)item * 128 + e) * 128 + dg * 32;
#pragma unroll
        for (int d8 = 0; d8 < 4; ++d8) { store8(of + d8 * 8, af + d8 * 8); store8(ob + d8 * 8, ab + d8 * 8); }
    }
}

__device__ void ph_scan(const Params& p) {
    const int tid = otid();
    for (int blk = blockIdx.x; blk < 512; blk += gridDim.x) {
        const int dir = blk >> 8, bh = (blk >> 3) & 31, h = bh & 3;
        const unsigned el = (unsigned)((blk & 7) * NT + tid) * 4u;
        const float gC = expf(lgam(p, dir, h) * 128.f);
        const bf16_t* __restrict__ ks = (dir ? p.Kb : p.Kf) + (size_t)bh * 34 * 16384;
        bf16_t* __restrict__ rs = (dir ? p.Rb : p.Rf) + (size_t)bh * 32 * 16384;
        uint2 kv[34];
#pragma unroll
        for (int n = 0; n < 34; ++n) kv[n] = *(const uint2*)(ks + (size_t)n * 16384 + el);
        float R[4];
        auto cv = [](const uint2 u, float* o) { o[0] = __uint_as_float(u.x << 16); o[1] = __uint_as_float(u.x & 0xffff0000u); o[2] = __uint_as_float(u.y << 16); o[3] = __uint_as_float(u.y & 0xffff0000u); };
        float t[4];
        cv(dir ? kv[33] : kv[32], R); cv(dir ? kv[32] : kv[33], t);
#pragma unroll
        for (int i = 0; i < 4; ++i) R[i] = gC * R[i] + t[i];
#pragma unroll
        for (int s = 0; s < 32; ++s) {
            const int n = dir ? 31 - s : s;
            uint2 u; u.x = pack2(R[0], R[1]); u.y = pack2(R[2], R[3]);
            *(uint2*)(rs + (size_t)n * 16384 + el) = u;
            cv(dir ? kv[31 - s] : kv[s], t);
#pragma unroll
            for (int i = 0; i < 4; ++i) R[i] = gC * R[i] + t[i];
        }
    }
}

__device__ void ph_retout_naive(const Params& p, float* S) {
    for (int item = blockIdx.x; item < 1024; item += gridDim.x) {
        const int bh = item >> 5, n = item & 31, b = bh >> 2, h = bh & 3;
        const float lgf = lgam(p, 0, h), lgb = lgam(p, 1, h);
        const bf16_t* Q = p.rq + ((size_t)bh * 4096 + n * 128) * 128;
        const bf16_t* K = p.rk + ((size_t)bh * KVROWS + n * 128) * 128;
        const bf16_t* V = p.rv + ((size_t)bh * KVROWS + n * 128) * 128;
        const bf16_t* RF = p.Rf + (size_t)(bh * 32 + n) * 16384;
        const bf16_t* RB = p.Rb + (size_t)(bh * 32 + n) * 16384;
        const int i = threadIdx.x >> 2, q4 = threadIdx.x & 3;
        for (int jj = 0; jj < 32; ++jj) {
            const int j = q4 * 32 + jj;
            float dot = 0.f;
#pragma unroll 4
            for (int d8 = 0; d8 < 16; ++d8) {
                float a[8], bb[8]; load8(Q + i * 128 + d8 * 8, a); load8(K + j * 128 + d8 * 8, bb);
#pragma unroll
                for (int t = 0; t < 8; ++t) dot += a[t] * bb[t];
            }
            const float dec = j <= i ? expf(lgf * (float)(i - j)) : expf(lgb * (float)(j - i));
            S[i * 128 + ((j + i) & 127)] = dot * dec;
        }
        __syncthreads();
        float y[32];
#pragma unroll
        for (int t = 0; t < 32; ++t) y[t] = 0.f;
        const int e0 = q4 * 32;
        for (int j = 0; j < 128; ++j) {
            const float s = S[i * 128 + ((j + i) & 127)];
#pragma unroll
            for (int e8 = 0; e8 < 4; ++e8) {
                float vv[8]; load8(V + j * 128 + e0 + e8 * 8, vv);
#pragma unroll
                for (int t = 0; t < 8; ++t) y[e8 * 8 + t] += s * vv[t];
            }
        }
        const float cf = expf(lgf * (float)(i + 1)), cb = expf(lgb * (float)(128 - i));
#pragma unroll 1
        for (int d8 = 0; d8 < 16; ++d8) {
            float a[8]; load8(Q + i * 128 + d8 * 8, a);
#pragma unroll
            for (int ee = 0; ee < 32; ++ee) {
                float rf[8], rb[8]; load8(RF + (e0 + ee) * 128 + d8 * 8, rf); load8(RB + (e0 + ee) * 128 + d8 * 8, rb);
                float sf = 0.f, sb = 0.f;
#pragma unroll
                for (int t = 0; t < 8; ++t) { sf += a[t] * rf[t]; sb += a[t] * rb[t]; }
                y[ee] += cf * sf + cb * sb;
            }
        }
        float sum = 0.f;
#pragma unroll
        for (int t = 0; t < 32; ++t) sum += y[t];
        sum += __shfl_xor(sum, 1); sum += __shfl_xor(sum, 2);
        const float mu = sum * (1.f / 128.f);
        float vs = 0.f;
#pragma unroll
        for (int t = 0; t < 32; ++t) { const float dlt = y[t] - mu; vs += dlt * dlt; }
        vs += __shfl_xor(vs, 1); vs += __shfl_xor(vs, 2);
        const float rs = rsqrtf(vs * (1.f / 128.f) + 1e-6f);
        const size_t row = (size_t)b * 4096 + n * 128 + i;
        const int col0 = h * 128 + e0;
#pragma unroll
        for (int e8 = 0; e8 < 4; ++e8) {
            float g[8], o[8]; load8(p.rg + row * 512 + col0 + e8 * 8, g);
#pragma unroll
            for (int t = 0; t < 8; ++t) o[t] = (y[e8 * 8 + t] - mu) * rs * p.gn_w[col0 + e8 * 8 + t] * g[t];
            store8(p.mixed + row * 1024 + col0 + e8 * 8, o);
        }
        __syncthreads();
    }
}

__device__ void ph_attn_naive(const Params& p) {
    for (int idx = blockIdx.x * NT + otid(); idx < 8 * 8 * 4096; idx += gridDim.x * NT) {
        const int t = idx & 4095, bq = idx >> 12, qh = bq & 7, b = bq >> 3, kvh = qh >> 2;
        float q[64], acc[64];
#pragma unroll
        for (int d8 = 0; d8 < 8; ++d8) load8(p.aq + ((size_t)bq * 4096 + t) * 64 + d8 * 8, q + d8 * 8);
#pragma unroll
        for (int e = 0; e < 64; ++e) acc[e] = 0.f;
        const bf16_t* Kb = p.ak + (size_t)(b * 2 + kvh) * KVROWS * 64;
        const bf16_t* Vb = p.av + (size_t)(b * 2 + kvh) * KVROWS * 64;
        float m = p.sink[qh], l = 1.f;
        const int lo = t - 128 < 0 ? 0 : t - 128, hi = t + 128 > 4095 ? 4095 : t + 128;
        const int nkeys = 256 + (hi - lo + 1);
        for (int kk = 0; kk < nkeys; ++kk) {
            const int krow = kk < 256 ? kk : lo + kk;
            float s = 0.f;
#pragma unroll
            for (int d8 = 0; d8 < 8; ++d8) {
                float kv[8]; load8(Kb + (size_t)krow * 64 + d8 * 8, kv);
#pragma unroll
                for (int i = 0; i < 8; ++i) s += q[d8 * 8 + i] * kv[i];
            }
            if (s > m) {
                const float sc = __expf(m - s); l *= sc;
#pragma unroll
                for (int e = 0; e < 64; ++e) acc[e] *= sc;
                m = s;
            }
            const float pe = __expf(s - m); l += pe;
#pragma unroll
            for (int d8 = 0; d8 < 8; ++d8) {
                float vv[8]; load8(Vb + (size_t)krow * 64 + d8 * 8, vv);
#pragma unroll
                for (int i = 0; i < 8; ++i) acc[d8 * 8 + i] += pe * vv[i];
            }
        }
        const float inv = 1.f / l;
        const size_t row = (size_t)b * 4096 + t;
#pragma unroll
        for (int d8 = 0; d8 < 8; ++d8) {
            float g[8], o[8]; load8(p.ag + row * 512 + qh * 64 + d8 * 8, g);
#pragma unroll
            for (int i = 0; i < 8; ++i) o[i] = acc[d8 * 8 + i] * inv * g[i];
            store8(p.mixed + row * 1024 + 512 + qh * 64 + d8 * 8, o);
        }
    }
}

__device__ void ph_final(const Params& p) {
    const int tid = otid(), wave = tid >> 6, lane = tid & 63;
    const int stride = gridDim.x * 8;
    float4 w4[4];
#pragma unroll
    for (int i = 0; i < 4; ++i) w4[i] = *(const float4*)(p.fnw + i * 256 + lane * 4);
    for (int row0 = blockIdx.x * 8 + wave; row0 < 32768; row0 += 2 * stride) {
        float4 xv[2][4]; bool ok[2];
#pragma unroll
        for (int u = 0; u < 2; ++u) {
            const int row = row0 + u * stride; ok[u] = row < 32768;
            const float* src = p.out + (size_t)(ok[u] ? row : row0) * 1024;
#pragma unroll
            for (int i = 0; i < 4; ++i) xv[u][i] = *(const float4*)(src + i * 256 + lane * 4);
        }
#pragma unroll
        for (int u = 0; u < 2; ++u) {
            if (!ok[u]) continue;
            float* dst = p.out + (size_t)(row0 + u * stride) * 1024;
            float ss = 0.f;
#pragma unroll
            for (int i = 0; i < 4; ++i) ss += xv[u][i].x * xv[u][i].x + xv[u][i].y * xv[u][i].y + xv[u][i].z * xv[u][i].z + xv[u][i].w * xv[u][i].w;
            ss = wave_sum(ss);
            const float rstd = rsqrtf(ss * (1.f / 1024.f) + 1e-6f);
#pragma unroll
            for (int i = 0; i < 4; ++i) {
                float4 o; o.x = xv[u][i].x * rstd * w4[i].x; o.y = xv[u][i].y * rstd * w4[i].y; o.z = xv[u][i].z * rstd * w4[i].z; o.w = xv[u][i].w * rstd * w4[i].w;
                *(float4*)(dst + i * 256 + lane * 4) = o;
            }
        }
    }
}

#define NPHASE 9
template <int PH> __device__ __forceinline__ void run_phase(const Params& p, float* lds) {
    if (PH == 0) ph_mod(p, lds);
    else if (PH == 1) { ph_wconv(p, lds); ph_h(p); }
    else if (PH == 2) ph_gemm_in(p, lds);
    else if (PH == 3) { ph_states(p, (ldsp)lds); ph_attn(p, (ldsp)lds); }
    else if (PH == 4) ph_scan(p);
    else if (PH == 5) ph_retout(p, (ldsp)lds);
    else if (PH == 6) ph_gemm_out(p, lds);
    else if (PH == 7) ph_final(p);
}

template <int PH> __global__ __launch_bounds__(NT) void k_ph(Params p) {
    extern __shared__ __attribute__((aligned(16))) float lds[];
    run_phase<PH>(p, lds);
}


#define XB_TMO      128
#define XB_XCNT(j)  (256  + 64 * (j))
#define XB_XSUB(j)  (1280 + 64 * (j))
#define XB_XGEN(j)  (2304 + 64 * (j))
#define XB_TOP      3328
#define XB_TOPGEN   3392
#define XCD_BAR_WORDS 3456
#define XB_SPIN_CAP (1u << 18)
__device__ __forceinline__ unsigned xb_ld(unsigned* p)              { return __hip_atomic_load(p, __ATOMIC_RELAXED, __HIP_MEMORY_SCOPE_AGENT); }
__device__ __forceinline__ unsigned xb_add(unsigned* p, unsigned v) { return __hip_atomic_fetch_add(p, v, __ATOMIC_RELAXED, __HIP_MEMORY_SCOPE_AGENT); }
__device__ __forceinline__ unsigned xb_xcc_id() { return (unsigned)__builtin_amdgcn_s_getreg((3 << 11) | 20) & 0xFu; }
#define XB_SPIN(cond, bar) do { unsigned _sp = 0; while (cond) { __builtin_amdgcn_s_sleep(1); \
    if ((++_sp & 255u) == 0u) { if (xb_ld(&(bar)[XB_TMO])) break; if (_sp > XB_SPIN_CAP) { atomicAdd(&(bar)[XB_TMO], 1u); break; } } } } while (0)
struct XcdBarrier { unsigned* bar; unsigned x; volatile LAS unsigned* st; };
__device__ __forceinline__ XcdBarrier xcd_barrier_post(unsigned* bar, volatile LAS unsigned* st) {
    XcdBarrier b; b.bar = bar; b.x = xb_xcc_id(); b.st = st;
    if (threadIdx.x == 0) (void)xb_add(&bar[XB_XCNT(b.x)], 1u);
    return b;
}
__device__ __forceinline__ void xcd_barrier_complete(unsigned* bar, unsigned x, unsigned& nloc, unsigned& nx) {
    const unsigned G = gridDim.x * gridDim.y * gridDim.z;
    unsigned sum, cnt, mine, sp = 0u;
    for (;;) {
        sum = 0u; cnt = 0u; mine = 0u;
#pragma unroll
        for (unsigned j = 0; j < 16; ++j) { const unsigned c = xb_ld(&bar[XB_XCNT(j)]); sum += c; cnt += (c > 0u) ? 1u : 0u; mine = (j == x) ? c : mine; }
        if (sum == G) break;
        __builtin_amdgcn_s_sleep(1);
        if ((++sp & 255u) == 0u) { if (xb_ld(&bar[XB_TMO])) break; if (sp > XB_SPIN_CAP) { atomicAdd(&bar[XB_TMO], 1u); break; } }
    }
    nloc = mine > 0u ? mine : 1u; nx = cnt > 0u ? cnt : 1u;
}
__device__ __forceinline__ void xcd_barrier(const XcdBarrier& b) {
    asm volatile("s_waitcnt vmcnt(0)" ::: "memory");
    __syncthreads();
    if (threadIdx.x == 0) {
        unsigned* bar = b.bar;
        __builtin_amdgcn_s_waitcnt(0);
        unsigned nloc = b.st[0], nx = b.st[1];
        if (nloc == 0u) { xcd_barrier_complete(bar, b.x, nloc, nx); b.st[0] = nloc; b.st[1] = nx; }
        const unsigned old = xb_add(&bar[XB_XSUB(b.x)], 1u);
        const unsigned gen = old / nloc;
        if (old + 1u == (gen + 1u) * nloc) {
            __builtin_amdgcn_fence(__ATOMIC_RELEASE, "agent");
            asm volatile("s_waitcnt vmcnt(0)" ::: "memory");
            const unsigned og = xb_add(&bar[XB_TOP], 1u);
            const unsigned tg = og / nx;
            if (og + 1u == (tg + 1u) * nx) xb_add(&bar[XB_TOPGEN], 1u);
            else XB_SPIN(xb_ld(&bar[XB_TOPGEN]) == tg, bar);
            __builtin_amdgcn_fence(__ATOMIC_ACQUIRE, "agent");
            xb_add(&bar[XB_XGEN(b.x)], 1u);
            asm volatile("s_waitcnt vmcnt(0)" ::: "memory");
        } else {
            XB_SPIN(xb_ld(&bar[XB_XGEN(b.x)]) == gen, bar);
            __builtin_amdgcn_fence(__ATOMIC_ACQUIRE, "agent");
            asm volatile("s_waitcnt vmcnt(0)" ::: "memory");
        }
    }
    __syncthreads();
}

#ifndef REPMASK
#define REPMASK 0
#endif
#define RUNPH(i) do { run_phase<i>(p, lds); if ((REPMASK >> i) & 1) { __syncthreads(); run_phase<i>(p, lds); } } while (0)
#define GSYNC() do { xcd_barrier(xb); if ((REPMASK >> 8) & 1) xcd_barrier(xb); } while (0)
__global__ __launch_bounds__(NT) void k_mega(Params p) {
    extern __shared__ __attribute__((aligned(16))) float lds[];
    cg::grid_group grid = cg::this_grid();
    if (p.out == nullptr) grid.sync();
    volatile LAS unsigned* xst = (volatile LAS unsigned*)((ldsp)lds + LDS_GEMM);
    if (threadIdx.x < 4) xst[threadIdx.x] = 0u;
    __syncthreads();
    const XcdBarrier xb = xcd_barrier_post(p.bar, xst);
    RUNPH(0); GSYNC();
    RUNPH(1); GSYNC();
    RUNPH(2); GSYNC();
    RUNPH(3); GSYNC();
    RUNPH(4); GSYNC();
    RUNPH(5); GSYNC();
    RUNPH(6); GSYNC();
    run_phase<7>(p, lds);
}

template <int PH> static void launch_ph(const Params& p, int grid, hipStream_t stream) {
    static bool attr = false;
    if (!attr) { (void)hipFuncSetAttribute((const void*)k_ph<PH>, hipFuncAttributeMaxDynamicSharedMemorySize, LDS_BYTES); attr = true; }
    hipLaunchKernelGGL(k_ph<PH>, dim3(grid), dim3(NT), LDS_BYTES, stream, p);
}

extern "C" void kernel_launch(void* const* d_in, const int* in_sizes, int n_in, void* d_out, int out_size, void* d_ws, size_t ws_size, hipStream_t stream) {
    Params p{};
    p.x = (const float*)d_in[0]; p.c = (const float*)d_in[1]; p.ctx = (const float*)d_in[2]; p.c_ctx = (const float*)d_in[3];
    p.w_ada = (const float*)d_in[4]; p.b_ada = (const float*)d_in[5]; p.w_in = (const float*)d_in[6]; p.decay = (const float*)d_in[7];
    p.gn_w = (const float*)d_in[8]; p.sink = (const float*)d_in[9]; p.w_out = (const float*)d_in[10]; p.fnw = (const float*)d_in[11];
    p.out = (float*)d_out;
    unsigned char* w = (unsigned char*)d_ws; size_t off = 0;
    auto take = [&](size_t bytes) { unsigned char* r = w + off; off += (bytes + 255) & ~(size_t)255; return r; };
    p.mod = (float*)take(9 * 3072 * 4);
    p.tab128 = (float2*)take(64 * 32 * 8);
    p.tab64 = (float2*)take(64 * 16 * 8);
    p.h = (bf16_t*)take((size_t)MROWS * 1024 * 2);
    p.mixed = p.h;
    p.rq = (bf16_t*)take((size_t)32 * 4096 * 128 * 2);
    p.rk = (bf16_t*)take((size_t)32 * KVROWS * 128 * 2);
    p.rv = (bf16_t*)take((size_t)32 * KVROWS * 128 * 2);
    p.rg = (bf16_t*)take((size_t)32768 * 512 * 2);
    p.aq = (bf16_t*)take((size_t)64 * 4096 * 64 * 2);
    p.ak = (bf16_t*)take((size_t)16 * KVROWS * 64 * 2);
    p.av = (bf16_t*)take((size_t)16 * KVROWS * 64 * 2);
    p.ag = (bf16_t*)take((size_t)32768 * 512 * 2);
    p.Kf = (bf16_t*)take((size_t)32 * 34 * 16384 * 2);
    p.Kb = (bf16_t*)take((size_t)32 * 34 * 16384 * 2);
    p.Rf = (bf16_t*)take((size_t)32 * 32 * 16384 * 2);
    p.Rb = (bf16_t*)take((size_t)32 * 32 * 16384 * 2);
    p.WinT = (bf16_t*)take((size_t)3328 * 1024 * 2);
    p.WoutT = (bf16_t*)take((size_t)1024 * 1024 * 2);
    p.bar = (unsigned*)take(XCD_BAR_WORDS * 4);
    if (off > ws_size) { fprintf(stderr, "kernel_launch: workspace too small (%zu > %zu)\n", off, ws_size); return; }
#if MK_ONE_LAUNCH
    static int grid_blocks = 0;
    if (!grid_blocks) {
        int dev = 0, cus = 0, per_cu = 0;
        (void)hipGetDevice(&dev);
        (void)hipDeviceGetAttribute(&cus, hipDeviceAttributeMultiprocessorCount, dev);
        (void)hipFuncSetAttribute((const void*)k_mega, hipFuncAttributeMaxDynamicSharedMemorySize, LDS_BYTES);
        (void)hipOccupancyMaxActiveBlocksPerMultiprocessor(&per_cu, (const void*)k_mega, NT, LDS_BYTES);
        if (per_cu < 1) per_cu = 1;
        grid_blocks = cus * per_cu;
    }
    (void)hipMemsetAsync(p.bar, 0, XCD_BAR_WORDS * 4, stream);
    void* args[] = {&p};
    hipError_t e = hipLaunchCooperativeKernel((const void*)k_mega, dim3(grid_blocks), dim3(NT), args, LDS_BYTES, stream);
    if (e != hipSuccess) fprintf(stderr, "cooperative launch failed: %s (grid %d)\n", hipGetErrorString(e), grid_blocks);
#else
    const int G = 1024;
    launch_ph<0>(p, G, stream); launch_ph<1>(p, G, stream); launch_ph<2>(p, G, stream); launch_ph<3>(p, G, stream);
    launch_ph<4>(p, G, stream); launch_ph<5>(p, G, stream); launch_ph<6>(p, G, stream); launch_ph<7>(p, G, stream);
#endif
}
```

```cpp
#include <hip/hip_runtime.h>
#include <hip/hip_cooperative_groups.h>
#include <cstdio>
namespace cg = cooperative_groups;

#ifndef MK_ONE_LAUNCH
#define MK_ONE_LAUNCH 1
#endif

typedef unsigned short bf16_t;
#define NT 512
#define MROWS 34816
#define KVROWS 4352
#define LDS_GEMM 131072
#define LDS_TAB (LDS_GEMM + 64)
#define LDS_BYTES (LDS_TAB + 24576)

struct Params {
    const float *x, *c, *ctx, *c_ctx, *w_ada, *b_ada, *w_in, *decay, *gn_w, *sink, *w_out, *fnw;
    float* out;
    float* mod;
    float2* tab128;
    float2* tab64;
    bf16_t *h, *rq, *rk, *rv, *rg, *aq, *ak, *av, *ag, *Kf, *Kb, *Rf, *Rb, *mixed, *WinT, *WoutT;
    unsigned* bar;
};

__device__ __forceinline__ int otid() { int t = threadIdx.x; asm volatile("" : "+v"(t)); return t; }
__device__ __forceinline__ float bf2f(bf16_t b) { return __uint_as_float(((unsigned)b) << 16); }
__device__ __forceinline__ bf16_t f2bf(float f) { unsigned u = __float_as_uint(f); u += 0x7FFFu + ((u >> 16) & 1u); return (bf16_t)(u >> 16); }
typedef __bf16 bf2_t __attribute__((ext_vector_type(2)));
typedef float fl2_t __attribute__((ext_vector_type(2)));
__device__ __forceinline__ unsigned pack2(float lo, float hi) { fl2_t v = {lo, hi}; bf2_t b = __builtin_convertvector(v, bf2_t); return *(unsigned*)&b; }
__device__ __forceinline__ void store8(bf16_t* dst, const float* o) {
    uint4 u; u.x = pack2(o[0], o[1]); u.y = pack2(o[2], o[3]); u.z = pack2(o[4], o[5]); u.w = pack2(o[6], o[7]);
    *(uint4*)dst = u;
}
__device__ __forceinline__ void load8(const bf16_t* src, float* o) {
    const uint4 u = *(const uint4*)src;
    o[0] = __uint_as_float(u.x << 16); o[1] = __uint_as_float(u.x & 0xffff0000u);
    o[2] = __uint_as_float(u.y << 16); o[3] = __uint_as_float(u.y & 0xffff0000u);
    o[4] = __uint_as_float(u.z << 16); o[5] = __uint_as_float(u.z & 0xffff0000u);
    o[6] = __uint_as_float(u.w << 16); o[7] = __uint_as_float(u.w & 0xffff0000u);
}
__device__ __forceinline__ float silu_f(float v) { return v * __builtin_amdgcn_rcpf(1.f + __expf(-v)); }
__device__ __forceinline__ float wave_sum(float v) {
#pragma unroll
    for (int o = 32; o >= 1; o >>= 1) v += __shfl_xor(v, o);
    return v;
}
__device__ __forceinline__ float lgam(const Params& p, int dir, int h) { return -log1pf(expf(-p.decay[dir * 4 + h])); }

__device__ __forceinline__ int ocol_in(int sg) {
    if (sg < 1024) { const int s = sg & 127; return (sg & ~127) + ((s >> 5) << 4) + (((s >> 3) & 3) << 2) + (s & 3) + (((s >> 2) & 1) << 6); }
    if (sg >= 2048 && sg < 2688) { const int s = sg & 63; return (sg & ~63) + ((s >> 5) << 4) + (((s >> 3) & 3) << 2) + (s & 3) + (((s >> 2) & 1) << 5); }
    return sg;
}

typedef __attribute__((address_space(3))) const fl2_t* ldstab_t;
enum { K_RQ = 0, K_RK, K_RV, K_RG, K_AQ, K_AK, K_AV, K_AG };
template <int KIND> __device__ __forceinline__ void epi_in8(const Params& p, ldstab_t t128, ldstab_t t64, int row, int s0, const float* v) {
    const bool isc = row >= 32768;
    int b, t;
    if (isc) { const int r = row - 32768; b = r >> 8; t = r & 255; } else { b = row >> 12; t = row & 4095; }
    const int gr = (t >> 6) & 63, gc = t & 63;
    float o[8];
    if (KIND == K_RQ || KIND == K_RK) {
        const bool isk = KIND == K_RK;
        if (!isk && isc) return;
        const int head = (s0 >> 7) & 3, s = s0 & 127, wc = s >> 5, fq = (s >> 3) & 3;
        const float scl = isk ? 0.08838834764831845f : 1.f;
        if (isc) {
#pragma unroll
            for (int i = 0; i < 8; ++i) o[i] = v[i] * scl;
        } else {
            const int pos = wc < 2 ? gr : gc;
            ldstab_t tb = t128 + pos * 32 + (wc & 1) * 16 + fq * 4;
#pragma unroll
            for (int j = 0; j < 4; ++j) { const fl2_t cs = tb[j]; const float x1 = v[j] * scl, x2 = v[4 + j] * scl; o[j] = x1 * cs.x - x2 * cs.y; o[4 + j] = x1 * cs.y + x2 * cs.x; }
        }
        bf16_t* dst = isk ? p.rk + ((size_t)(b * 4 + head) * KVROWS + (isc ? 4096 + t : t)) * 128 + s
                          : p.rq + ((size_t)(b * 4 + head) * 4096 + t) * 128 + s;
        store8(dst, o);
    } else if (KIND == K_RV) {
        const int head = (s0 - 1024) >> 7, s = s0 & 127;
        store8(p.rv + ((size_t)(b * 4 + head) * KVROWS + (isc ? 4096 + t : t)) * 128 + s, v);
    } else if (KIND == K_RG) {
        if (isc) return;
#pragma unroll
        for (int i = 0; i < 8; ++i) o[i] = silu_f(v[i]);
        store8(p.rg + (size_t)row * 512 + (s0 - 1536), o);
    } else if (KIND == K_AQ || KIND == K_AK) {
        const bool isk = KIND == K_AK;
        if (!isk && isc) return;
        const int head = isk ? (s0 - 2560) >> 6 : (s0 - 2048) >> 6, s = s0 & 63, w = s >> 5, fq = (s >> 3) & 3;
        const float scl = isk ? 1.f : 0.125f * 1.4426950408889634f;
        if (isc) {
#pragma unroll
            for (int i = 0; i < 8; ++i) o[i] = v[i];
        } else {
            const int pos = w == 0 ? gr : gc;
            ldstab_t tb = t64 + pos * 16 + fq * 4;
#pragma unroll
            for (int j = 0; j < 4; ++j) { const fl2_t cs = tb[j]; const float x1 = v[j] * scl, x2 = v[4 + j] * scl; o[j] = x1 * cs.x - x2 * cs.y; o[4 + j] = x1 * cs.y + x2 * cs.x; }
        }
        bf16_t* dst = isk ? p.ak + ((size_t)(b * 2 + head) * KVROWS + (isc ? t : 256 + t)) * 64 + s
                          : p.aq + ((size_t)(b * 8 + head) * 4096 + t) * 64 + s;
        store8(dst, o);
    } else if (KIND == K_AV) {
        const int head = (s0 - 2688) >> 6, s = s0 & 63;
        store8(p.av + ((size_t)(b * 2 + head) * KVROWS + (isc ? t : 256 + t)) * 64 + s, v);
    } else {
        if (isc) return;
#pragma unroll
        for (int i = 0; i < 8; ++i) o[i] = silu_f(v[i]);
        store8(p.ag + (size_t)row * 512 + (s0 - 2816), o);
    }
}

__device__ void ph_mod(const Params& p, float* lds) {
    const int tid = otid();
    float* sc = lds;
    float* red = lds + 9216;
    if (blockIdx.x < 192) {
        for (int i = tid; i < 9 * 1024; i += NT) {
            const int v = i >> 10, k = i & 1023;
            const float cv = v < 8 ? p.c[v * 1024 + k] : p.c_ctx[k];
            sc[i] = cv / (1.f + expf(-cv));
        }
        __syncthreads();
        for (int item = blockIdx.x; item < 192; item += gridDim.x) {
            const int cl = tid & 15, kg = tid >> 4, col = item * 16 + cl;
            float acc[9];
#pragma unroll
            for (int v = 0; v < 9; ++v) acc[v] = 0.f;
#pragma unroll 4
            for (int kk = 0; kk < 32; ++kk) {
                const int k = kg * 32 + kk;
                const float w = p.w_ada[(size_t)k * 3072 + col];
#pragma unroll
                for (int v = 0; v < 9; ++v) acc[v] += sc[v * 1024 + k] * w;
            }
#pragma unroll
            for (int v = 0; v < 9; ++v) red[(kg * 9 + v) * 16 + cl] = acc[v];
            __syncthreads();
            if (tid < 144) {
                const int v = tid >> 4;
                float s = 0.f;
                for (int g2 = 0; g2 < 32; ++g2) s += red[(g2 * 9 + v) * 16 + cl];
                p.mod[v * 3072 + col] = s + p.b_ada[col];
            }
            __syncthreads();
        }
    }
    const int gt = blockIdx.x * NT + tid;
    if (gt < 2048) { const int pos = gt >> 5, f = gt & 31; const float a = (float)pos * powf(10000.f, -(float)f / 32.f); p.tab128[gt] = make_float2(cosf(a), sinf(a)); }
    else if (gt < 3072) { const int g2 = gt - 2048, pos = g2 >> 4, f = g2 & 15; const float a = (float)pos * powf(10000.f, -(float)f / 16.f); p.tab64[g2] = make_float2(cosf(a), sinf(a)); }
}

__device__ void ph_h(const Params& p) {
    const int tid = otid(), wave = tid >> 6, lane = tid & 63;
    const int stride = gridDim.x * 8;
    for (int row0 = blockIdx.x * 8 + wave; row0 < MROWS; row0 += 2 * stride) {
        float4 xv[2][4]; int vv[2]; bool ok[2];
#pragma unroll
        for (int u = 0; u < 2; ++u) {
            const int row = row0 + u * stride; ok[u] = row < MROWS;
            const int rr = ok[u] ? row : row0;
            const float* src; if (rr < 32768) { src = p.x + (size_t)rr * 1024; vv[u] = rr >> 12; } else { src = p.ctx + (size_t)(rr - 32768) * 1024; vv[u] = 8; }
#pragma unroll
            for (int i = 0; i < 4; ++i) xv[u][i] = *(const float4*)(src + i * 256 + lane * 4);
        }
#pragma unroll
        for (int u = 0; u < 2; ++u) {
            if (!ok[u]) continue;
            const int row = row0 + u * stride;
            float ss = 0.f;
#pragma unroll
            for (int i = 0; i < 4; ++i) ss += xv[u][i].x * xv[u][i].x + xv[u][i].y * xv[u][i].y + xv[u][i].z * xv[u][i].z + xv[u][i].w * xv[u][i].w;
            ss = wave_sum(ss);
            const float rstd = rsqrtf(ss * (1.f / 1024.f) + 1e-6f);
            const float* sh = p.mod + vv[u] * 3072; const float* sc = sh + 1024;
#pragma unroll
            for (int i = 0; i < 4; ++i) {
                const int col = i * 256 + lane * 4;
                const float4 s4 = *(const float4*)(sc + col), h4 = *(const float4*)(sh + col);
                uint2 o;
                o.x = pack2(xv[u][i].x * rstd * (1.f + s4.x) + h4.x, xv[u][i].y * rstd * (1.f + s4.y) + h4.y);
                o.y = pack2(xv[u][i].z * rstd * (1.f + s4.z) + h4.z, xv[u][i].w * rstd * (1.f + s4.w) + h4.w);
                *(uint2*)(p.h + (size_t)row * 1024 + col) = o;
            }
        }
    }
}

template <int MODE> __device__ void ph_gemm_naive(const Params& p, float* lds) {
    const bf16_t* A = MODE == 0 ? p.h : p.mixed;
    const float* Bm = MODE == 0 ? p.w_in : p.w_out;
    constexpr int ldb = MODE == 0 ? 3328 : 1024;
    constexpr int nrt = (MODE == 0 ? MROWS : 32768) / 64, nct = ldb / 128;
    float* As = lds;
    float* Bs = lds + 32 * 65;
    const int tid = threadIdx.x, ty = tid >> 4, tx = tid & 15;
    for (int tile = blockIdx.x; tile < nrt * nct; tile += gridDim.x) {
        const int rt = tile / nct, ct = tile % nct;
        float acc[2][8];
#pragma unroll
        for (int r = 0; r < 2; ++r)
#pragma unroll
            for (int t = 0; t < 8; ++t) acc[r][t] = 0.f;
        int bc[8];
#pragma unroll
        for (int i = 0; i < 8; ++i) { const int cc = (tid + NT * i) & 127; const int sg = ct * 128 + cc; bc[i] = MODE == 0 ? ocol_in(sg) : sg; }
        for (int k0 = 0; k0 < 1024; k0 += 32) {
#pragma unroll
            for (int i = 0; i < 4; ++i) { const int e = tid + NT * i, r = e >> 5, kk = e & 31; As[kk * 65 + r] = bf2f(A[(size_t)(rt * 64 + r) * 1024 + k0 + kk]); }
#pragma unroll
            for (int i = 0; i < 8; ++i) { const int e = tid + NT * i, kk = e >> 7, cc = e & 127; Bs[kk * 129 + cc] = Bm[(size_t)(k0 + kk) * ldb + bc[i]]; }
            __syncthreads();
#pragma unroll 4
            for (int kk = 0; kk < 32; ++kk) {
                const float a0 = As[kk * 65 + ty * 2], a1 = As[kk * 65 + ty * 2 + 1];
#pragma unroll
                for (int t = 0; t < 8; ++t) { const float bv = Bs[kk * 129 + tx * 8 + t]; acc[0][t] += a0 * bv; acc[1][t] += a1 * bv; }
            }
            __syncthreads();
        }
#pragma unroll
        for (int r = 0; r < 2; ++r) {
            const int row = rt * 64 + ty * 2 + r, s0 = ct * 128 + tx * 8;
            if (MODE == 0) { }
            else {
                const int b = row >> 12;
                const float* gate = p.mod + b * 3072 + 2048 + s0;
                const float* xr = p.x + (size_t)row * 1024 + s0;
                float* orow = p.out + (size_t)row * 1024 + s0;
#pragma unroll
                for (int t = 0; t < 8; ++t) orow[t] = xr[t] + gate[t] * acc[r][t];
            }
        }
    }
}


__device__ void ph_wconv(const Params& p, float* lds) {
    const int tid = otid();
    for (int item = blockIdx.x; item < 544; item += gridDim.x) {
        const bool isin = item < 416; const int it = isin ? item : item - 416;
        const int win = it >> 4, kb = it & 15; const int ld = isin ? 3328 : 1024;
        const float* W = (isin ? p.w_in : p.w_out) + (size_t)(kb * 64) * ld + win * 128;
#pragma unroll
        for (int i = 0; i < 16; ++i) { const int e = tid + NT * i, k = e >> 7, c = e & 127; lds[k * 129 + c] = W[(size_t)k * ld + c]; }
        __syncthreads();
#pragma unroll
        for (int i = 0; i < 2; ++i) {
            const int e = tid + NT * i, pp = e >> 3, k8 = e & 7;
            const int pglob = win * 128 + pp;
            int col = pp;
            if (isin) {
                const int pos = pglob & 255;
                const int slot = (pos & ~31) | (((pos >> 2) & 3) << 3) | (((pos >> 4) & 1) << 2) | (pos & 3);
                col = ocol_in((pglob & ~255) + slot) - win * 128;
            }
            float o[8];
#pragma unroll
            for (int t = 0; t < 8; ++t) o[t] = lds[(k8 * 8 + t) * 129 + col];
            store8((isin ? p.WinT : p.WoutT) + (size_t)pglob * 1024 + kb * 64 + k8 * 8, o);
        }
        __syncthreads();
    }
}

namespace pg8 {
#define PG8_LAS __attribute__((address_space(3)))
typedef short bf16x8 __attribute__((ext_vector_type(8)));
typedef float f32x4 __attribute__((ext_vector_type(4)));
constexpr int BM = 256, BK = 64, HALF = 128, HTB = HALF * BK * 2, STAGE_BYTES = 8 * HTB, NXCD = 8, WGM = 8;
__device__ __forceinline__ int lds_byte(int r, int c) { const int st = (r >> 4) * 2 + (c >> 5), rr = r & 15, cc = c & 31, ob = rr * 64 + cc * 2; return st * 1024 + (ob ^ (((ob >> 9) & 1) << 5)); }
__device__ __forceinline__ void stage_rc(int b, int& R, int& C) { const int st = b / 1024, sb = b % 1024, swz = sb ^ (((sb >> 9) & 1) << 5); R = (st >> 1) * 16 + swz / 64; C = (st & 1) * 32 + (swz % 64) / 2; }
struct Unit { int pm, pn; };
struct Gemm { const bf16_t* A; const bf16_t* Bt; int K; };
__device__ __forceinline__ void static_unit(int wgid, int nM, int nN, Unit& u) {
    const int nwg = nM * nN;
    { const int q = nwg / NXCD, r = nwg % NXCD, xcd = wgid % NXCD, off = wgid / NXCD; wgid = (xcd < r ? xcd * (q + 1) : r * (q + 1) + (xcd - r) * q) + off; }
    const int nig = WGM * nN, gid = wgid / nig, fm = gid * WGM, gsz = (nM - fm) < WGM ? (nM - fm) : WGM;
    u.pm = fm + ((wgid % nig) % gsz); u.pn = (wgid % nig) / gsz;
}
struct SchedIn {
    int G, c;
    __device__ __forceinline__ bool next(int i, Unit& u) const {
        const int L = i * G + c;
        if (L < 1664) { static_unit(L, 128, 13, u); return true; }
        if (L < 1704) { const int q = L - 1664, r = q % 5; u.pm = 128 + q / 5; u.pn = r < 4 ? 2 + r : 10; return true; }
        return false;
    }
};
struct SchedOut {
    int G, c;
    __device__ __forceinline__ bool next(int i, Unit& u) const {
        const int L = i * G + c;
        if (L < 512) { static_unit(L, 128, 4, u); return true; }
        return false;
    }
};
struct EpiIn {
    const Params* p; ldstab_t t128, t64;
    template <int KIND, int BJ> __device__ __forceinline__ void half(const f32x4 (&acc)[2][2][4][2], const Unit& u, int wr, int wc, int fr, int fq) const {
        const int s0 = u.pn * BM + BJ * HALF + wc * 32 + fq * 8;
#pragma unroll
        for (int ai = 0; ai < 2; ++ai)
#pragma unroll
            for (int m = 0; m < 4; ++m) {
                const int row = u.pm * BM + ai * HALF + wr * 64 + m * 16 + fr;
                float v[8];
#pragma unroll
                for (int j = 0; j < 4; ++j) { v[j] = acc[ai][BJ][m][0][j]; v[4 + j] = acc[ai][BJ][m][1][j]; }
                epi_in8<KIND>(*p, t128, t64, row, s0, v);
            }
    }
    template <int K0, int K1> __device__ __forceinline__ void both(const f32x4 (&acc)[2][2][4][2], const Unit& u, int wr, int wc, int fr, int fq) const {
        half<K0, 0>(acc, u, wr, wc, fr, fq); half<K1, 1>(acc, u, wr, wc, fr, fq);
    }
    __device__ __forceinline__ void operator()(const f32x4 (&acc)[2][2][4][2], const Unit& u, int wr, int wc, int fr, int fq) const {
        switch (u.pn) {
            case 0: case 1: both<K_RQ, K_RQ>(acc, u, wr, wc, fr, fq); break;
            case 2: case 3: both<K_RK, K_RK>(acc, u, wr, wc, fr, fq); break;
            case 4: case 5: both<K_RV, K_RV>(acc, u, wr, wc, fr, fq); break;
            case 6: case 7: both<K_RG, K_RG>(acc, u, wr, wc, fr, fq); break;
            case 8: case 9: both<K_AQ, K_AQ>(acc, u, wr, wc, fr, fq); break;
            case 10: both<K_AK, K_AV>(acc, u, wr, wc, fr, fq); break;
            default: both<K_AG, K_AG>(acc, u, wr, wc, fr, fq); break;
        }
    }
};
struct EpiOut {
    const Params* p;
    __device__ __forceinline__ void operator()(const f32x4 (&acc)[2][2][4][2], const Unit& u, int wr, int wc, int fr, int fq) const {
        const int b = (u.pm * BM) >> 12;
        f32x4 gv[2][2];
#pragma unroll
        for (int bj = 0; bj < 2; ++bj)
#pragma unroll
            for (int n = 0; n < 2; ++n) gv[bj][n] = *(const f32x4*)(p->mod + b * 3072 + 2048 + u.pn * BM + bj * HALF + wc * 32 + n * 16 + fq * 4);
#pragma unroll
        for (int ai = 0; ai < 2; ++ai) {
            f32x4 xv[4][2][2];
#pragma unroll
            for (int m = 0; m < 4; ++m) {
                const size_t rowoff = (size_t)(u.pm * BM + ai * HALF + wr * 64 + m * 16 + fr) * 1024 + u.pn * BM + wc * 32 + fq * 4;
#pragma unroll
                for (int bj = 0; bj < 2; ++bj)
#pragma unroll
                    for (int n = 0; n < 2; ++n) xv[m][bj][n] = *(const f32x4*)(p->x + rowoff + bj * HALF + n * 16);
            }
#pragma unroll
            for (int m = 0; m < 4; ++m) {
                const size_t rowoff = (size_t)(u.pm * BM + ai * HALF + wr * 64 + m * 16 + fr) * 1024 + u.pn * BM + wc * 32 + fq * 4;
#pragma unroll
                for (int bj = 0; bj < 2; ++bj)
#pragma unroll
                    for (int n = 0; n < 2; ++n) *(f32x4*)(p->out + rowoff + bj * HALF + n * 16) = xv[m][bj][n] + gv[bj][n] * acc[ai][bj][m][n];
            }
        }
    }
};

template <class Epi, class Sched>
__device__ __forceinline__ void gemm_phase(PG8_LAS unsigned char* lds, const Gemm g, const Sched& S, const Epi& E) {
    const int tid = otid(), wid = __builtin_amdgcn_readfirstlane(tid >> 6), lane = tid & 63, wr = wid >> 2, wc = wid & 3, fr = lane & 15, fq = lane >> 4;
    const int K = g.K, nt = K / BK;
    unsigned voffA[2];
#pragma unroll
    for (int i = 0; i < 2; ++i) { int R, C; stage_rc(tid * 16 + i * 8192, R, C); voffA[i] = (unsigned)(R * K + C) * 2u; }
    const size_t kstep = (size_t)(BK * 2);
    const size_t hstep = (size_t)HALF * K * 2;
    const size_t tstep = 2 * hstep;
    const unsigned ldsw = (unsigned)wid * 1024u;
    const int aoff = lds_byte(wr * 64 + fr, fq * 8), boff = lds_byte(wc * 32 + fr, fq * 8);
#define PG8_SA(b, h) (((b) * 2 + (h)) * HTB)
#define PG8_SB(b, h) ((4 + (b) * 2 + (h)) * HTB)
#define PG8_STAGE(bufoff, gbase) do { _Pragma("unroll") for (int _i = 0; _i < 2; ++_i) \
        __builtin_amdgcn_global_load_lds((const unsigned*)((const char*)(gbase) + voffA[_i]), (PG8_LAS unsigned*)(lds + (bufoff) + ldsw + _i * 8192), 16, 0, 0); } while (0)
#define PG8_LDA(dst, b, h) do { _Pragma("unroll") for (int m = 0; m < 4; ++m) _Pragma("unroll") for (int k = 0; k < 2; ++k) dst[m][k] = *(const PG8_LAS bf16x8*)(lds + PG8_SA(b, h) + aoff + m * 2048 + k * 1024); } while (0)
#define PG8_LDB(dst, b, h) do { _Pragma("unroll") for (int n = 0; n < 2; ++n) _Pragma("unroll") for (int k = 0; k < 2; ++k) dst[n][k] = *(const PG8_LAS bf16x8*)(lds + PG8_SB(b, h) + boff + n * 2048 + k * 1024); } while (0)
#define PG8_MMA(ai, bj, At, Bt) do { __builtin_amdgcn_s_setprio(1); _Pragma("unroll") for (int m = 0; m < 4; ++m) _Pragma("unroll") for (int n = 0; n < 2; ++n) _Pragma("unroll") for (int k = 0; k < 2; ++k) \
        acc[ai][bj][m][n] = __builtin_amdgcn_mfma_f32_16x16x32_bf16(Bt[n][k], At[m][k], acc[ai][bj][m][n], 0, 0, 0); __builtin_amdgcn_s_setprio(0); } while (0)
#define PG8_WAIT_V(n) asm volatile("s_waitcnt vmcnt(" #n ")" ::: "memory")
#define PG8_WAIT_L(n) asm volatile("s_waitcnt lgkmcnt(" #n ")" ::: "memory")
#define PG8_BAR __builtin_amdgcn_s_barrier()
#define PG8_SCHED __builtin_amdgcn_sched_barrier(0)
    Unit cur, nxt; int ui = 0;
    if (!S.next(0, cur)) return;
    f32x4 acc[2][2][4][2];
#pragma unroll
    for (int a = 0; a < 2; ++a)
#pragma unroll
        for (int b = 0; b < 2; ++b)
#pragma unroll
            for (int m = 0; m < 4; ++m)
#pragma unroll
                for (int n = 0; n < 2; ++n) acc[a][b][m][n] = (f32x4){0.f, 0.f, 0.f, 0.f};
    bf16x8 At[4][2], B0[2][2], B1[2][2];
    const char* cA = (const char*)g.A + (size_t)cur.pm * tstep; const char* cB = (const char*)g.Bt + (size_t)cur.pn * tstep;
    PG8_STAGE(PG8_SB(0, 0), cB); PG8_STAGE(PG8_SA(0, 0), cA); PG8_STAGE(PG8_SB(0, 1), cB + hstep); PG8_STAGE(PG8_SA(0, 1), cA + hstep);
    if (wr == 1) PG8_BAR;
    PG8_WAIT_V(4); PG8_BAR;
    PG8_STAGE(PG8_SB(1, 0), cB + kstep); PG8_STAGE(PG8_SA(1, 0), cA + kstep); PG8_STAGE(PG8_SB(1, 1), cB + hstep + kstep);
    PG8_WAIT_V(6); PG8_BAR;
    for (;;) {
        const bool has_next = S.next(ui + 1, nxt);
        const char* nA = has_next ? (const char*)g.A + (size_t)nxt.pm * tstep : cA; const char* nB = has_next ? (const char*)g.Bt + (size_t)nxt.pn * tstep : cB;
        for (int t = 0; t < nt; t += 2) {
            const bool last = (t == nt - 2);
            const char* a1 = cA + (size_t)(t + 1) * kstep;
            const char* a2 = last ? nA : cA + (size_t)(t + 2) * kstep; const char* b2 = last ? nB : cB + (size_t)(t + 2) * kstep;
            const char* a3 = a2 + kstep; const char* b3 = b2 + kstep;
            PG8_LDB(B0, 0, 0); PG8_SCHED; PG8_LDA(At, 0, 0); PG8_STAGE(PG8_SA(1, 1), a1 + hstep);
            PG8_WAIT_L(8); PG8_BAR; PG8_WAIT_L(0); PG8_MMA(0, 0, At, B0); PG8_BAR; PG8_SCHED;
            PG8_LDB(B1, 0, 1); PG8_STAGE(PG8_SB(0, 0), b2);
            PG8_BAR; PG8_WAIT_L(0); PG8_MMA(0, 1, At, B1); PG8_BAR;
            PG8_LDA(At, 0, 1); PG8_STAGE(PG8_SA(0, 0), a2);
            PG8_BAR; PG8_WAIT_L(0); PG8_MMA(1, 0, At, B0); PG8_BAR; PG8_SCHED;
            PG8_STAGE(PG8_SB(0, 1), b2 + hstep);
            PG8_WAIT_V(6); PG8_BAR; PG8_MMA(1, 1, At, B1); PG8_BAR;
            PG8_LDB(B0, 1, 0); PG8_SCHED; PG8_LDA(At, 1, 0); PG8_STAGE(PG8_SA(0, 1), a2 + hstep);
            PG8_WAIT_L(8); PG8_BAR; PG8_WAIT_L(0); PG8_MMA(0, 0, At, B0); PG8_BAR; PG8_SCHED;
            PG8_LDB(B1, 1, 1); PG8_STAGE(PG8_SB(1, 0), b3);
            PG8_BAR; PG8_WAIT_L(0); PG8_MMA(0, 1, At, B1); PG8_BAR;
            PG8_LDA(At, 1, 1); PG8_STAGE(PG8_SA(1, 0), a3);
            PG8_BAR; PG8_WAIT_L(0); PG8_MMA(1, 0, At, B0); PG8_BAR; PG8_SCHED;
            PG8_STAGE(PG8_SB(1, 1), b3 + hstep);
            PG8_WAIT_V(6); PG8_BAR; PG8_MMA(1, 1, At, B1); PG8_BAR;
        }
        E(acc, cur, wr, wc, fr, fq);
        if (!has_next) break;
#pragma unroll
        for (int a = 0; a < 2; ++a)
#pragma unroll
            for (int b = 0; b < 2; ++b)
#pragma unroll
                for (int m = 0; m < 4; ++m)
#pragma unroll
                    for (int n = 0; n < 2; ++n) acc[a][b][m][n] = (f32x4){0.f, 0.f, 0.f, 0.f};
        cur = nxt; cA = nA; cB = nB; ++ui;
    }
    PG8_WAIT_V(0);
    if (wr == 0) PG8_BAR;
    PG8_BAR;
#undef PG8_SA
#undef PG8_SB
#undef PG8_STAGE
#undef PG8_LDA
#undef PG8_LDB
#undef PG8_MMA
#undef PG8_WAIT_V
#undef PG8_WAIT_L
#undef PG8_BAR
#undef PG8_SCHED
}
}

__device__ __forceinline__ void ph_gemm_in(const Params& p, float* lds) {
    {
        const int tid = otid();
        PG8_LAS pg8::f32x4* dt = (PG8_LAS pg8::f32x4*)((PG8_LAS unsigned char*)lds + LDS_TAB);
        const pg8::f32x4* s1 = (const pg8::f32x4*)p.tab128; const pg8::f32x4* s2 = (const pg8::f32x4*)p.tab64;
        dt[tid] = s1[tid]; dt[tid + NT] = s1[tid + NT]; dt[tid + 2 * NT] = s2[tid];
        __syncthreads();
    }
    ldstab_t t128 = (ldstab_t)((PG8_LAS unsigned char*)lds + LDS_TAB), t64 = t128 + 2048;
    pg8::Gemm g{p.h, p.WinT, 1024}; pg8::SchedIn S{(int)gridDim.x, (int)blockIdx.x}; pg8::EpiIn E{&p, t128, t64};
    pg8::gemm_phase(( PG8_LAS unsigned char*)lds, g, S, E);
}
__device__ __forceinline__ void ph_gemm_out(const Params& p, float* lds) {
    pg8::Gemm g{p.mixed, p.WoutT, 1024}; pg8::SchedOut S{(int)gridDim.x, (int)blockIdx.x}; pg8::EpiOut E{&p};
    pg8::gemm_phase((PG8_LAS unsigned char*)lds, g, S, E);
}


#define LAS __attribute__((address_space(3)))
typedef LAS unsigned char* ldsp;
typedef short bf16x8_t __attribute__((ext_vector_type(8)));
typedef float f32x4_t __attribute__((ext_vector_type(4)));
typedef unsigned u32x4_t __attribute__((ext_vector_type(4)));
typedef unsigned u32x2_t __attribute__((ext_vector_type(2)));
#define MFMA16(a, b, c) __builtin_amdgcn_mfma_f32_16x16x32_bf16(a, b, c, 0, 0, 0)
__device__ __forceinline__ int toff(int r, int c) { return r * 256 + ((((c >> 3) ^ (r & 15)) << 4) | ((c & 7) << 1)); }
__device__ __forceinline__ bf16x8_t ldfrag(ldsp tile, int r, int kk, int fq) { return *(const LAS bf16x8_t*)(tile + toff(r, 32 * kk + 8 * fq)); }
__device__ __forceinline__ void stage_tile(ldsp dst, const bf16_t* src, int tid) {
#pragma unroll
    for (int i = 0; i < 4; ++i) { const int idx = tid + NT * i, r = idx >> 4, c = idx & 15; const u32x4_t v = *(const u32x4_t*)(src + (size_t)idx * 8); *(LAS u32x4_t*)(dst + r * 256 + ((c ^ (r & 15)) << 4)) = v; }
}
__device__ __forceinline__ void stage_tileT(ldsp dst, const bf16_t* src, int tid) {
    const int jj = tid & 63, c0 = tid >> 6;
#pragma unroll
    for (int ps = 0; ps < 2; ++ps) {
        const int c = c0 + 8 * ps;
        const u32x4_t aw = *(const u32x4_t*)(src + (2 * jj) * 128 + c * 8), bw = *(const u32x4_t*)(src + (2 * jj + 1) * 128 + c * 8);
#pragma unroll
        for (int i = 0; i < 8; ++i) {
            const int e = 8 * c + i;
            const unsigned lo = (i & 1) ? (aw[i >> 1] >> 16) : (aw[i >> 1] & 0xffffu), hi = (i & 1) ? (bw[i >> 1] & 0xffff0000u) : (bw[i >> 1] << 16);
            *(LAS unsigned*)(dst + e * 256 + ((((jj >> 2) ^ (e & 15)) << 4) | ((jj & 3) << 2))) = lo | hi;
        }
    }
}

__device__ void ph_states(const Params& p, ldsp lds) {
    const int tid = otid(), w = tid >> 6, lane = tid & 63, fr = lane & 15, fq = lane >> 4;
    ldsp bKf = lds, bKb = lds + 32768, bV = lds + 65536;
    const int jj = tid & 63, c0 = tid >> 6;
    u32x4_t rk[2][2], rv[2][2];
    auto issue = [&](int item) {
        const int bh = item / 34, c = item % 34;
        const bf16_t* K = p.rk + ((size_t)bh * KVROWS + c * 128) * 128;
        const bf16_t* V = p.rv + ((size_t)bh * KVROWS + c * 128) * 128;
#pragma unroll
        for (int ps = 0; ps < 2; ++ps) {
            const int cc = c0 + 8 * ps;
            rk[ps][0] = *(const u32x4_t*)(K + (2 * jj) * 128 + cc * 8); rk[ps][1] = *(const u32x4_t*)(K + (2 * jj + 1) * 128 + cc * 8);
            rv[ps][0] = *(const u32x4_t*)(V + (2 * jj) * 128 + cc * 8); rv[ps][1] = *(const u32x4_t*)(V + (2 * jj + 1) * 128 + cc * 8);
        }
    };
    if ((int)blockIdx.x < 32 * 34) issue(blockIdx.x);
    for (int item = blockIdx.x; item < 32 * 34; item += gridDim.x) {
        const int bh = item / 34, h = bh & 3;
        const float lgf = lgam(p, 0, h), lgb = lgam(p, 1, h);
        {
            const float wf0 = __expf(lgf * (float)(127 - 2 * jj)), wf1 = __expf(lgf * (float)(126 - 2 * jj));
            const float wb0 = __expf(lgb * (float)(2 * jj)), wb1 = __expf(lgb * (float)(2 * jj + 1));
#pragma unroll
            for (int ps = 0; ps < 2; ++ps) {
                const int cc = c0 + 8 * ps;
#pragma unroll
                for (int i = 0; i < 8; ++i) {
                    const int e = 8 * cc + i, off = e * 256 + ((((jj >> 2) ^ (e & 15)) << 4) | ((jj & 3) << 2));
                    const unsigned ka = rk[ps][0][i >> 1], kb2 = rk[ps][1][i >> 1], va = rv[ps][0][i >> 1], vb2 = rv[ps][1][i >> 1];
                    const float a = (i & 1) ? __uint_as_float(ka & 0xffff0000u) : __uint_as_float(ka << 16);
                    const float b = (i & 1) ? __uint_as_float(kb2 & 0xffff0000u) : __uint_as_float(kb2 << 16);
                    *(LAS unsigned*)(bKf + off) = pack2(a * wf0, b * wf1);
                    *(LAS unsigned*)(bKb + off) = pack2(a * wb0, b * wb1);
                    *(LAS unsigned*)(bV + off) = (i & 1) ? ((va >> 16) | (vb2 & 0xffff0000u)) : ((va & 0xffffu) | (vb2 << 16));
                }
            }
        }
        if (item + (int)gridDim.x < 32 * 34) issue(item + gridDim.x);
        __syncthreads();
        f32x4_t af[8], ab[8];
#pragma unroll
        for (int i = 0; i < 8; ++i) { af[i] = (f32x4_t){0.f, 0.f, 0.f, 0.f}; ab[i] = (f32x4_t){0.f, 0.f, 0.f, 0.f}; }
#pragma unroll 1
        for (int kk = 0; kk < 4; ++kk) {
            const bf16x8_t xf = ldfrag(bKf, 16 * w + fr, kk, fq), xb = ldfrag(bKb, 16 * w + fr, kk, fq);
#pragma unroll
            for (int nt = 0; nt < 8; ++nt) { const bf16x8_t bv = ldfrag(bV, 16 * nt + fr, kk, fq); af[nt] = MFMA16(xf, bv, af[nt]); ab[nt] = MFMA16(xb, bv, ab[nt]); }
        }
#pragma unroll
        for (int nt = 0; nt < 8; ++nt) {
            const size_t o = ((size_t)item * 128 + 16 * nt + fr) * 128 + 16 * w + 4 * fq;
            uint2 u; u.x = pack2(af[nt][0], af[nt][1]); u.y = pack2(af[nt][2], af[nt][3]); *(uint2*)(p.Kf + o) = u;
            u.x = pack2(ab[nt][0], ab[nt][1]); u.y = pack2(ab[nt][2], ab[nt][3]); *(uint2*)(p.Kb + o) = u;
        }
        __syncthreads();
    }
}

__device__ void ph_retout(const Params& p, ldsp lds) {
    const int tid = otid(), w = tid >> 6, lane = tid & 63, fr = lane & 15, fq = lane >> 4;
    ldsp bQ = lds, bK = lds + 32768, bV = lds + 65536, bR = lds + 98304;
    for (int item = blockIdx.x; item < 1024; item += gridDim.x) {
        const int bh = item >> 5, n = item & 31, b = bh >> 2, h = bh & 3;
        const float lgf = lgam(p, 0, h), lgb = lgam(p, 1, h);
        const bf16_t* Q = p.rq + ((size_t)bh * 4096 + n * 128) * 128;
        const bf16_t* K = p.rk + ((size_t)bh * KVROWS + n * 128) * 128;
        const bf16_t* V = p.rv + ((size_t)bh * KVROWS + n * 128) * 128;
        const bf16_t* RF = p.Rf + (size_t)(bh * 32 + n) * 16384;
        const bf16_t* RB = p.Rb + (size_t)(bh * 32 + n) * 16384;
        stage_tile(bQ, Q, tid); stage_tile(bK, K, tid); stage_tileT(bV, V, tid); stage_tile(bR, RF, tid);
        __syncthreads();
        f32x4_t s[8];
#pragma unroll
        for (int i = 0; i < 8; ++i) s[i] = (f32x4_t){0.f, 0.f, 0.f, 0.f};
#pragma unroll 1
        for (int kk = 0; kk < 4; ++kk) {
            const bf16x8_t a = ldfrag(bK, 16 * w + fr, kk, fq);
#pragma unroll
            for (int nt = 0; nt < 8; ++nt) { const bf16x8_t bq = ldfrag(bQ, 16 * nt + fr, kk, fq); s[nt] = MFMA16(a, bq, s[nt]); }
        }
        u32x4_t rbreg[4];
#pragma unroll
        for (int i = 0; i < 4; ++i) rbreg[i] = *(const u32x4_t*)(RB + (size_t)(tid + NT * i) * 8);
        __syncthreads();
#pragma unroll
        for (int nt = 0; nt < 8; ++nt) {
            const int i = 16 * nt + fr; float o[4];
#pragma unroll
            for (int r = 0; r < 4; ++r) { const int dlt = i - (16 * w + 4 * fq + r); const float dec = dlt >= 0 ? __expf(lgf * (float)dlt) : __expf(lgb * (float)(-dlt)); o[r] = s[nt][r] * dec; }
            u32x2_t u; u.x = pack2(o[0], o[1]); u.y = pack2(o[2], o[3]);
            *(LAS u32x2_t*)(bK + toff(i, 16 * w + 4 * fq)) = u;
        }
        __syncthreads();
        f32x4_t y[8], ca[8];
#pragma unroll
        for (int i = 0; i < 8; ++i) { y[i] = (f32x4_t){0.f, 0.f, 0.f, 0.f}; ca[i] = (f32x4_t){0.f, 0.f, 0.f, 0.f}; }
#pragma unroll 1
        for (int kk = 0; kk < 4; ++kk) {
            const bf16x8_t bs = ldfrag(bK, 16 * w + fr, kk, fq), bq = ldfrag(bQ, 16 * w + fr, kk, fq);
#pragma unroll
            for (int mt = 0; mt < 8; ++mt) {
                y[mt] = MFMA16(ldfrag(bV, 16 * mt + fr, kk, fq), bs, y[mt]);
                ca[mt] = MFMA16(ldfrag(bR, 16 * mt + fr, kk, fq), bq, ca[mt]);
            }
        }
        const int ip = 16 * w + fr;
        {
            const float cfs = __expf(lgf * (float)(ip + 1));
#pragma unroll
            for (int mt = 0; mt < 8; ++mt) { y[mt] += cfs * ca[mt]; ca[mt] = (f32x4_t){0.f, 0.f, 0.f, 0.f}; }
        }
        __syncthreads();
#pragma unroll
        for (int i = 0; i < 4; ++i) { const int idx = tid + NT * i, r = idx >> 4, c = idx & 15; *(LAS u32x4_t*)(bV + r * 256 + ((c ^ (r & 15)) << 4)) = rbreg[i]; }
        __syncthreads();
#pragma unroll 1
        for (int kk = 0; kk < 4; ++kk) {
            const bf16x8_t bq = ldfrag(bQ, 16 * w + fr, kk, fq);
#pragma unroll
            for (int mt = 0; mt < 8; ++mt) ca[mt] = MFMA16(ldfrag(bV, 16 * mt + fr, kk, fq), bq, ca[mt]);
        }
        const float cbs = __expf(lgb * (float)(128 - ip));
        float sum = 0.f;
#pragma unroll
        for (int mt = 0; mt < 8; ++mt) { y[mt] += cbs * ca[mt]; sum += y[mt][0] + y[mt][1] + y[mt][2] + y[mt][3]; }
        sum += __shfl_xor(sum, 16); sum += __shfl_xor(sum, 32);
        const float mu = sum * (1.f / 128.f);
        float vs = 0.f;
#pragma unroll
        for (int mt = 0; mt < 8; ++mt)
#pragma unroll
            for (int r = 0; r < 4; ++r) { const float dl = y[mt][r] - mu; vs += dl * dl; }
        vs += __shfl_xor(vs, 16); vs += __shfl_xor(vs, 32);
        const float rs = rsqrtf(vs * (1.f / 128.f) + 1e-6f);
        const size_t row = (size_t)b * 4096 + n * 128 + ip;
#pragma unroll
        for (int mt = 0; mt < 8; ++mt) {
            const int col = h * 128 + 16 * mt + 4 * fq;
            const uint2 g = *(const uint2*)(p.rg + row * 512 + col);
            const float4 gw = *(const float4*)(p.gn_w + col);
            const float o0 = (y[mt][0] - mu) * rs * gw.x * __uint_as_float(g.x << 16), o1 = (y[mt][1] - mu) * rs * gw.y * __uint_as_float(g.x & 0xffff0000u);
            const float o2 = (y[mt][2] - mu) * rs * gw.z * __uint_as_float(g.y << 16), o3 = (y[mt][3] - mu) * rs * gw.w * __uint_as_float(g.y & 0xffff0000u);
            uint2 u; u.x = pack2(o0, o1); u.y = pack2(o2, o3);
            *(uint2*)(p.mixed + row * 1024 + col) = u;
        }
        __syncthreads();
    }
}


__device__ __forceinline__ int koff(int r, int c) { return r * 128 + ((((c >> 3) ^ ((r >> 1) & 7)) << 4) | ((c & 7) << 1)); }
__device__ void ph_attn(const Params& p, ldsp lds) {
    const int tid = otid(), w = tid >> 6, lane = tid & 63, fr = lane & 15, fq = lane >> 4;
    const int g = w >> 1, sub = w & 1;
    int cnt = 0;
    for (int item = blockIdx.x; item < 1024; item += gridDim.x) {
        const int half = item & 1, nb = (item >> 1) & 31, bk = item >> 6, qoff = 64 * half + 32 * sub, b = bk >> 1, kvh = bk & 1, qh = kvh * 4 + g;
        const bf16_t* Kg = p.ak + (size_t)bk * KVROWS * 64;
        const bf16_t* Vg = p.av + (size_t)bk * KVROWS * 64;
        bf16x8_t qf[2][2];
#pragma unroll
        for (int st = 0; st < 2; ++st)
#pragma unroll
            for (int kk = 0; kk < 2; ++kk) qf[st][kk] = *(const bf16x8_t*)(p.aq + ((size_t)(b * 8 + qh) * 4096 + nb * 128 + qoff + 16 * st + fr) * 64 + 32 * kk + 8 * fq);
        f32x4_t oacc[2][4], lacc[2]; float mrun[2];
        const float sink = p.sink[qh] * 1.4426950408889634f;
        const bf16x8_t ones = (bf16x8_t){0x3F80, 0x3F80, 0x3F80, 0x3F80, 0x3F80, 0x3F80, 0x3F80, 0x3F80};
#pragma unroll
        for (int st = 0; st < 2; ++st) {
            mrun[st] = sink; lacc[st] = (f32x4_t){1.f, 1.f, 1.f, 1.f};
#pragma unroll
            for (int mt = 0; mt < 4; ++mt) oacc[st][mt] = (f32x4_t){0.f, 0.f, 0.f, 0.f};
        }
        const int ntl = 5 - (nb == 0 ? 1 : 0) - (nb == 31 ? 1 : 0);
        const int jj = tid & 63, vc = tid >> 6;
        u32x4_t pk0, pk1, pv0, pv1;
        {
            const int rb0 = 0;
            pk0 = *(const u32x4_t*)(Kg + (size_t)rb0 * 64 + (size_t)tid * 8); pk1 = *(const u32x4_t*)(Kg + (size_t)rb0 * 64 + (size_t)(tid + NT) * 8);
            pv0 = *(const u32x4_t*)(Vg + (size_t)(rb0 + 2 * jj) * 64 + vc * 8); pv1 = *(const u32x4_t*)(Vg + (size_t)(rb0 + 2 * jj + 1) * 64 + vc * 8);
        }
#pragma unroll 1
        for (int k = 0; k < ntl; ++k) {
            const int ti = k + ((nb == 0 && k >= 2) ? 1 : 0);
            const int mode = ti == 2 ? 1 : (ti == 4 ? 2 : 0);
            ldsp kb = lds + (cnt & 1) * 32768, vb = kb + 16384; ++cnt;
            {
                const int r0 = tid >> 3, c0 = tid & 7, r1 = (tid + NT) >> 3;
                *(LAS u32x4_t*)(kb + r0 * 128 + ((c0 ^ ((r0 >> 1) & 7)) << 4)) = pk0;
                *(LAS u32x4_t*)(kb + r1 * 128 + ((c0 ^ ((r1 >> 1) & 7)) << 4)) = pk1;
#pragma unroll
                for (int i = 0; i < 8; ++i) {
                    const int e = 8 * vc + i;
                    const unsigned lo = (i & 1) ? (pv0[i >> 1] >> 16) : (pv0[i >> 1] & 0xffffu), hi = (i & 1) ? (pv1[i >> 1] & 0xffff0000u) : (pv1[i >> 1] << 16);
                    *(LAS unsigned*)(vb + e * 256 + ((((jj >> 2) ^ (e & 15)) << 4) | ((jj & 3) << 2))) = lo | hi;
                }
            }
            if (k + 1 < ntl) {
                const int tn = k + 1 + ((nb == 0 && k + 1 >= 2) ? 1 : 0);
                const int rbn = tn < 2 ? tn * 128 : 256 + (nb + tn - 3) * 128;
                pk0 = *(const u32x4_t*)(Kg + (size_t)rbn * 64 + (size_t)tid * 8); pk1 = *(const u32x4_t*)(Kg + (size_t)rbn * 64 + (size_t)(tid + NT) * 8);
                pv0 = *(const u32x4_t*)(Vg + (size_t)(rbn + 2 * jj) * 64 + vc * 8); pv1 = *(const u32x4_t*)(Vg + (size_t)(rbn + 2 * jj + 1) * 64 + vc * 8);
            }
            __syncthreads();
#pragma unroll
            for (int st = 0; st < 2; ++st) {
                const int q0s = qoff + 16 * st;
                constexpr int mlo = 0, mhi = 7;
                f32x4_t s[8];
#pragma unroll
                for (int mt = 0; mt < 8; ++mt) {
                    if (mt >= mlo && mt <= mhi) {
                        s[mt] = (f32x4_t){0.f, 0.f, 0.f, 0.f};
#pragma unroll
                        for (int kk = 0; kk < 2; ++kk) s[mt] = MFMA16(*(const LAS bf16x8_t*)(kb + koff(16 * mt + fr, 32 * kk + 8 * fq)), qf[st][kk], s[mt]);
                    } else s[mt] = (f32x4_t){-1e30f, -1e30f, -1e30f, -1e30f};
                }
                if (mode) {
                    const int qi = q0s + fr;
#pragma unroll
                    for (int mt = 0; mt < 8; ++mt)
#pragma unroll
                        for (int r = 0; r < 4; ++r) { const int kj = 16 * mt + 4 * fq + r; const bool ok = mode == 1 ? kj >= qi : kj <= qi; s[mt][r] = ok ? s[mt][r] : -1e30f; }
                }
                float mx = s[0][0];
#pragma unroll
                for (int mt = 0; mt < 8; ++mt)
#pragma unroll
                    for (int r = 0; r < 4; ++r) mx = fmaxf(mx, s[mt][r]);
                mx = fmaxf(mx, __shfl_xor(mx, 16)); mx = fmaxf(mx, __shfl_xor(mx, 32));
                const float mn = fmaxf(mrun[st], mx), sc = __builtin_amdgcn_exp2f(mrun[st] - mn);
                mrun[st] = mn;
#pragma unroll
                for (int mt = 0; mt < 8; ++mt) {
                    if (mt >= mlo && mt <= mhi) {
#pragma unroll
                        for (int r = 0; r < 4; ++r) s[mt][r] = __builtin_amdgcn_exp2f(s[mt][r] - mn);
                    } else s[mt] = (f32x4_t){0.f, 0.f, 0.f, 0.f};
                }
                lacc[st] *= sc;
#pragma unroll
                for (int mt = 0; mt < 4; ++mt) oacc[st][mt] *= sc;
#pragma unroll
                for (int kk = 0; kk < 4; ++kk) {
                    if (2 * kk + 1 >= mlo && 2 * kk <= mhi) {
                        u32x4_t pu; pu.x = pack2(s[2 * kk][0], s[2 * kk][1]); pu.y = pack2(s[2 * kk][2], s[2 * kk][3]); pu.z = pack2(s[2 * kk + 1][0], s[2 * kk + 1][1]); pu.w = pack2(s[2 * kk + 1][2], s[2 * kk + 1][3]);
                        const bf16x8_t pf = __builtin_bit_cast(bf16x8_t, pu);
                        lacc[st] = MFMA16(ones, pf, lacc[st]);
#pragma unroll
                        for (int mt = 0; mt < 4; ++mt) {
                            const u32x2_t lo = *(const LAS u32x2_t*)(vb + toff(16 * mt + fr, 32 * kk + 4 * fq)), hi = *(const LAS u32x2_t*)(vb + toff(16 * mt + fr, 32 * kk + 16 + 4 * fq));
                            u32x4_t au; au.x = lo.x; au.y = lo.y; au.z = hi.x; au.w = hi.y;
                            oacc[st][mt] = MFMA16(__builtin_bit_cast(bf16x8_t, au), pf, oacc[st][mt]);
                        }
                    }
                }
                __builtin_amdgcn_sched_barrier(0);
            }
        }
#pragma unroll
        for (int st = 0; st < 2; ++st) {
            const float inv = 1.f / lacc[st][0];
            const size_t row = (size_t)b * 4096 + nb * 128 + qoff + 16 * st + fr;
#pragma unroll
            for (int mt = 0; mt < 4; ++mt) {
                const int col = qh * 64 + 16 * mt + 4 * fq;
                const uint2 gt = *(const uint2*)(p.ag + row * 512 + col);
                const float o0 = oacc[st][mt][0] * inv * __uint_as_float(gt.x << 16), o1 = oacc[st][mt][1] * inv * __uint_as_float(gt.x & 0xffff0000u);
                const float o2 = oacc[st][mt][2] * inv * __uint_as_float(gt.y << 16), o3 = oacc[st][mt][3] * inv * __uint_as_float(gt.y & 0xffff0000u);
                uint2 u; u.x = pack2(o0, o1); u.y = pack2(o2, o3);
                *(uint2*)(p.mixed + row * 1024 + 512 + col) = u;
            }
        }
    }
    __syncthreads();
}

__device__ void ph_states_naive(const Params& p) {
    for (int item = blockIdx.x; item < 32 * 34; item += gridDim.x) {
        const int bh = item / 34, c = item % 34, h = bh & 3;
        const float lgf = lgam(p, 0, h), lgb = lgam(p, 1, h);
        const bf16_t* K = p.rk + ((size_t)bh * KVROWS + c * 128) * 128;
        const bf16_t* V = p.rv + ((size_t)bh * KVROWS + c * 128) * 128;
        const int e = threadIdx.x & 127, dg = threadIdx.x >> 7;
        float af[32], ab[32];
#pragma unroll
        for (int i = 0; i < 32; ++i) { af[i] = 0.f; ab[i] = 0.f; }
        for (int j = 0; j < 128; ++j) {
            const float vv = bf2f(V[j * 128 + e]);
            const float wf = expf(lgf * (float)(127 - j)) * vv, wb = expf(lgb * (float)j) * vv;
#pragma unroll
            for (int d8 = 0; d8 < 4; ++d8) {
                float kk[8]; load8(K + j * 128 + dg * 32 + d8 * 8, kk);
#pragma unroll
                for (int i = 0; i < 8; ++i) { af[d8 * 8 + i] += wf * kk[i]; ab[d8 * 8 + i] += wb * kk[i]; }
            }
        }
        bf16_t* of = p.Kf + ((size_t)item * 128 + e) * 128 + dg * 32;
        bf16_t* ob = p.Kb + ((size_t)item * 128 + e) * 128 + dg * 32;
#pragma unroll
        for (int d8 = 0; d8 < 4; ++d8) { store8(of + d8 * 8, af + d8 * 8); store8(ob + d8 * 8, ab + d8 * 8); }
    }
}

__device__ void ph_scan(const Params& p) {
    const int tid = otid();
    for (int blk = blockIdx.x; blk < 512; blk += gridDim.x) {
        const int dir = blk >> 8, bh = (blk >> 3) & 31, h = bh & 3;
        const unsigned el = (unsigned)((blk & 7) * NT + tid) * 4u;
        const float gC = expf(lgam(p, dir, h) * 128.f);
        const bf16_t* __restrict__ ks = (dir ? p.Kb : p.Kf) + (size_t)bh * 34 * 16384;
        bf16_t* __restrict__ rs = (dir ? p.Rb : p.Rf) + (size_t)bh * 32 * 16384;
        uint2 kv[34];
#pragma unroll
        for (int n = 0; n < 34; ++n) kv[n] = *(const uint2*)(ks + (size_t)n * 16384 + el);
        float R[4];
        auto cv = [](const uint2 u, float* o) { o[0] = __uint_as_float(u.x << 16); o[1] = __uint_as_float(u.x & 0xffff0000u); o[2] = __uint_as_float(u.y << 16); o[3] = __uint_as_float(u.y & 0xffff0000u); };
        float t[4];
        cv(dir ? kv[33] : kv[32], R); cv(dir ? kv[32] : kv[33], t);
#pragma unroll
        for (int i = 0; i < 4; ++i) R[i] = gC * R[i] + t[i];
#pragma unroll
        for (int s = 0; s < 32; ++s) {
            const int n = dir ? 31 - s : s;
            uint2 u; u.x = pack2(R[0], R[1]); u.y = pack2(R[2], R[3]);
            *(uint2*)(rs + (size_t)n * 16384 + el) = u;
            cv(dir ? kv[31 - s] : kv[s], t);
#pragma unroll
            for (int i = 0; i < 4; ++i) R[i] = gC * R[i] + t[i];
        }
    }
}

__device__ void ph_retout_naive(const Params& p, float* S) {
    for (int item = blockIdx.x; item < 1024; item += gridDim.x) {
        const int bh = item >> 5, n = item & 31, b = bh >> 2, h = bh & 3;
        const float lgf = lgam(p, 0, h), lgb = lgam(p, 1, h);
        const bf16_t* Q = p.rq + ((size_t)bh * 4096 + n * 128) * 128;
        const bf16_t* K = p.rk + ((size_t)bh * KVROWS + n * 128) * 128;
        const bf16_t* V = p.rv + ((size_t)bh * KVROWS + n * 128) * 128;
        const bf16_t* RF = p.Rf + (size_t)(bh * 32 + n) * 16384;
        const bf16_t* RB = p.Rb + (size_t)(bh * 32 + n) * 16384;
        const int i = threadIdx.x >> 2, q4 = threadIdx.x & 3;
        for (int jj = 0; jj < 32; ++jj) {
            const int j = q4 * 32 + jj;
            float dot = 0.f;
#pragma unroll 4
            for (int d8 = 0; d8 < 16; ++d8) {
                float a[8], bb[8]; load8(Q + i * 128 + d8 * 8, a); load8(K + j * 128 + d8 * 8, bb);
#pragma unroll
                for (int t = 0; t < 8; ++t) dot += a[t] * bb[t];
            }
            const float dec = j <= i ? expf(lgf * (float)(i - j)) : expf(lgb * (float)(j - i));
            S[i * 128 + ((j + i) & 127)] = dot * dec;
        }
        __syncthreads();
        float y[32];
#pragma unroll
        for (int t = 0; t < 32; ++t) y[t] = 0.f;
        const int e0 = q4 * 32;
        for (int j = 0; j < 128; ++j) {
            const float s = S[i * 128 + ((j + i) & 127)];
#pragma unroll
            for (int e8 = 0; e8 < 4; ++e8) {
                float vv[8]; load8(V + j * 128 + e0 + e8 * 8, vv);
#pragma unroll
                for (int t = 0; t < 8; ++t) y[e8 * 8 + t] += s * vv[t];
            }
        }
        const float cf = expf(lgf * (float)(i + 1)), cb = expf(lgb * (float)(128 - i));
#pragma unroll 1
        for (int d8 = 0; d8 < 16; ++d8) {
            float a[8]; load8(Q + i * 128 + d8 * 8, a);
#pragma unroll
            for (int ee = 0; ee < 32; ++ee) {
                float rf[8], rb[8]; load8(RF + (e0 + ee) * 128 + d8 * 8, rf); load8(RB + (e0 + ee) * 128 + d8 * 8, rb);
                float sf = 0.f, sb = 0.f;
#pragma unroll
                for (int t = 0; t < 8; ++t) { sf += a[t] * rf[t]; sb += a[t] * rb[t]; }
                y[ee] += cf * sf + cb * sb;
            }
        }
        float sum = 0.f;
#pragma unroll
        for (int t = 0; t < 32; ++t) sum += y[t];
        sum += __shfl_xor(sum, 1); sum += __shfl_xor(sum, 2);
        const float mu = sum * (1.f / 128.f);
        float vs = 0.f;
#pragma unroll
        for (int t = 0; t < 32; ++t) { const float dlt = y[t] - mu; vs += dlt * dlt; }
        vs += __shfl_xor(vs, 1); vs += __shfl_xor(vs, 2);
        const float rs = rsqrtf(vs * (1.f / 128.f) + 1e-6f);
        const size_t row = (size_t)b * 4096 + n * 128 + i;
        const int col0 = h * 128 + e0;
#pragma unroll
        for (int e8 = 0; e8 < 4; ++e8) {
            float g[8], o[8]; load8(p.rg + row * 512 + col0 + e8 * 8, g);
#pragma unroll
            for (int t = 0; t < 8; ++t) o[t] = (y[e8 * 8 + t] - mu) * rs * p.gn_w[col0 + e8 * 8 + t] * g[t];
            store8(p.mixed + row * 1024 + col0 + e8 * 8, o);
        }
        __syncthreads();
    }
}

__device__ void ph_attn_naive(const Params& p) {
    for (int idx = blockIdx.x * NT + otid(); idx < 8 * 8 * 4096; idx += gridDim.x * NT) {
        const int t = idx & 4095, bq = idx >> 12, qh = bq & 7, b = bq >> 3, kvh = qh >> 2;
        float q[64], acc[64];
#pragma unroll
        for (int d8 = 0; d8 < 8; ++d8) load8(p.aq + ((size_t)bq * 4096 + t) * 64 + d8 * 8, q + d8 * 8);
#pragma unroll
        for (int e = 0; e < 64; ++e) acc[e] = 0.f;
        const bf16_t* Kb = p.ak + (size_t)(b * 2 + kvh) * KVROWS * 64;
        const bf16_t* Vb = p.av + (size_t)(b * 2 + kvh) * KVROWS * 64;
        float m = p.sink[qh], l = 1.f;
        const int lo = t - 128 < 0 ? 0 : t - 128, hi = t + 128 > 4095 ? 4095 : t + 128;
        const int nkeys = 256 + (hi - lo + 1);
        for (int kk = 0; kk < nkeys; ++kk) {
            const int krow = kk < 256 ? kk : lo + kk;
            float s = 0.f;
#pragma unroll
            for (int d8 = 0; d8 < 8; ++d8) {
                float kv[8]; load8(Kb + (size_t)krow * 64 + d8 * 8, kv);
#pragma unroll
                for (int i = 0; i < 8; ++i) s += q[d8 * 8 + i] * kv[i];
            }
            if (s > m) {
                const float sc = __expf(m - s); l *= sc;
#pragma unroll
                for (int e = 0; e < 64; ++e) acc[e] *= sc;
                m = s;
            }
            const float pe = __expf(s - m); l += pe;
#pragma unroll
            for (int d8 = 0; d8 < 8; ++d8) {
                float vv[8]; load8(Vb + (size_t)krow * 64 + d8 * 8, vv);
#pragma unroll
                for (int i = 0; i < 8; ++i) acc[d8 * 8 + i] += pe * vv[i];
            }
        }
        const float inv = 1.f / l;
        const size_t row = (size_t)b * 4096 + t;
#pragma unroll
        for (int d8 = 0; d8 < 8; ++d8) {
            float g[8], o[8]; load8(p.ag + row * 512 + qh * 64 + d8 * 8, g);
#pragma unroll
            for (int i = 0; i < 8; ++i) o[i] = acc[d8 * 8 + i] * inv * g[i];
            store8(p.mixed + row * 1024 + 512 + qh * 64 + d8 * 8, o);
        }
    }
}

__device__ void ph_final(const Params& p) {
    const int tid = otid(), wave = tid >> 6, lane = tid & 63;
    const int stride = gridDim.x * 8;
    float4 w4[4];
#pragma unroll
    for (int i = 0; i < 4; ++i) w4[i] = *(const float4*)(p.fnw + i * 256 + lane * 4);
    for (int row0 = blockIdx.x * 8 + wave; row0 < 32768; row0 += 2 * stride) {
        float4 xv[2][4]; bool ok[2];
#pragma unroll
        for (int u = 0; u < 2; ++u) {
            const int row = row0 + u * stride; ok[u] = row < 32768;
            const float* src = p.out + (size_t)(ok[u] ? row : row0) * 1024;
#pragma unroll
            for (int i = 0; i < 4; ++i) xv[u][i] = *(const float4*)(src + i * 256 + lane * 4);
        }
#pragma unroll
        for (int u = 0; u < 2; ++u) {
            if (!ok[u]) continue;
            float* dst = p.out + (size_t)(row0 + u * stride) * 1024;
            float ss = 0.f;
#pragma unroll
            for (int i = 0; i < 4; ++i) ss += xv[u][i].x * xv[u][i].x + xv[u][i].y * xv[u][i].y + xv[u][i].z * xv[u][i].z + xv[u][i].w * xv[u][i].w;
            ss = wave_sum(ss);
            const float rstd = rsqrtf(ss * (1.f / 1024.f) + 1e-6f);
#pragma unroll
            for (int i = 0; i < 4; ++i) {
                float4 o; o.x = xv[u][i].x * rstd * w4[i].x; o.y = xv[u][i].y * rstd * w4[i].y; o.z = xv[u][i].z * rstd * w4[i].z; o.w = xv[u][i].w * rstd * w4[i].w;
                *(float4*)(dst + i * 256 + lane * 4) = o;
            }
        }
    }
}

#define NPHASE 9
template <int PH> __device__ __forceinline__ void run_phase(const Params& p, float* lds) {
    if (PH == 0) ph_mod(p, lds);
    else if (PH == 1) { ph_wconv(p, lds); ph_h(p); }
    else if (PH == 2) ph_gemm_in(p, lds);
    else if (PH == 3) { ph_states(p, (ldsp)lds); ph_attn(p, (ldsp)lds); }
    else if (PH == 4) ph_scan(p);
    else if (PH == 5) ph_retout(p, (ldsp)lds);
    else if (PH == 6) ph_gemm_out(p, lds);
    else if (PH == 7) ph_final(p);
}

template <int PH> __global__ __launch_bounds__(NT) void k_ph(Params p) {
    extern __shared__ __attribute__((aligned(16))) float lds[];
    run_phase<PH>(p, lds);
}


#define XB_TMO      128
#define XB_XCNT(j)  (256  + 64 * (j))
#define XB_XSUB(j)  (1280 + 64 * (j))
#define XB_XGEN(j)  (2304 + 64 * (j))
#define XB_TOP      3328
#define XB_TOPGEN   3392
#define XCD_BAR_WORDS 3456
#define XB_SPIN_CAP (1u << 18)
__device__ __forceinline__ unsigned xb_ld(unsigned* p)              { return __hip_atomic_load(p, __ATOMIC_RELAXED, __HIP_MEMORY_SCOPE_AGENT); }
__device__ __forceinline__ unsigned xb_add(unsigned* p, unsigned v) { return __hip_atomic_fetch_add(p, v, __ATOMIC_RELAXED, __HIP_MEMORY_SCOPE_AGENT); }
__device__ __forceinline__ unsigned xb_xcc_id() { return (unsigned)__builtin_amdgcn_s_getreg((3 << 11) | 20) & 0xFu; }
#define XB_SPIN(cond, bar) do { unsigned _sp = 0; while (cond) { __builtin_amdgcn_s_sleep(1); \
    if ((++_sp & 255u) == 0u) { if (xb_ld(&(bar)[XB_TMO])) break; if (_sp > XB_SPIN_CAP) { atomicAdd(&(bar)[XB_TMO], 1u); break; } } } } while (0)
struct XcdBarrier { unsigned* bar; unsigned x; volatile LAS unsigned* st; };
__device__ __forceinline__ XcdBarrier xcd_barrier_post(unsigned* bar, volatile LAS unsigned* st) {
    XcdBarrier b; b.bar = bar; b.x = xb_xcc_id(); b.st = st;
    if (threadIdx.x == 0) (void)xb_add(&bar[XB_XCNT(b.x)], 1u);
    return b;
}
__device__ __forceinline__ void xcd_barrier_complete(unsigned* bar, unsigned x, unsigned& nloc, unsigned& nx) {
    const unsigned G = gridDim.x * gridDim.y * gridDim.z;
    unsigned sum, cnt, mine, sp = 0u;
    for (;;) {
        sum = 0u; cnt = 0u; mine = 0u;
#pragma unroll
        for (unsigned j = 0; j < 16; ++j) { const unsigned c = xb_ld(&bar[XB_XCNT(j)]); sum += c; cnt += (c > 0u) ? 1u : 0u; mine = (j == x) ? c : mine; }
        if (sum == G) break;
        __builtin_amdgcn_s_sleep(1);
        if ((++sp & 255u) == 0u) { if (xb_ld(&bar[XB_TMO])) break; if (sp > XB_SPIN_CAP) { atomicAdd(&bar[XB_TMO], 1u); break; } }
    }
    nloc = mine > 0u ? mine : 1u; nx = cnt > 0u ? cnt : 1u;
}
__device__ __forceinline__ void xcd_barrier(const XcdBarrier& b) {
    asm volatile("s_waitcnt vmcnt(0)" ::: "memory");
    __syncthreads();
    if (threadIdx.x == 0) {
        unsigned* bar = b.bar;
        __builtin_amdgcn_s_waitcnt(0);
        unsigned nloc = b.st[0], nx = b.st[1];
        if (nloc == 0u) { xcd_barrier_complete(bar, b.x, nloc, nx); b.st[0] = nloc; b.st[1] = nx; }
        const unsigned old = xb_add(&bar[XB_XSUB(b.x)], 1u);
        const unsigned gen = old / nloc;
        if (old + 1u == (gen + 1u) * nloc) {
            __builtin_amdgcn_fence(__ATOMIC_RELEASE, "agent");
            asm volatile("s_waitcnt vmcnt(0)" ::: "memory");
            const unsigned og = xb_add(&bar[XB_TOP], 1u);
            const unsigned tg = og / nx;
            if (og + 1u == (tg + 1u) * nx) xb_add(&bar[XB_TOPGEN], 1u);
            else XB_SPIN(xb_ld(&bar[XB_TOPGEN]) == tg, bar);
            __builtin_amdgcn_fence(__ATOMIC_ACQUIRE, "agent");
            xb_add(&bar[XB_XGEN(b.x)], 1u);
            asm volatile("s_waitcnt vmcnt(0)" ::: "memory");
        } else {
            XB_SPIN(xb_ld(&bar[XB_XGEN(b.x)]) == gen, bar);
            __builtin_amdgcn_fence(__ATOMIC_ACQUIRE, "agent");
            asm volatile("s_waitcnt vmcnt(0)" ::: "memory");
        }
    }
    __syncthreads();
}

#ifndef REPMASK
#define REPMASK 0
#endif
#define RUNPH(i) do { run_phase<i>(p, lds); if ((REPMASK >> i) & 1) { __syncthreads(); run_phase<i>(p, lds); } } while (0)
#define GSYNC() do { xcd_barrier(xb); if ((REPMASK >> 8) & 1) xcd_barrier(xb); } while (0)
__global__ __launch_bounds__(NT) void k_mega(Params p) {
    extern __shared__ __attribute__((aligned(16))) float lds[];
    cg::grid_group grid = cg::this_grid();
    if (p.out == nullptr) grid.sync();
    volatile LAS unsigned* xst = (volatile LAS unsigned*)((ldsp)lds + LDS_GEMM);
    if (threadIdx.x < 4) xst[threadIdx.x] = 0u;
    __syncthreads();
    const XcdBarrier xb = xcd_barrier_post(p.bar, xst);
    RUNPH(0); GSYNC();
    RUNPH(1); GSYNC();
    RUNPH(2); GSYNC();
    RUNPH(3); GSYNC();
    RUNPH(4); GSYNC();
    RUNPH(5); GSYNC();
    RUNPH(6); GSYNC();
    run_phase<7>(p, lds);
}

template <int PH> static void launch_ph(const Params& p, int grid, hipStream_t stream) {
    static bool attr = false;
    if (!attr) { (void)hipFuncSetAttribute((const void*)k_ph<PH>, hipFuncAttributeMaxDynamicSharedMemorySize, LDS_BYTES); attr = true; }
    hipLaunchKernelGGL(k_ph<PH>, dim3(grid), dim3(NT), LDS_BYTES, stream, p);
}

extern "C" void kernel_launch(void* const* d_in, const int* in_sizes, int n_in, void* d_out, int out_size, void* d_ws, size_t ws_size, hipStream_t stream) {
    Params p{};
    p.x = (const float*)d_in[0]; p.c = (const float*)d_in[1]; p.ctx = (const float*)d_in[2]; p.c_ctx = (const float*)d_in[3];
    p.w_ada = (const float*)d_in[4]; p.b_ada = (const float*)d_in[5]; p.w_in = (const float*)d_in[6]; p.decay = (const float*)d_in[7];
    p.gn_w = (const float*)d_in[8]; p.sink = (const float*)d_in[9]; p.w_out = (const float*)d_in[10]; p.fnw = (const float*)d_in[11];
    p.out = (float*)d_out;
    unsigned char* w = (unsigned char*)d_ws; size_t off = 0;
    auto take = [&](size_t bytes) { unsigned char* r = w + off; off += (bytes + 255) & ~(size_t)255; return r; };
    p.mod = (float*)take(9 * 3072 * 4);
    p.tab128 = (float2*)take(64 * 32 * 8);
    p.tab64 = (float2*)take(64 * 16 * 8);
    p.h = (bf16_t*)take((size_t)MROWS * 1024 * 2);
    p.mixed = p.h;
    p.rq = (bf16_t*)take((size_t)32 * 4096 * 128 * 2);
    p.rk = (bf16_t*)take((size_t)32 * KVROWS * 128 * 2);
    p.rv = (bf16_t*)take((size_t)32 * KVROWS * 128 * 2);
    p.rg = (bf16_t*)take((size_t)32768 * 512 * 2);
    p.aq = (bf16_t*)take((size_t)64 * 4096 * 64 * 2);
    p.ak = (bf16_t*)take((size_t)16 * KVROWS * 64 * 2);
    p.av = (bf16_t*)take((size_t)16 * KVROWS * 64 * 2);
    p.ag = (bf16_t*)take((size_t)32768 * 512 * 2);
    p.Kf = (bf16_t*)take((size_t)32 * 34 * 16384 * 2);
    p.Kb = (bf16_t*)take((size_t)32 * 34 * 16384 * 2);
    p.Rf = (bf16_t*)take((size_t)32 * 32 * 16384 * 2);
    p.Rb = (bf16_t*)take((size_t)32 * 32 * 16384 * 2);
    p.WinT = (bf16_t*)take((size_t)3328 * 1024 * 2);
    p.WoutT = (bf16_t*)take((size_t)1024 * 1024 * 2);
    p.bar = (unsigned*)take(XCD_BAR_WORDS * 4);
    if (off > ws_size) { fprintf(stderr, "kernel_launch: workspace too small (%zu > %zu)\n", off, ws_size); return; }
#if MK_ONE_LAUNCH
    static int grid_blocks = 0;
    if (!grid_blocks) {
        int dev = 0, cus = 0, per_cu = 0;
        (void)hipGetDevice(&dev);
        (void)hipDeviceGetAttribute(&cus, hipDeviceAttributeMultiprocessorCount, dev);
        (void)hipFuncSetAttribute((const void*)k_mega, hipFuncAttributeMaxDynamicSharedMemorySize, LDS_BYTES);
        (void)hipOccupancyMaxActiveBlocksPerMultiprocessor(&per_cu, (const void*)k_mega, NT, LDS_BYTES);
        if (per_cu < 1) per_cu = 1;
        grid_blocks = cus * per_cu;
    }
    (void)hipMemsetAsync(p.bar, 0, XCD_BAR_WORDS * 4, stream);
    void* args[] = {&p};
    hipError_t e = hipLaunchCooperativeKernel((const void*)k_mega, dim3(grid_blocks), dim3(NT), args, LDS_BYTES, stream);
    if (e != hipSuccess) fprintf(stderr, "cooperative launch failed: %s (grid %d)\n", hipGetErrorString(e), grid_blocks);
#else
    const int G = 1024;
    launch_ph<0>(p, G, stream); launch_ph<1>(p, G, stream); launch_ph<2>(p, G, stream); launch_ph<3>(p, G, stream);
    launch_ph<4>(p, G, stream); launch_ph<5>(p, G, stream); launch_ph<6>(p, G, stream); launch_ph<7>(p, G, stream);
#endif
}
```
